# Optimizing an MI355X kernel written in HIP

```python
import jax, jax.numpy as jnp
from jax import lax
import numpy as np

D_MODEL = 1024
BATCH = 4
SEQ = 4096
DEPTH = 1

CHUNK = 64
HEAD_DIM = 64
RW_WIDTH = 512
FX_WIDTH = 512
RW_HEADS = RW_WIDTH // HEAD_DIM
FX_HEADS = FX_WIDTH // HEAD_DIM
MIX_WIDTH = RW_WIDTH + FX_WIDTH
RW_DECAY_LORA = 32
RW_AAA_LORA = 32
RW_GATE_LORA = 96
RW_COLS = 3 * RW_WIDTH + RW_DECAY_LORA + RW_AAA_LORA + RW_GATE_LORA
FX_COLS = 4 * FX_WIDTH + FX_HEADS
IN_COLS = RW_COLS + FX_COLS
RW_SPLITS = [RW_WIDTH, 2 * RW_WIDTH, 3 * RW_WIDTH, 3 * RW_WIDTH + RW_DECAY_LORA,
             3 * RW_WIDTH + RW_DECAY_LORA + RW_AAA_LORA]
FX_SPLITS = [FX_WIDTH, 2 * FX_WIDTH, 3 * FX_WIDTH, 4 * FX_WIDTH]
RW_GN_EPS = 64e-5
QK_EPS = 1e-6
LN_EPS = 1e-5
Q_BLOCK = 128
N_EXPERTS = 32
TOP_K = 4
EXPERT_FF = D_MODEL
SWIGLU_ALPHA = 1.702
SWIGLU_LIMIT = 7.0
MOE_BLOCK = 128
DEEPNORM_ALPHA = (2 * DEPTH) ** 0.25
DEEPNORM_BETA = (8 * DEPTH) ** -0.25

kernel_name = 'hybrid_rwkv7_fox_moe_encoder'


def _layer_norm(x, w, b):
    xf = x.astype(jnp.float32)
    mu = jnp.mean(xf, axis=-1, keepdims=True)
    var = jnp.mean(jnp.square(xf - mu), axis=-1, keepdims=True)
    return ((xf - mu) * lax.rsqrt(var + LN_EPS) * w + b).astype(x.dtype)


def _rms_norm(x, w):
    xf = x.astype(jnp.float32)
    return (xf * lax.rsqrt(jnp.mean(jnp.square(xf), axis=-1, keepdims=True) + QK_EPS) * w).astype(x.dtype)


def _rwkv7_mixer(p, mu, w0, w2, a0, a2, g2, k_k, k_a, r_k, gn_w, gn_b):
    B, S, _ = p.shape
    H, N = RW_HEADS, HEAD_DIM
    prev = jnp.pad(p, ((0, 0), (1, 0), (0, 0)))[:, :-1]
    p = p + mu * (prev - p)
    r, k, v, wd, ad, gd = jnp.split(p, RW_SPLITS, axis=-1)
    w = -jax.nn.softplus(-(w0 + jnp.tanh(wd) @ w2)) - 0.5
    decay = jnp.exp(-jnp.exp(w.astype(jnp.float32)))
    a = jax.nn.sigmoid(a0 + ad @ a2)
    g = jax.nn.sigmoid(gd) @ g2
    kk = (k * k_k).reshape(B, S, H, N).astype(jnp.float32)
    kk = kk / jnp.maximum(jnp.linalg.norm(kk, axis=-1, keepdims=True), 1e-12)
    k = k * (1 + (a - 1) * k_a)
    r_h, k_h, v_h, a_h = (t.reshape(B, S, H, N) for t in (r, k, v, a))
    w_h = decay.reshape(B, S, H, N)

    def to_chunks(t):
        return t.astype(jnp.float32).transpose(1, 0, 2, 3).reshape(S // CHUNK, CHUNK, B, H, N)

    xs = tuple(to_chunks(t) for t in (r_h, w_h, k_h, v_h, -kk, kk * a_h))

    def step(state, inp):
        rt, wt, kt, vt, at, bt = inp
        sa = jnp.einsum('bhvk,bhk->bhv', state, at)
        state = state * wt[:, :, None, :] + sa[..., None] * bt[:, :, None, :] + vt[..., None] * kt[:, :, None, :]
        return state, jnp.einsum('bhvk,bhk->bhv', state, rt)

    def chunk_step(state, chunk):
        return lax.scan(step, state, chunk)

    s0 = jnp.zeros((B, H, N, N), jnp.float32)
    _, ys = lax.scan(chunk_step, s0, xs)
    y = ys.reshape(S, B, H, N).transpose(1, 0, 2, 3)
    ym = jnp.mean(y, axis=-1, keepdims=True)
    yv = jnp.mean(jnp.square(y - ym), axis=-1, keepdims=True)
    yn = ((y - ym) * lax.rsqrt(yv + RW_GN_EPS)).reshape(B, S, RW_WIDTH) * gn_w + gn_b
    bonus = (jnp.sum(r_h * k_h * r_k, axis=-1, keepdims=True) * v_h).reshape(B, S, RW_WIDTH)
    return (yn.astype(p.dtype) + bonus) * g


def _fox_mixer(p, b_f, q_norm, k_norm):
    B, S, _ = p.shape
    H, N = FX_HEADS, HEAD_DIM
    q, k, v, og, fz = jnp.split(p, FX_SPLITS, axis=-1)
    q = _rms_norm(q.reshape(B, S, H, N), q_norm).transpose(0, 2, 1, 3)
    k = _rms_norm(k.reshape(B, S, H, N), k_norm).transpose(0, 2, 1, 3)
    v = v.reshape(B, S, H, N).transpose(0, 2, 1, 3)
    log_f = jax.nn.log_sigmoid(fz.astype(jnp.float32) + b_f.astype(jnp.float32))
    c = jnp.cumsum(log_f, axis=1).transpose(0, 2, 1)
    scale = HEAD_DIM ** -0.5
    outs = []
    for i in range(S // Q_BLOCK):
        q0 = i * Q_BLOCK
        L = q0 + Q_BLOCK
        s = jnp.einsum('bhqd,bhkd->bhqk', q[:, :, q0:L], k[:, :, :L]).astype(jnp.float32) * scale
        s = s + c[:, :, q0:L, None] - c[:, :, None, :L]
        causal = jnp.arange(L)[None, :] <= (q0 + jnp.arange(Q_BLOCK))[:, None]
        s = jnp.where(causal, s, -jnp.inf)
        pr = jax.nn.softmax(s, axis=-1).astype(v.dtype)
        outs.append(jnp.einsum('bhqk,bhkd->bhqd', pr, v[:, :, :L]))
    o = jnp.concatenate(outs, axis=2).transpose(0, 2, 1, 3).reshape(B, S, FX_WIDTH)
    return o * jax.nn.sigmoid(og)


def _moe(h, router_w, router_b, w1, b1, w2, b2):
    B, S, D = h.shape
    T = B * S
    xt = h.reshape(T, D)
    logits = (xt @ router_w + router_b).astype(jnp.float32)
    top_val, top_idx = lax.top_k(logits, TOP_K)
    gates = jax.nn.softmax(top_val, axis=-1)
    e_flat = top_idx.reshape(-1).astype(jnp.int32)
    g_flat = gates.reshape(-1)
    tok_flat = jnp.repeat(jnp.arange(T, dtype=jnp.int32), TOP_K)
    n_assign = T * TOP_K
    n_rows = -(-n_assign // MOE_BLOCK) * MOE_BLOCK + N_EXPERTS * MOE_BLOCK
    n_blocks = n_rows // MOE_BLOCK
    order = jnp.argsort(e_flat, stable=True)
    e_sorted = e_flat[order]
    counts = jnp.bincount(e_flat, length=N_EXPERTS)
    starts = jnp.cumsum(counts) - counts
    padded = (counts + MOE_BLOCK - 1) // MOE_BLOCK * MOE_BLOCK
    pends = jnp.cumsum(padded)
    pstarts = pends - padded
    dest = pstarts[e_sorted] + (jnp.arange(n_assign, dtype=jnp.int32) - starts[e_sorted])
    row_tok = jnp.full((n_rows,), T, jnp.int32).at[dest].set(tok_flat[order])
    row_gate = jnp.zeros((n_rows,), jnp.float32).at[dest].set(g_flat[order])
    block_exp = jnp.minimum(jnp.searchsorted(pends, jnp.arange(n_blocks) * MOE_BLOCK, side='right'),
                            N_EXPERTS - 1).astype(jnp.int32)
    xs = jnp.concatenate([xt, jnp.zeros((1, D), xt.dtype)], axis=0)[row_tok].reshape(n_blocks, MOE_BLOCK, D)

    def expert_block(args):
        xb, e = args
        hid = xb @ w1[e] + b1[e]
        x_glu = jnp.minimum(hid[..., ::2], SWIGLU_LIMIT)
        x_lin = jnp.clip(hid[..., 1::2], -SWIGLU_LIMIT, SWIGLU_LIMIT)
        act = x_glu * jax.nn.sigmoid(SWIGLU_ALPHA * x_glu) * (x_lin + 1)
        return act @ w2[e] + b2[e]

    out = lax.map(expert_block, (xs, block_exp)).reshape(n_rows, D)
    out = out * row_gate[:, None].astype(out.dtype)
    y = jax.ops.segment_sum(out, row_tok, num_segments=T + 1)[:T]
    return y.reshape(B, S, D)


def setup_inputs(seed: int = 0) -> dict:
    key = jax.random.key(seed)
    ks = jax.random.split(key, 32)
    L = DEPTH
    nrm = lambda k, shape, s: jax.random.normal(k, shape, jnp.float32) * s
    uni = lambda k, shape, lo, hi: jax.random.uniform(k, shape, jnp.float32, lo, hi)
    return {
        'x': nrm(ks[0], (BATCH, SEQ, D_MODEL), 1.0),
        'ln_in_w': 1.0 + nrm(ks[1], (D_MODEL,), 0.02),
        'ln_in_b': nrm(ks[2], (D_MODEL,), 0.02),
        'w_in': nrm(ks[3], (L, D_MODEL, IN_COLS), D_MODEL ** -0.5),
        'rw_mu': uni(ks[4], (L, RW_COLS), 0.0, 1.0),
        'rw_w0': uni(ks[5], (L, RW_WIDTH), -6.0, 1.0),
        'rw_w2': nrm(ks[6], (L, RW_DECAY_LORA, RW_WIDTH), 0.1),
        'rw_a0': nrm(ks[7], (L, RW_WIDTH), 0.5),
        'rw_a2': nrm(ks[8], (L, RW_AAA_LORA, RW_WIDTH), 0.1),
        'rw_g2': nrm(ks[9], (L, RW_GATE_LORA, RW_WIDTH), RW_GATE_LORA ** -0.5),
        'rw_k_k': 0.85 + nrm(ks[10], (L, RW_WIDTH), 0.05),
        'rw_k_a': 1.0 + nrm(ks[11], (L, RW_WIDTH), 0.05),
        'rw_r_k': nrm(ks[12], (L, RW_HEADS, HEAD_DIM), 0.1),
        'rw_gn_w': 1.0 + nrm(ks[13], (L, RW_WIDTH), 0.02),
        'rw_gn_b': nrm(ks[14], (L, RW_WIDTH), 0.02),
        'fx_b_f': uni(ks[15], (L, FX_HEADS), 1.0, 5.0),
        'fx_q_norm': 1.0 + nrm(ks[16], (L, HEAD_DIM), 0.02),
        'fx_k_norm': 1.0 + nrm(ks[17], (L, HEAD_DIM), 0.02),
        'w_o': nrm(ks[18], (L, MIX_WIDTH, D_MODEL), MIX_WIDTH ** -0.5 * DEEPNORM_BETA),
        'ln1_w': 1.0 + nrm(ks[19], (L, D_MODEL), 0.02),
        'ln1_b': nrm(ks[20], (L, D_MODEL), 0.02),
        'router_w': nrm(ks[21], (L, D_MODEL, N_EXPERTS), D_MODEL ** -0.5),
        'router_b': nrm(ks[22], (L, N_EXPERTS), 0.01),
        'exp_w1': nrm(ks[23], (L, N_EXPERTS, D_MODEL, 2 * EXPERT_FF), D_MODEL ** -0.5),
        'exp_b1': nrm(ks[24], (L, N_EXPERTS, 2 * EXPERT_FF), 0.01),
        'exp_w2': nrm(ks[25], (L, N_EXPERTS, EXPERT_FF, D_MODEL), EXPERT_FF ** -0.5 * DEEPNORM_BETA),
        'exp_b2': nrm(ks[26], (L, N_EXPERTS, D_MODEL), 0.01),
        'ln2_w': 1.0 + nrm(ks[27], (L, D_MODEL), 0.02),
        'ln2_b': nrm(ks[28], (L, D_MODEL), 0.02),
    }


def reference(x, ln_in_w, ln_in_b, w_in, rw_mu, rw_w0, rw_w2, rw_a0, rw_a2, rw_g2, rw_k_k, rw_k_a,
              rw_r_k, rw_gn_w, rw_gn_b, fx_b_f, fx_q_norm, fx_k_norm, w_o, ln1_w, ln1_b,
              router_w, router_b, exp_w1, exp_b1, exp_w2, exp_b2, ln2_w, ln2_b):
    h = _layer_norm(x, ln_in_w, ln_in_b)
    for l in range(DEPTH):
        proj = h @ w_in[l]
        p_rw, p_fx = proj[..., :RW_COLS], proj[..., RW_COLS:]
        y_rw = _rwkv7_mixer(p_rw, rw_mu[l], rw_w0[l], rw_w2[l], rw_a0[l], rw_a2[l], rw_g2[l],
                            rw_k_k[l], rw_k_a[l], rw_r_k[l], rw_gn_w[l], rw_gn_b[l])
        y_fx = _fox_mixer(p_fx, fx_b_f[l], fx_q_norm[l], fx_k_norm[l])
        mix = jnp.concatenate([y_rw, y_fx], axis=-1) @ w_o[l]
        h = _layer_norm(DEEPNORM_ALPHA * h + mix, ln1_w[l], ln1_b[l])
        ffn = _moe(h, router_w[l], router_b[l], exp_w1[l], exp_b1[l], exp_w2[l], exp_b2[l])
        h = _layer_norm(DEEPNORM_ALPHA * h + ffn, ln2_w[l], ln2_b[l])
    return h
```

```cpp
#include <hip/hip_runtime.h>
#include <hip/hip_bf16.h>
#include <cstdio>
#include <cstdint>
#include <cmath>

namespace pg8 {
#define PG8_LAS __attribute__((address_space(3)))
typedef unsigned short bf16_t;
typedef short bf16x8 __attribute__((ext_vector_type(8)));
typedef float f32x4 __attribute__((ext_vector_type(4)));
typedef unsigned u32x4 __attribute__((ext_vector_type(4)));
typedef unsigned u32x2 __attribute__((ext_vector_type(2)));
constexpr int BM = 256, BK = 64, HALF = 128, HTB = HALF * BK * 2  , STAGE_BYTES = 8 * HTB, NXCD = 8, WGM = 8;

__host__ __device__ __forceinline__ int lds_byte(int r, int c) { const int st = (r >> 4) * 2 + (c >> 5), rr = r & 15, cc = c & 31, ob = rr * 64 + cc * 2; return st * 1024 + (ob ^ (((ob >> 9) & 1) << 5)); }
__host__ __device__ __forceinline__ void stage_rc(int b, int& R, int& C) { const int st = b / 1024, sb = b % 1024, swz = sb ^ (((sb >> 9) & 1) << 5); R = (st >> 1) * 16 + swz / 64; C = (st & 1) * 32 + (swz % 64) / 2; }
__host__ __device__ __forceinline__ int perm32(int rho) { const int n = rho >> 4, i = rho & 15; return 8 * (i >> 2) + 4 * n + (i & 3); }

struct Unit { int pm, pn, pb, pe; };
struct Gemm { const bf16_t* A; const bf16_t* Bt; int M, N, K; };

struct StaticOrder {
    int nM, nN, nwg, G, c;
    __host__ __device__ void init(int M, int N, int G_, int c_) { nM = M / BM; nN = N / BM; nwg = nM * nN; G = G_; c = c_; }
    __host__ __device__ bool next(int i, Unit& u) const {
        const long L = (long)i * G + c; if (L >= nwg) return false;
        int wgid = (int)L; { const int q = nwg / NXCD, r = nwg % NXCD, xcd = wgid % NXCD, off = wgid / NXCD; wgid = (xcd < r ? xcd * (q + 1) : r * (q + 1) + (xcd - r) * q) + off; }
        const int nig = WGM * nN, gid = wgid / nig, fm = gid * WGM, gsz = (nM - fm) < WGM ? (nM - fm) : WGM;
        u.pm = fm + ((wgid % nig) % gsz); u.pn = (wgid % nig) / gsz; u.pb = u.pn; u.pe = 0; return true;
    }
};
struct MoeOrder {
    const PG8_LAS unsigned char* texp; int ntiles, nN, G, c;
    __device__ __forceinline__ bool next(int i, Unit& u) const {
        const int L = i * G + c; if (L >= ntiles * nN) return false;
        const int rt = L / nN, pn = L - rt * nN; const int e = texp[rt];
        u.pm = rt; u.pn = pn; u.pb = e * nN + pn; u.pe = e; return true;
    }
};

__device__ __forceinline__ unsigned cvt_pk_bf16(float lo, float hi) { unsigned r; asm volatile("v_cvt_pk_bf16_f32 %0, %1, %2" : "=v"(r) : "v"(lo), "v"(hi)); return r; }

struct EpiF32 {
    static constexpr bool PERM = false;
    float* O; int ldc;
    __device__ __forceinline__ void operator()(const f32x4 (&acc)[2][2][4][2], const Unit& u, int wr, int wc, int fr, int fq) const {
        const int row0 = u.pm * BM + wr * 64 + fr, col0 = u.pn * BM + wc * 32 + 4 * fq;
#pragma unroll
        for (int ai = 0; ai < 2; ++ai)
#pragma unroll
            for (int m = 0; m < 4; ++m) { float* rowp = O + (size_t)(row0 + ai * HALF + m * 16) * ldc + col0;
#pragma unroll
                for (int bj = 0; bj < 2; ++bj)
#pragma unroll
                    for (int n = 0; n < 2; ++n) *(f32x4*)(rowp + bj * HALF + n * 16) = acc[ai][bj][m][n]; }
    }
};
struct EpiResid {
    static constexpr bool PERM = false;
    float* O; int ldc; float alpha;
    __device__ __forceinline__ void operator()(const f32x4 (&acc)[2][2][4][2], const Unit& u, int wr, int wc, int fr, int fq) const {
        const int row0 = u.pm * BM + wr * 64 + fr, col0 = u.pn * BM + wc * 32 + 4 * fq;
#pragma unroll
        for (int ai = 0; ai < 2; ++ai)
#pragma unroll
            for (int m = 0; m < 4; ++m) { float* rowp = O + (size_t)(row0 + ai * HALF + m * 16) * ldc + col0;
#pragma unroll
                for (int bj = 0; bj < 2; ++bj)
#pragma unroll
                    for (int n = 0; n < 2; ++n) { f32x4* p = (f32x4*)(rowp + bj * HALF + n * 16); const f32x4 o = *p; *p = o * alpha + acc[ai][bj][m][n]; } }
    }
};
__device__ __forceinline__ float swiglu1(float g, float l) {
    g = fminf(g, 7.0f); l = fminf(fmaxf(l, -7.0f), 7.0f);
    const float s = __builtin_amdgcn_rcpf(1.0f + __builtin_amdgcn_exp2f(-1.702f * 1.4426950408889634f * g));
    return g * s * (l + 1.0f);
}
struct EpiSwiglu {
    static constexpr bool PERM = true;
    bf16_t* O; int ldc; const float* b1;
    __device__ __forceinline__ void operator()(const f32x4 (&acc)[2][2][4][2], const Unit& u, int wr, int wc, int fr, int fq) const {
        const int row0 = u.pm * BM + wr * 64 + fr; const int cl0 = u.pn * BM + wc * 32 + 8 * fq;
        const float* bp = b1 + (size_t)u.pe * 2048 + cl0;
        f32x4 bv[2][2];
#pragma unroll
        for (int bj = 0; bj < 2; ++bj)
#pragma unroll
            for (int n = 0; n < 2; ++n) bv[bj][n] = *(const f32x4*)(bp + bj * HALF + 4 * n);
#pragma unroll
        for (int ai = 0; ai < 2; ++ai)
#pragma unroll
            for (int m = 0; m < 4; ++m) { bf16_t* rowp = O + (size_t)(row0 + ai * HALF + m * 16) * ldc + (cl0 >> 1);
#pragma unroll
                for (int bj = 0; bj < 2; ++bj) { const f32x4 v0 = acc[ai][bj][m][0] + bv[bj][0], v1 = acc[ai][bj][m][1] + bv[bj][1];
                    u32x2 w; w.x = cvt_pk_bf16(swiglu1(v0[0], v0[1]), swiglu1(v0[2], v0[3])); w.y = cvt_pk_bf16(swiglu1(v1[0], v1[1]), swiglu1(v1[2], v1[3]));
                    *(u32x2*)(rowp + bj * (HALF / 2)) = w; } }
    }
};
struct EpiGate {
    static constexpr bool PERM = true;
    bf16_t* O; int ldc; const float* b2; const float* gate;
    __device__ __forceinline__ void operator()(const f32x4 (&acc)[2][2][4][2], const Unit& u, int wr, int wc, int fr, int fq) const {
        const int row0 = u.pm * BM + wr * 64 + fr; const int col0 = u.pn * BM + wc * 32 + 8 * fq;
        const float* bp = b2 + (size_t)u.pe * 1024 + col0;
        f32x4 bv[2][2];
#pragma unroll
        for (int bj = 0; bj < 2; ++bj)
#pragma unroll
            for (int n = 0; n < 2; ++n) bv[bj][n] = *(const f32x4*)(bp + bj * HALF + 4 * n);
#pragma unroll
        for (int ai = 0; ai < 2; ++ai)
#pragma unroll
            for (int m = 0; m < 4; ++m) { const int row = row0 + ai * HALF + m * 16; const float gt = gate[row]; bf16_t* rowp = O + (size_t)row * ldc + col0;
#pragma unroll
                for (int bj = 0; bj < 2; ++bj) { const f32x4 v0 = (acc[ai][bj][m][0] + bv[bj][0]) * gt, v1 = (acc[ai][bj][m][1] + bv[bj][1]) * gt;
                    u32x4 w; w.x = cvt_pk_bf16(v0[0], v0[1]); w.y = cvt_pk_bf16(v0[2], v0[3]); w.z = cvt_pk_bf16(v1[0], v1[1]); w.w = cvt_pk_bf16(v1[2], v1[3]);
                    *(u32x4*)(rowp + bj * HALF) = w; } }
    }
};
template <class Epi, class Sched, bool ALIGN_EPI = false, bool SP2 = false>
__device__ __forceinline__ void gemm_phase(PG8_LAS unsigned char* lds, const Gemm g, const Sched& S, const Epi& E) {
    const int tid = threadIdx.x, wid = __builtin_amdgcn_readfirstlane(tid >> 6), lane = tid & 63, wr = wid >> 2, wc = wid & 3, fr = lane & 15, fq = lane >> 4;
    const int K = g.K, nt = K / BK;
    unsigned voffA[2], voffB[2];
#pragma unroll
    for (int i = 0; i < 2; ++i) { int R, C; stage_rc(tid * 16 + i * 8192, R, C); const int Rb = Epi::PERM ? ((R & ~31) + perm32(R & 31)) : R;
        voffA[i] = (unsigned)(R * K + C) * 2u; voffB[i] = (unsigned)(Rb * K + C) * 2u; }
    const size_t kstep = (size_t)(BK * 2);
    const size_t hstep = (size_t)HALF * K * 2;
    const size_t tstep = 2 * hstep;
    const unsigned ldsw = (unsigned)wid * 1024u;
    const int aoff = lds_byte(wr * 64 + fr, fq * 8), boff = lds_byte(wc * 32 + fr, fq * 8);
#define PG8_SA(b, h) (((b) * 2 + (h)) * HTB)
#define PG8_SB(b, h) ((4 + (b) * 2 + (h)) * HTB)
#define PG8_STAGE(bufoff, gbase, voff) do { _Pragma("unroll") for (int _i = 0; _i < 2; ++_i) \
        __builtin_amdgcn_global_load_lds((const unsigned*)((const char*)(gbase) + (voff)[_i]), (PG8_LAS unsigned*)(lds + (bufoff) + ldsw + _i * 8192), 16, 0, 0); } while (0)
#define PG8_LDA(dst, b, h) do { _Pragma("unroll") for (int m = 0; m < 4; ++m) _Pragma("unroll") for (int k = 0; k < 2; ++k) dst[m][k] = *(const PG8_LAS bf16x8*)(lds + PG8_SA(b, h) + aoff + m * 2048 + k * 1024); } while (0)
#define PG8_LDB(dst, b, h) do { _Pragma("unroll") for (int n = 0; n < 2; ++n) _Pragma("unroll") for (int k = 0; k < 2; ++k) dst[n][k] = *(const PG8_LAS bf16x8*)(lds + PG8_SB(b, h) + boff + n * 2048 + k * 1024); } while (0)
#define PG8_MMA(ai, bj, At, Bt) do { __builtin_amdgcn_s_setprio(1); _Pragma("unroll") for (int m = 0; m < 4; ++m) _Pragma("unroll") for (int n = 0; n < 2; ++n) _Pragma("unroll") for (int k = 0; k < 2; ++k) \
        acc[ai][bj][m][n] = __builtin_amdgcn_mfma_f32_16x16x32_bf16(Bt[n][k], At[m][k], acc[ai][bj][m][n], 0, 0, 0); __builtin_amdgcn_s_setprio(0); } while (0)
#define PG8_WAIT_V(n) asm volatile("s_waitcnt vmcnt(" #n ")" ::: "memory")
#define PG8_WAIT_L(n) asm volatile("s_waitcnt lgkmcnt(" #n ")" ::: "memory")
#define PG8_BAR __builtin_amdgcn_s_barrier()
#define PG8_SCHED __builtin_amdgcn_sched_barrier(0)
    Unit cur, nxt; int ui = 0;
    if (!S.next(0, cur)) return;
    f32x4 acc[2][2][4][2];
#pragma unroll
    for (int a = 0; a < 2; ++a)
#pragma unroll
        for (int b = 0; b < 2; ++b)
#pragma unroll
            for (int m = 0; m < 4; ++m)
#pragma unroll
                for (int n = 0; n < 2; ++n) acc[a][b][m][n] = (f32x4){0.f, 0.f, 0.f, 0.f};
    bf16x8 At[4][2], B0[2][2], B1[2][2];
    const char* cA = (const char*)g.A + (size_t)cur.pm * tstep; const char* cB = (const char*)g.Bt + (size_t)cur.pb * tstep;
    if constexpr (SP2) {
        PG8_STAGE(PG8_SB(0, 0), cB, voffB); PG8_STAGE(PG8_SB(0, 1), cB + hstep, voffB); PG8_STAGE(PG8_SA(0, 0), cA, voffA); PG8_STAGE(PG8_SA(0, 1), cA + hstep, voffA);
        if (wr == 1) PG8_BAR;
        PG8_WAIT_V(2); PG8_BAR;
        PG8_STAGE(PG8_SB(1, 0), cB + kstep, voffB); PG8_STAGE(PG8_SA(1, 0), cA + kstep, voffA); PG8_STAGE(PG8_SB(1, 1), cB + hstep + kstep, voffB);
        PG8_WAIT_V(6); PG8_BAR;
    } else {
        PG8_STAGE(PG8_SB(0, 0), cB, voffB); PG8_STAGE(PG8_SA(0, 0), cA, voffA); PG8_STAGE(PG8_SB(0, 1), cB + hstep, voffB); PG8_STAGE(PG8_SA(0, 1), cA + hstep, voffA);
        if (wr == 1) PG8_BAR;
        PG8_WAIT_V(4); PG8_BAR;
        PG8_STAGE(PG8_SB(1, 0), cB + kstep, voffB); PG8_STAGE(PG8_SA(1, 0), cA + kstep, voffA); PG8_STAGE(PG8_SB(1, 1), cB + hstep + kstep, voffB);
        PG8_WAIT_V(6); PG8_BAR;
    }
    for (;;) {
        const bool has_next = S.next(ui + 1, nxt);
        const char* nA = has_next ? (const char*)g.A + (size_t)nxt.pm * tstep : cA; const char* nB = has_next ? (const char*)g.Bt + (size_t)nxt.pb * tstep : cB;
        for (int t = 0; t < nt; t += 2) {
            const bool last = (t == nt - 2);
            const char* a1 = cA + (size_t)(t + 1) * kstep;
            const char* a2 = last ? nA : cA + (size_t)(t + 2) * kstep; const char* b2 = last ? nB : cB + (size_t)(t + 2) * kstep;
            const char* a3 = a2 + kstep; const char* b3 = b2 + kstep;

            if constexpr (SP2) {
            PG8_LDB(B0, 0, 0); PG8_LDB(B1, 0, 1); PG8_SCHED; PG8_LDA(At, 0, 0); PG8_STAGE(PG8_SA(1, 1), a1 + hstep, voffA);
            PG8_WAIT_V(8); PG8_WAIT_L(0); PG8_BAR; PG8_MMA(0, 0, At, B0); PG8_MMA(0, 1, At, B1); PG8_BAR; PG8_SCHED;
            PG8_LDA(At, 0, 1); PG8_STAGE(PG8_SB(0, 0), b2, voffB); PG8_STAGE(PG8_SB(0, 1), b2 + hstep, voffB); PG8_STAGE(PG8_SA(0, 0), a2, voffA);
            PG8_WAIT_V(8); PG8_WAIT_L(0); PG8_BAR; PG8_MMA(1, 0, At, B0); PG8_MMA(1, 1, At, B1); PG8_BAR; PG8_SCHED;
            PG8_LDB(B0, 1, 0); PG8_LDB(B1, 1, 1); PG8_SCHED; PG8_LDA(At, 1, 0); PG8_STAGE(PG8_SA(0, 1), a2 + hstep, voffA);
            PG8_WAIT_V(8); PG8_WAIT_L(0); PG8_BAR; PG8_MMA(0, 0, At, B0); PG8_MMA(0, 1, At, B1); PG8_BAR; PG8_SCHED;
            PG8_LDA(At, 1, 1); PG8_STAGE(PG8_SB(1, 0), b3, voffB); PG8_STAGE(PG8_SB(1, 1), b3 + hstep, voffB); PG8_STAGE(PG8_SA(1, 0), a3, voffA);
            PG8_WAIT_V(8); PG8_WAIT_L(0); PG8_BAR; PG8_MMA(1, 0, At, B0); PG8_MMA(1, 1, At, B1); PG8_BAR; PG8_SCHED;
            } else {
            PG8_LDB(B0, 0, 0); PG8_SCHED; PG8_LDA(At, 0, 0); PG8_STAGE(PG8_SA(1, 1), a1 + hstep, voffA);
            PG8_WAIT_L(8); PG8_BAR; PG8_WAIT_L(0); PG8_MMA(0, 0, At, B0); PG8_BAR; PG8_SCHED;
            PG8_LDB(B1, 0, 1); PG8_STAGE(PG8_SB(0, 0), b2, voffB);
            PG8_BAR; PG8_WAIT_L(0); PG8_MMA(0, 1, At, B1); PG8_BAR;
            PG8_LDA(At, 0, 1); PG8_STAGE(PG8_SA(0, 0), a2, voffA);
            PG8_BAR; PG8_WAIT_L(0); PG8_MMA(1, 0, At, B0); PG8_BAR; PG8_SCHED;
            PG8_STAGE(PG8_SB(0, 1), b2 + hstep, voffB);
            PG8_WAIT_V(6); PG8_BAR; PG8_MMA(1, 1, At, B1); PG8_BAR;
            PG8_LDB(B0, 1, 0); PG8_SCHED; PG8_LDA(At, 1, 0); PG8_STAGE(PG8_SA(0, 1), a2 + hstep, voffA);
            PG8_WAIT_L(8); PG8_BAR; PG8_WAIT_L(0); PG8_MMA(0, 0, At, B0); PG8_BAR; PG8_SCHED;
            PG8_LDB(B1, 1, 1); PG8_STAGE(PG8_SB(1, 0), b3, voffB);
            PG8_BAR; PG8_WAIT_L(0); PG8_MMA(0, 1, At, B1); PG8_BAR;
            PG8_LDA(At, 1, 1); PG8_STAGE(PG8_SA(1, 0), a3, voffA);
            PG8_BAR; PG8_WAIT_L(0); PG8_MMA(1, 0, At, B0); PG8_BAR; PG8_SCHED;
            PG8_STAGE(PG8_SB(1, 1), b3 + hstep, voffB);
            PG8_WAIT_V(6); PG8_BAR; PG8_MMA(1, 1, At, B1); PG8_BAR;
            }
        }
        if constexpr (ALIGN_EPI) { if (wr == 0) PG8_BAR; }
        E(acc, cur, wr, wc, fr, fq);
        if (!has_next) break;
#pragma unroll
        for (int a = 0; a < 2; ++a)
#pragma unroll
            for (int b = 0; b < 2; ++b)
#pragma unroll
                for (int m = 0; m < 4; ++m)
#pragma unroll
                    for (int n = 0; n < 2; ++n) acc[a][b][m][n] = (f32x4){0.f, 0.f, 0.f, 0.f};
        cur = nxt; cA = nA; cB = nB; ++ui;
        if constexpr (ALIGN_EPI) { if (wr == 1) PG8_BAR; }
    }
    PG8_WAIT_V(0);
    if constexpr (!ALIGN_EPI) { if (wr == 0) PG8_BAR; }
    PG8_BAR;
#undef PG8_SA
#undef PG8_SB
#undef PG8_STAGE
#undef PG8_LDA
#undef PG8_LDB
#undef PG8_MMA
#undef PG8_WAIT_V
#undef PG8_WAIT_L
#undef PG8_BAR
#undef PG8_SCHED
}
}
namespace attn_body {
using bf16=__hip_bfloat16;
using bf16x8=__attribute__((ext_vector_type(8)))short;
using s16x4=__attribute__((ext_vector_type(4)))short;
using f32x16=__attribute__((ext_vector_type(16)))float;
using u32x4=__attribute__((ext_vector_type(4)))unsigned;
using f32x4=__attribute__((ext_vector_type(4)))float;
constexpr int BATCH=4,NHEAD=8,SEQ=4096,D=64,DM=NHEAD*D;
constexpr int OPITCH=1024;
constexpr int PROJ_PITCH=3840, OG_COL=3232;
constexpr int NW=8,QBLK=32,QB=QBLK*NW,KVBLK=64,NQB=SEQ/QB;
constexpr int ATTN_PITCH=DM, ATTN_UNIT_ROWS=QB;
__device__ __forceinline__ int crow(int r,int hi){return (r&3)+8*(r>>2)+4*hi;}
#define SBAR() __builtin_amdgcn_sched_barrier(0)
__device__ __forceinline__ void cmask(f32x16&p0,f32x16&p1,int jb,int qrel,int hi){
  const float NEG=-INFINITY; int kb=64*jb+4*hi;
  #pragma unroll
  for(int r=0;r<16;++r){int kv=kb+(r&3)+8*(r>>2); if(kv>qrel)p0[r]=NEG; if(kv+32>qrel)p1[r]=NEG;}
}

constexpr int NSLOT=3, SLOTB=8192;
constexpr int LDS_K=0, LDS_V=NSLOT*SLOTB, LDS_WS=2*NSLOT*SLOTB, LDS_OST=LDS_WS+NW*64*4, LDS_BIAS=LDS_OST+NW*4096, LDS_SCAN=LDS_BIAS+SEQ*4, LDS_BYTES=LDS_SCAN+64;
constexpr float C2=0.125f*1.4426950408889634f;
__device__ __forceinline__ void glds16(const void*gsrc,unsigned lds_dst){unsigned keep;
  asm volatile("s_mov_b32 %0, m0\n\ts_mov_b32 m0, %2\n\ts_nop 0\n\tglobal_load_lds_dwordx4 %1, off\n\ts_mov_b32 m0, %0":"=&s"(keep):"v"(gsrc),"s"(lds_dst):"memory");}
__device__ __forceinline__ float max3f(float a,float b,float c){float r;asm("v_max3_f32 %0, %1, %2, %3":"=v"(r):"v"(a),"v"(b),"v"(c));return r;}
__device__ __forceinline__ float max2f(float a,float b){float r;asm("v_max_f32_e32 %0, %1, %2":"=v"(r):"v"(a),"v"(b));return r;}
__device__ __forceinline__ float fadd_s(float a,float b){float r;asm("v_add_f32_e32 %0, %1, %2":"=v"(r):"v"(a),"v"(b));return r;}
__device__ __forceinline__ float fsub_s(float a,float b){float r;asm("v_sub_f32_e32 %0, %1, %2":"=v"(r):"v"(a),"v"(b));return r;}
typedef float f32x2_t __attribute__((ext_vector_type(2))); typedef __bf16 bf16x2_t __attribute__((ext_vector_type(2)));
__device__ __forceinline__ unsigned cvtpk_s(float lo,float hi){f32x2_t v={lo,hi};bf16x2_t b=__builtin_convertvector(v,bf16x2_t);return __builtin_bit_cast(unsigned,b);}
#define WAIT_BAR(N) asm volatile("s_waitcnt vmcnt(" #N ") lgkmcnt(0)\n\ts_barrier":::"memory")

__device__ __forceinline__ void qkt(f32x16&p0,f32x16&p1,const char*Kslot,const bf16x8*qr,const f32x16&c0i,const f32x16&c1i,int r32,int hi){
  const char*kb=Kslot+hi*1024+r32*16;
  #pragma unroll
  for(int d0=0;d0<4;++d0){
    const bf16x8 b0=*reinterpret_cast<const bf16x8*>(kb+d0*2048);
    const bf16x8 b1=*reinterpret_cast<const bf16x8*>(kb+d0*2048+512);
    if(d0==0){p0=__builtin_amdgcn_mfma_f32_32x32x16_bf16(b0,qr[0],c0i,0,0,0);p1=__builtin_amdgcn_mfma_f32_32x32x16_bf16(b1,qr[0],c1i,0,0,0);}
    else{p0=__builtin_amdgcn_mfma_f32_32x32x16_bf16(b0,qr[d0],p0,0,0,0);p1=__builtin_amdgcn_mfma_f32_32x32x16_bf16(b1,qr[d0],p1,0,0,0);}}
}
typedef __attribute__((address_space(3))) const char* lds_cptr;
typedef short v4i16_t __attribute__((ext_vector_type(4)));
__device__ __forceinline__ void kload8(bf16x8*kf,lds_cptr kp){
  kf[0]=*(const __attribute__((address_space(3))) bf16x8*)(kp);      kf[1]=*(const __attribute__((address_space(3))) bf16x8*)(kp+512);
  kf[2]=*(const __attribute__((address_space(3))) bf16x8*)(kp+2048); kf[3]=*(const __attribute__((address_space(3))) bf16x8*)(kp+2560);
  kf[4]=*(const __attribute__((address_space(3))) bf16x8*)(kp+4096); kf[5]=*(const __attribute__((address_space(3))) bf16x8*)(kp+4608);
  kf[6]=*(const __attribute__((address_space(3))) bf16x8*)(kp+6144); kf[7]=*(const __attribute__((address_space(3))) bf16x8*)(kp+6656);
}
__device__ __forceinline__ void kload2(bf16x8*kf,lds_cptr kp,int j){ kf[2*j]=*(const __attribute__((address_space(3))) bf16x8*)(kp+j*2048); kf[2*j+1]=*(const __attribute__((address_space(3))) bf16x8*)(kp+j*2048+512); }
__device__ __forceinline__ s16x4 vtr(lds_cptr p){ return __builtin_bit_cast(s16x4,__builtin_amdgcn_ds_read_tr16_b64_v4i16((__attribute__((address_space(3))) v4i16_t*)p)); }
__device__ __forceinline__ float rowmax(const f32x16&p0,const f32x16&p1){
  float a=max3f(p0[0],p0[1],p1[0]),b=max3f(p0[2],p0[3],p1[1]);a=max3f(a,p1[2],p1[3]);
  #pragma unroll
  for(int r=4;r<16;r+=4){a=max3f(a,p0[r],p0[r+1]);b=max3f(b,p0[r+2],p0[r+3]);a=max3f(a,p1[r],p1[r+1]);b=max3f(b,p1[r+2],p1[r+3]);}
  const float m=max2f(a,b);
  auto rr=__builtin_amdgcn_permlane32_swap(__float_as_uint(m),__float_as_uint(m),false,false);
  return max2f(__uint_as_float(rr[0]),__uint_as_float(rr[1]));
}
__device__ __forceinline__ void pv(f32x16*o,int vb,bf16x8 pa0,bf16x8 pa1,bf16x8 pa2,bf16x8 pa3){
  #pragma unroll
  for(int d0=0;d0<2;++d0){s16x4 lo[4],hi[4];
    #pragma unroll
    for(int ks=0;ks<4;++ks){
      asm volatile("ds_read_b64_tr_b16 %0,%1 offset:%c2":"=&v"(lo[ks]):"v"(vb),"i"(d0*4096+ks*1024):"memory");
      asm volatile("ds_read_b64_tr_b16 %0,%1 offset:%c2":"=&v"(hi[ks]):"v"(vb),"i"(d0*4096+ks*1024+512):"memory");}
    asm volatile("s_waitcnt lgkmcnt(0)":::"memory");SBAR();
    #define PK(k) (bf16x8){lo[k][0],lo[k][1],lo[k][2],lo[k][3],hi[k][0],hi[k][1],hi[k][2],hi[k][3]}
    o[d0]=__builtin_amdgcn_mfma_f32_32x32x16_bf16(pa0,PK(0),o[d0],0,0,0);
    o[d0]=__builtin_amdgcn_mfma_f32_32x32x16_bf16(pa1,PK(1),o[d0],0,0,0);
    o[d0]=__builtin_amdgcn_mfma_f32_32x32x16_bf16(pa2,PK(2),o[d0],0,0,0);
    o[d0]=__builtin_amdgcn_mfma_f32_32x32x16_bf16(pa3,PK(3),o[d0],0,0,0);
    #undef PK
  }
}

#ifndef ATTN_STORE16
#define ATTN_STORE16(p,v) (*(u32x4*)(p)=(v))
#endif
template<int THRL> __device__ __forceinline__ void attn_unit(int b,int h,int qb,const bf16*Q,const bf16*__restrict__ K,const bf16*__restrict__ V,bf16*O,const float*__restrict__ logf,const float*__restrict__ proj,char*shm){
  const int tid=threadIdx.x,lane=tid&63,r32=lane&31,hi=lane>>5; const int wid=__builtin_amdgcn_readfirstlane(tid>>6);
  const long rowbase=(long)b*SEQ; const int q0=qb*QB;
  const bf16*Qw=Q+(rowbase+q0+wid*QBLK)*DM+h*D;
  const bf16*Kh=K+rowbase*DM+h*D,*Vh=V+rowbase*DM+h*D;
  const unsigned lds0=(unsigned)(uintptr_t)shm;
  float*wsf=(float*)(shm+LDS_WS)+wid*64;
  const bf16*ksrc=Kh+(long)lane*DM+wid*8;
  const bf16*vsrc=Vh+(long)(16*(wid&3)+(lane>>2))*DM+(wid>>2)*32+(lane&3)*8;
  const unsigned kdst=lds0+LDS_K+wid*1024, vdst=lds0+LDS_V+wid*1024;
  #define DMA_K(t,slot) glds16(ksrc+(long)(t)*KVBLK*DM,(unsigned)__builtin_amdgcn_readfirstlane(kdst+(slot)))
  #define DMA_V(t,slot) glds16(vsrc+(long)(t)*KVBLK*DM,(unsigned)__builtin_amdgcn_readfirstlane(vdst+(slot)))
  const int vb0=(int)(lds0+LDS_V)+((lane>>4)&1)*32+(lane&3)*8+(4*hi+((lane&15)>>2))*64;
  const char*Kbase=shm+LDS_K; bf16x8 kf[8];
  const lds_cptr shm3=(lds_cptr)shm; const lds_cptr kp0=shm3+LDS_K+hi*1024+r32*16; const lds_cptr vp0=shm3+LDS_V+((lane>>4)&1)*32+(lane&3)*8+(4*hi+((lane&15)>>2))*64;
  const int NT=(q0+QB)/KVBLK;
  { float*biasL=(float*)(shm+LDS_BIAS); float*scanL=(float*)(shm+LDS_SCAN);
    const int nk=q0+QB,i0=tid*8; const float*lf=logf+((long)(b*NHEAD+h))*SEQ;
    float v8[8]; float run=0.f;
    if(i0<nk){ const f32x4 a_=*(const f32x4*)(lf+i0),c_=*(const f32x4*)(lf+i0+4);
      v8[0]=a_[0];v8[1]=v8[0]+a_[1];v8[2]=v8[1]+a_[2];v8[3]=v8[2]+a_[3];v8[4]=v8[3]+c_[0];v8[5]=v8[4]+c_[1];v8[6]=v8[5]+c_[2];v8[7]=v8[6]+c_[3];run=v8[7]; }
    else{ _Pragma("unroll") for(int i=0;i<8;++i)v8[i]=0.f; }
    float inc=run;
    _Pragma("unroll") for(int o_=1;o_<64;o_<<=1){ const float t_=__shfl_up(inc,o_); if(lane>=o_)inc+=t_; }
    if(lane==63)scanL[wid]=inc;
    __syncthreads();
    float base=inc-run; for(int w_=0;w_<wid;++w_)base+=scanL[w_];
    if(i0<nk){ const float L2E=-1.4426950408889634f;
      *(f32x4*)(biasL+i0)=(f32x4){(base+v8[0])*L2E,(base+v8[1])*L2E,(base+v8[2])*L2E,(base+v8[3])*L2E};
      *(f32x4*)(biasL+i0+4)=(f32x4){(base+v8[4])*L2E,(base+v8[5])*L2E,(base+v8[6])*L2E,(base+v8[7])*L2E}; }
    __syncthreads(); }
  #define BIASC(C0,C1,t,ng) do{ const __attribute__((address_space(3))) f32x4*bq_=(const __attribute__((address_space(3))) f32x4*)(shm3+LDS_BIAS+(t)*256+hi*16); \
    _Pragma("unroll") for(int g_=0;g_<4;++g_){ const f32x4 x0_=bq_[2*g_],x1_=bq_[8+2*g_]; \
      _Pragma("unroll") for(int i_=0;i_<4;++i_){ C0[4*g_+i_]=x0_[i_]+(ng); C1[4*g_+i_]=x1_[i_]+(ng); } } }while(0)
  DMA_K(0,0);DMA_V(0,0);DMA_K(1,SLOTB);
  bf16x8 qr[4];
  #pragma unroll
  for(int d0=0;d0<4;++d0)qr[d0]=*reinterpret_cast<const bf16x8*>(&Qw[(long)r32*DM+d0*16+hi*8]);
  float mhat=0.f,l_reg=0.f;f32x16 o[2];o[0]=f32x16{};o[1]=f32x16{};float negm_s=0.f;
  const int qrel=wid*QBLK+r32;
  #define CMASK(P0,P1,t) do{int jb_=(t)-(NT-4); if(jb_>=0)cmask(P0,P1,jb_,qrel,hi);}while(0)
  bool resc=false;
  #define START(P0,P1) do{ const float rm=rowmax(P0,P1); resc=false; \
    { const float dl=rm; mhat=fadd_s(mhat,dl); \
      _Pragma("unroll") for(int r=0;r<16;++r){P0[r]=fsub_s(P0[r],dl);P1[r]=fsub_s(P1[r],dl);} \
      negm_s=-mhat; } \
    _Pragma("unroll") for(int r=0;r<16;++r)P0[r]=__builtin_amdgcn_exp2f(P0[r]); }while(0)
  #define RESC() do{ if(resc){ asm volatile("s_waitcnt lgkmcnt(0)":::"memory"); \
      _Pragma("unroll") for(int d_=0;d_<2;++d_) _Pragma("unroll") for(int r=0;r<16;++r)o[d_][r]*=wsf[crow(r,hi)]; } }while(0)
  f32x16 pA0,pA1,pB0,pB1;
  int sl_prev=0,sl_cur=0,sl_next=SLOTB;
  #define ROT() do{sl_prev=sl_cur;sl_cur=sl_next;sl_next=(sl_next==(NSLOT-1)*SLOTB)?0:sl_next+SLOTB;}while(0)
  DMA_K(2,2*SLOTB);
  WAIT_BAR(3);
  { f32x16 c0i_,c1i_; BIASC(c0i_,c1i_,0,0.f); qkt(pA0,pA1,Kbase,qr,c0i_,c1i_,r32,hi); }asm volatile("s_nop 15\n\ts_nop 7":"+v"(pA0),"+v"(pA1));CMASK(pA0,pA1,0);
  START(pA0,pA1);
  _Pragma("unroll") for(int r=0;r<16;++r)pA1[r]=__builtin_amdgcn_exp2f(pA1[r]);
  WAIT_BAR(0);
  DMA_K(3,0);DMA_V(1,SLOTB);
  ROT();
  kload8(kf,kp0+sl_cur);
  WAIT_BAR(2);
  s16x4 vlo[8],vhi[8]; u32x4 pw0,pw1,pw2,pw3;
  #define PKW(P,B) cvtpk_s(P[B],P[B+1])
  #define PAF(k) __builtin_bit_cast(bf16x8,pw##k)
  #define VFR(i) (bf16x8){vlo[i][0],vlo[i][1],vlo[i][2],vlo[i][3],vhi[i][0],vhi[i][1],vhi[i][2],vhi[i][3]}
  #define PIN(x) asm volatile("":"+v"(x))
  #define MX3(a,b,c) __builtin_fmaxf(__builtin_fmaxf((a),(b)),(c))
  #define GAPA(MF,A0,A1,A2,A3,W0,W1,PW) do{ MF; sacc+=A0; sacc+=A1; sacc+=A2; sacc+=A3; PIN(sacc); W0; W1; PIN(PW); SBAR(); }while(0)
  #define EX(v) __builtin_amdgcn_exp2f(v)
  #define GAPB(MF,X,B) do{ MF; X[B]=EX(X[B]); X[B+1]=EX(X[B+1]); X[B+2]=EX(X[B+2]); X[B+3]=EX(X[B+3]); PIN(X); SBAR(); }while(0)
  #define VRD(i) do{ vlo[i]=vtr(vp_+(((i)>>2)*4096+((i)&3)*1024)); vhi[i]=vtr(vp_+(((i)>>2)*4096+((i)&3)*1024+512)); }while(0)
  #define KRD(G,j) do{ if(G){ kload2(kf,kp0+sl_next,j); SBAR(); } }while(0)
  #define STEP(C0,C1,P0,P1,t,GK,GV,GL) do{ SBAR(); BIASC(C0,C1,t,negm_s); SBAR(); \
    const lds_cptr vp_=vp0+sl_prev; \
    VRD(0); SBAR(); float sacc=(P0[0]+P0[1]); \
    GAPA(C0=__builtin_amdgcn_mfma_f32_32x32x16_bf16(kf[0],qr[0],C0,0,0,0), P0[2],P0[3],P0[4],P0[5],     pw0[0]=PKW(P0,0), pw0[1]=PKW(P0,2), pw0); \
    VRD(4); SBAR(); GAPA(C1=__builtin_amdgcn_mfma_f32_32x32x16_bf16(kf[1],qr[0],C1,0,0,0), P0[6],P0[7],P0[8],P0[9],     pw0[2]=PKW(P0,4), pw0[3]=PKW(P0,6), pw0); \
    VRD(1); SBAR(); GAPA(C0=__builtin_amdgcn_mfma_f32_32x32x16_bf16(kf[2],qr[1],C0,0,0,0),   P0[10],P0[11],P0[12],P0[13], pw1[0]=PKW(P0,8), pw1[1]=PKW(P0,10), pw1); \
    VRD(5); SBAR(); GAPA(C1=__builtin_amdgcn_mfma_f32_32x32x16_bf16(kf[3],qr[1],C1,0,0,0),   P0[14],P0[15],P1[0],P1[1],   pw1[2]=PKW(P0,12),pw1[3]=PKW(P0,14), pw1); \
    VRD(2); SBAR(); GAPA(C0=__builtin_amdgcn_mfma_f32_32x32x16_bf16(kf[4],qr[2],C0,0,0,0),   P1[2],P1[3],P1[4],P1[5],     pw2[0]=PKW(P1,0), pw2[1]=PKW(P1,2), pw2); \
    VRD(6); SBAR(); GAPA(C1=__builtin_amdgcn_mfma_f32_32x32x16_bf16(kf[5],qr[2],C1,0,0,0),   P1[6],P1[7],P1[8],P1[9],     pw2[2]=PKW(P1,4), pw2[3]=PKW(P1,6), pw2); \
    VRD(3); SBAR(); GAPA(C0=__builtin_amdgcn_mfma_f32_32x32x16_bf16(kf[6],qr[3],C0,0,0,0),   P1[10],P1[11],P1[12],P1[13], pw3[0]=PKW(P1,8), pw3[1]=PKW(P1,10), pw3); \
    VRD(7); SBAR(); GAPA(C1=__builtin_amdgcn_mfma_f32_32x32x16_bf16(kf[7],qr[3],C1,0,0,0),   P1[14],P1[15],0.f,0.f,       pw3[2]=PKW(P1,12),pw3[3]=PKW(P1,14), pw3); \
    l_reg+=sacc; \
    if(GK){DMA_K((t)+3,sl_cur);} if(GV){DMA_V((t)+1,sl_next);} \
    CMASK(C0,C1,t); \
    { float a=MX3(C0[0],C0[1],C1[0]),b=MX3(C0[2],C0[3],C1[1]); a=MX3(a,C1[2],C1[3]); \
      _Pragma("unroll") for(int r=4;r<16;r+=4){a=MX3(a,C0[r],C0[r+1]);b=MX3(b,C0[r+2],C0[r+3]);a=MX3(a,C1[r],C1[r+1]);b=MX3(b,C1[r+2],C1[r+3]);} \
      float rm=__builtin_fmaxf(a,b); { auto rr=__builtin_amdgcn_permlane32_swap(__float_as_uint(rm),__float_as_uint(rm),false,false); rm=__builtin_fmaxf(__uint_as_float(rr[0]),__uint_as_float(rr[1])); } \
      resc=false; \
      if(__builtin_expect(__any(rm>(float)THRL),0)){ const float dl=__builtin_fmaxf(rm,0.f); mhat+=dl; \
        _Pragma("unroll") for(int r=0;r<16;++r){C0[r]-=dl;C1[r]-=dl;} \
        negm_s=-mhat; \
        const float f=__builtin_amdgcn_exp2f(-dl); l_reg*=f; if(hi==0)wsf[r32]=f; resc=true; } } \
    SBAR(); \
    GAPB(o[0]=__builtin_amdgcn_mfma_f32_32x32x16_bf16(PAF(0),VFR(0),o[0],0,0,0), C0,0); \
    GAPB(o[1]=__builtin_amdgcn_mfma_f32_32x32x16_bf16(PAF(0),VFR(4),o[1],0,0,0), C0,4); \
    KRD(GL,0); GAPB(o[0]=__builtin_amdgcn_mfma_f32_32x32x16_bf16(PAF(1),VFR(1),o[0],0,0,0), C0,8); \
    KRD(GL,1); GAPB(o[1]=__builtin_amdgcn_mfma_f32_32x32x16_bf16(PAF(1),VFR(5),o[1],0,0,0), C0,12); \
    KRD(GL,2); GAPB(o[0]=__builtin_amdgcn_mfma_f32_32x32x16_bf16(PAF(2),VFR(2),o[0],0,0,0), C1,0); \
    KRD(GL,3); GAPB(o[1]=__builtin_amdgcn_mfma_f32_32x32x16_bf16(PAF(2),VFR(6),o[1],0,0,0), C1,4); \
    GAPB(o[0]=__builtin_amdgcn_mfma_f32_32x32x16_bf16(PAF(3),VFR(3),o[0],0,0,0), C1,8); \
    GAPB(o[1]=__builtin_amdgcn_mfma_f32_32x32x16_bf16(PAF(3),VFR(7),o[1],0,0,0), C1,12); \
    }while(0)
  int t=1;
  #undef CMASK
  #define CMASK(P0,P1,t) do{}while(0)
  for(;t+5<NT;t+=2){
    STEP(pB0,pB1,pA0,pA1,t,true,true,true);     WAIT_BAR(2); RESC(); ROT();
    STEP(pA0,pA1,pB0,pB1,t+1,true,true,true);   WAIT_BAR(2); RESC(); ROT();
  }
  #undef CMASK
  #define CMASK(P0,P1,t) do{int jb_=(t)-(NT-4); if(jb_>=0)cmask(P0,P1,jb_,qrel,hi);}while(0)
  #define ENDW(tt) do{ if((tt)+3<NT){WAIT_BAR(2);} else if((tt)+2<NT){WAIT_BAR(1);} else {WAIT_BAR(0);} }while(0)
  for(;t+1<NT;t+=2){
    STEP(pB0,pB1,pA0,pA1,t,(t+3<NT),(t+1<NT),(t+1<NT));       ENDW(t);   RESC(); ROT();
    STEP(pA0,pA1,pB0,pB1,t+1,(t+4<NT),(t+2<NT),(t+2<NT));     ENDW(t+1); RESC(); ROT();
  }
  STEP(pB0,pB1,pA0,pA1,NT-1,false,false,false); RESC();
  { float sacc=pB0[0]+pB0[1]; _Pragma("unroll") for(int r=2;r<16;++r)sacc+=pB0[r]; _Pragma("unroll") for(int r=0;r<16;++r)sacc+=pB1[r]; l_reg+=sacc;
    pw0=(u32x4){PKW(pB0,0),PKW(pB0,2),PKW(pB0,4),PKW(pB0,6)};pw1=(u32x4){PKW(pB0,8),PKW(pB0,10),PKW(pB0,12),PKW(pB0,14)};pw2=(u32x4){PKW(pB1,0),PKW(pB1,2),PKW(pB1,4),PKW(pB1,6)};pw3=(u32x4){PKW(pB1,8),PKW(pB1,10),PKW(pB1,12),PKW(pB1,14)};
    SBAR(); pv(o,vb0+sl_cur,PAF(0),PAF(1),PAF(2),PAF(3)); }
  #undef PKW
  #undef PAF
  #undef VFR
  #undef PIN
  #undef MX3
  #undef GAPA
  #undef GAPB
  #undef EX
  #undef VRD
  #undef KRD
  #undef STEP
  #undef ENDW
  {auto rr=__builtin_amdgcn_permlane32_swap(__float_as_uint(l_reg),__float_as_uint(l_reg),false,false);l_reg=__uint_as_float(rr[0])+__uint_as_float(rr[1]);}
  if(hi==0)wsf[32+r32]=l_reg;asm volatile("s_waitcnt lgkmcnt(0)":::"memory");
  float rli[16];
  #pragma unroll
  for(int r=0;r<16;++r)rli[r]=__builtin_amdgcn_rcpf(wsf[32+crow(r,hi)]);
  bf16*Ow=O+(rowbase+q0+wid*QBLK)*OPITCH+h*D; const float*ogw=proj+(rowbase+q0+wid*QBLK)*(long)PROJ_PITCH+OG_COL+h*D;
  { bf16*stg=(bf16*)(shm+LDS_OST)+wid*2048;
    #pragma unroll
    for(int r=0;r<16;++r){const int orow=crow(r,hi);
      #pragma unroll
      for(int d0=0;d0<2;++d0)stg[orow*64+d0*32+r32]=__float2bfloat16(o[d0][r]*rli[r]);}
    asm volatile("s_waitcnt lgkmcnt(0)":::"memory");
    #pragma unroll
    for(int i=0;i<4;++i){const int row=i*8+(lane>>3),ch=lane&7; u32x4 v=*(const u32x4*)(stg+row*64+ch*8);
      const f32x4 g0=*(const f32x4*)(ogw+(long)row*PROJ_PITCH+ch*8),g1=*(const f32x4*)(ogw+(long)row*PROJ_PITCH+ch*8+4);
      #define SG(x) __builtin_amdgcn_rcpf(1.0f+__builtin_amdgcn_exp2f(-1.4426950408889634f*(x)))
      #define LO(w) __uint_as_float((w)<<16)
      #define HI(w) __uint_as_float((w)&0xffff0000u)
      v[0]=cvtpk_s(LO(v[0])*SG(g0[0]),HI(v[0])*SG(g0[1])); v[1]=cvtpk_s(LO(v[1])*SG(g0[2]),HI(v[1])*SG(g0[3]));
      v[2]=cvtpk_s(LO(v[2])*SG(g1[0]),HI(v[2])*SG(g1[1])); v[3]=cvtpk_s(LO(v[3])*SG(g1[2]),HI(v[3])*SG(g1[3]));
      #undef SG
      #undef LO
      #undef HI
      ATTN_STORE16(Ow+(long)row*OPITCH+ch*8,v);} }
  asm volatile("s_waitcnt lgkmcnt(0)\n\ts_barrier":::"memory");
  #undef DMA_K
  #undef DMA_V
  #undef CMASK
  #undef START
  #undef RESC
  #undef ROT
  #undef BIASC
}
constexpr int ATTN_LDS_BYTES=LDS_BYTES;
struct AttnTensors { const bf16* Q; const bf16* K; const bf16* V; bf16* O; const float* logf; const float* proj; };
constexpr int N_UNITS=BATCH*NHEAD*NQB;
template<int THRL=8> __device__ __forceinline__ void attn_phase(char*lds,const AttnTensors&T,unsigned*qhead,volatile __attribute__((address_space(3))) unsigned*qslot){
  for(;;){
    if(threadIdx.x==0)*qslot=__hip_atomic_fetch_add(qhead,1u,__ATOMIC_RELAXED,__HIP_MEMORY_SCOPE_AGENT);
    __syncthreads(); const unsigned u=*qslot; __syncthreads();
    if(u>=(unsigned)N_UNITS)break;
    const int qb=NQB-1-(int)(u>>5),bh=(int)(u&31u);
    attn_unit<THRL>(bh/NHEAD,bh%NHEAD,qb,T.Q,T.K,T.V,T.O,T.logf,T.proj,lds);
  }
}
#undef SBAR
#undef WAIT_BAR
}
#define GAS __attribute__((address_space(1)))
#define LAS __attribute__((address_space(3)))
typedef unsigned short bf16;
typedef unsigned v4u __attribute__((ext_vector_type(4)));
typedef float f32x4 __attribute__((ext_vector_type(4)));
typedef short bf16x8 __attribute__((ext_vector_type(8)));
typedef GAS unsigned gu32;
typedef GAS unsigned long long gu64;
#define RLX_AGENT __ATOMIC_RELAXED, __HIP_MEMORY_SCOPE_AGENT
#define LDS_WAIT() asm volatile("s_waitcnt lgkmcnt(0)" ::: "memory")
#define VM_WAIT() asm volatile("s_waitcnt vmcnt(0)" ::: "memory")
__device__ __forceinline__ unsigned long long rt() { return __builtin_amdgcn_s_memrealtime(); }
__device__ __forceinline__ unsigned f2bf(float f) { unsigned u = __builtin_bit_cast(unsigned, f); return (u + 0x7fffu + ((u >> 16) & 1u)) >> 16; }
__device__ __forceinline__ unsigned pk2(float lo, float hi) { return f2bf(lo) | (f2bf(hi) << 16); }

#define XB_TMO      128
#define XB_XCNT(j)  (256  + 64 * (j))
#define XB_XSUB(j)  (1280 + 64 * (j))
#define XB_XGEN(j)  (2304 + 64 * (j))
#define XB_TOP      3328
#define XB_TOPGEN   3392
#define XCD_BAR_WORDS 3456
#define XB_SPIN_CAP (1u << 18)

__device__ __forceinline__ unsigned xb_ld(unsigned* p)              { return __hip_atomic_load(p, __ATOMIC_RELAXED, __HIP_MEMORY_SCOPE_AGENT); }
__device__ __forceinline__ unsigned xb_add(unsigned* p, unsigned v) { return __hip_atomic_fetch_add(p, v, __ATOMIC_RELAXED, __HIP_MEMORY_SCOPE_AGENT); }
__device__ __forceinline__ unsigned xb_xcc_id() { return (unsigned)__builtin_amdgcn_s_getreg((3 << 11) | 20) & 0xFu; }
#define XB_SPIN(cond, bar) do { unsigned _sp = 0; while (cond) { __builtin_amdgcn_s_sleep(1); \
    if ((++_sp & 255u) == 0u) { if (xb_ld(&(bar)[XB_TMO])) break; if (_sp > XB_SPIN_CAP) { atomicAdd(&(bar)[XB_TMO], 1u); break; } } } } while (0)

struct XcdBarrier {
    unsigned* bar; unsigned x;
    volatile LAS unsigned* st;
};

__device__ __forceinline__ XcdBarrier xcd_barrier_post(unsigned* bar, volatile LAS unsigned* st) {
    XcdBarrier b; b.bar = bar; b.x = xb_xcc_id(); b.st = st;
    if (threadIdx.x == 0) (void)xb_add(&bar[XB_XCNT(b.x)], 1u);
    return b;
}
__device__ __forceinline__ void xcd_barrier_complete(unsigned* bar, unsigned x, unsigned& nloc, unsigned& nx) {
    const unsigned G = gridDim.x * gridDim.y * gridDim.z;
    unsigned sum, cnt, mine, sp = 0u;
    for (;;) {
        sum = 0u; cnt = 0u; mine = 0u;
#pragma unroll
        for (unsigned j = 0; j < 16; ++j) { const unsigned c = xb_ld(&bar[XB_XCNT(j)]); sum += c; cnt += (c > 0u) ? 1u : 0u; mine = (j == x) ? c : mine; }
        if (sum == G) break;
        __builtin_amdgcn_s_sleep(1);
        if ((++sp & 255u) == 0u) { if (xb_ld(&bar[XB_TMO])) break; if (sp > XB_SPIN_CAP) { atomicAdd(&bar[XB_TMO], 1u); break; } }
    }
    nloc = mine > 0u ? mine : 1u; nx = cnt > 0u ? cnt : 1u;
}

__device__ __forceinline__ void xcd_barrier(const XcdBarrier& b) {
    asm volatile("s_waitcnt vmcnt(0)" ::: "memory");
    __syncthreads();
    if (threadIdx.x == 0) {
        unsigned* bar = b.bar;
        __builtin_amdgcn_s_waitcnt(0);
        unsigned nloc = b.st[0], nx = b.st[1];
        if (nloc == 0u) { xcd_barrier_complete(bar, b.x, nloc, nx); b.st[0] = nloc; b.st[1] = nx; }
        const unsigned old = xb_add(&bar[XB_XSUB(b.x)], 1u);
        const unsigned gen = old / nloc;
        if (old + 1u == (gen + 1u) * nloc) {
            __builtin_amdgcn_fence(__ATOMIC_RELEASE, "agent");
            asm volatile("s_waitcnt vmcnt(0)" ::: "memory");
            const unsigned og = xb_add(&bar[XB_TOP], 1u);
            const unsigned tg = og / nx;
            if (og + 1u == (tg + 1u) * nx) xb_add(&bar[XB_TOPGEN], 1u);
            else XB_SPIN(xb_ld(&bar[XB_TOPGEN]) == tg, bar);
            __builtin_amdgcn_fence(__ATOMIC_ACQUIRE, "agent");
            xb_add(&bar[XB_XGEN(b.x)], 1u);
            asm volatile("s_waitcnt vmcnt(0)" ::: "memory");
        } else {
            XB_SPIN(xb_ld(&bar[XB_XGEN(b.x)]) == gen, bar);
            __builtin_amdgcn_fence(__ATOMIC_ACQUIRE, "agent");
            asm volatile("s_waitcnt vmcnt(0)" ::: "memory");
        }
    }
    __syncthreads();
}

constexpr int NWAVES = 8, NTHR = 512;
constexpr int BATCH = 4, SEQ = 4096, D = 1024, M = BATCH * SEQ;
constexpr int NH = 8, HD = 64, RWW = 512;
constexpr int IN_COLS = 3752, PL = 3840;
constexpr int C_R = 0, C_K = 512, C_V = 1024, C_WD = 1536, C_AD = 1568, C_GD = 1600;
constexpr int C_FQ = 1696, C_FK = 2208, C_FV = 2720, C_OG = 3232, C_FZ = 3744;
constexpr int NE = 32, TOPK = 4, NASSIGN = M * TOPK, MAXTILES = NASSIGN / 256 + NE, XROWS = MAXTILES * 256;
constexpr float LN_EPS = 1e-5f, QK_EPS = 1e-6f, GN_EPS = 64e-5f, ALPHA = 1.189207115002721f;
static_assert(attn_body::PROJ_PITCH == PL && attn_body::OG_COL == C_OG, "attention body constants");

constexpr size_t MiB = 1u << 20;
constexpr size_t WS_CTL = 0, CTL_ZERO_BYTES = 1 * MiB;
constexpr size_t WS_WIN = 2 * MiB, WS_WO = 10 * MiB;
constexpr size_t WS_LOGF = 12 * MiB;
constexpr size_t WS_AE = WS_LOGF + 512 * 1024, WS_APOS = WS_AE + 256 * 1024, WS_AGATE = WS_APOS + 256 * 1024, WS_AROW = WS_AGATE + 256 * 1024, WS_ROWGATE = WS_AROW + 256 * 1024;
constexpr size_t WS_W1T = 32 * MiB, WS_W2T = 160 * MiB;
constexpr size_t WS_HB = 224 * MiB;
constexpr size_t WS_HF = 256 * MiB;
constexpr size_t WS_PROJ = 320 * MiB;
constexpr size_t WS_G = 560 * MiB, WS_BONUS = 592 * MiB;
constexpr size_t WS_QB = 624 * MiB, WS_KB = 640 * MiB, WS_VB = 656 * MiB;
constexpr size_t WS_MIX = 672 * MiB;
constexpr size_t WS_MC = 704 * MiB, WS_NT = 720 * MiB, WS_QC = 752 * MiB, WS_ZT = 768 * MiB;
constexpr size_t WS_Y = 800 * MiB;
constexpr size_t WS_XS = 320 * MiB, WS_ACT = 464 * MiB, WS_EOUT = 320 * MiB;
constexpr size_t WS_END = 832 * MiB;
static_assert(WS_ROWGATE + (size_t)XROWS * 4 <= WS_W1T && WS_XS + (size_t)XROWS * 2048 <= WS_ACT && WS_ACT + (size_t)XROWS * 2048 <= WS_QB, "d_ws map");

constexpr int CW_BAR = 4096, CW_ATTQ = 8192, CW_ECNT = 8256;

constexpr int RING_OFF = 0;
constexpr int CTRL_OFF = 159744, LDS_BYTES = 163840;
constexpr int LC_MISC = 0  , LC_HIST = 128, LC_BASE = 256, LC_TSTART = 384, LC_TEXP = 640  , LC_ROWINFO = 1024  ;
static_assert(attn_body::ATTN_LDS_BYTES <= 131072, "attention scratch inside the ring region");

typedef float f32x2 __attribute__((ext_vector_type(2)));
typedef unsigned u32x2v __attribute__((ext_vector_type(2)));
#define MFMA16(a, b, c) __builtin_amdgcn_mfma_f32_16x16x32_bf16((a), (b), (c), 0, 0, 0)
__device__ __forceinline__ float sigmoidf_(float x) { return __builtin_amdgcn_rcpf(1.0f + __builtin_amdgcn_exp2f(-1.4426950408889634f * x)); }
__device__ __forceinline__ float bf2f(unsigned short b) { return __uint_as_float((unsigned)b << 16); }
__device__ __forceinline__ unsigned short f2bf16(float f) { return (unsigned short)f2bf(f); }
__device__ __forceinline__ v4u pack8(const float* v) { v4u o; o.x = pg8::cvt_pk_bf16(v[0], v[1]); o.y = pg8::cvt_pk_bf16(v[2], v[3]); o.z = pg8::cvt_pk_bf16(v[4], v[5]); o.w = pg8::cvt_pk_bf16(v[6], v[7]); return o; }
__device__ __forceinline__ float wave_sum(float v) {
#pragma unroll
    for (int o = 1; o < 64; o <<= 1) v += __shfl_xor(v, o);
    return v;
}

__device__ __forceinline__ void transpose_item(const float* W, int K, int N, int nblk, bf16* WT, LAS float* scr, int item, int lane) {
    const int kb = item / nblk, nb = item - kb * nblk, k0 = 64 * kb, n0 = 32 * nb; const int nn = n0 + (lane & 31); const bool ok = nn < N;
#pragma unroll 8
    for (int i = 0; i < 32; ++i) { const int kk = 2 * i + (lane >> 5); scr[kk * 33 + (lane & 31)] = ok ? W[(size_t)(k0 + kk) * N + nn] : 0.f; }
    LDS_WAIT(); asm volatile("" ::: "memory");
    const int c = lane & 7;
#pragma unroll
    for (int j = 0; j < 4; ++j) { const int n = (lane >> 3) + 8 * j; const LAS float* s = scr + (8 * c) * 33 + n;
        v4u o; o.x = pk2(s[0 * 33], s[1 * 33]); o.y = pk2(s[2 * 33], s[3 * 33]); o.z = pk2(s[4 * 33], s[5 * 33]); o.w = pk2(s[6 * 33], s[7 * 33]);
        *(GAS v4u*)(WT + (size_t)(n0 + n) * K + k0 + 8 * c) = o; }
    LDS_WAIT(); asm volatile("" ::: "memory");
}
__device__ __forceinline__ void ln_finish(f32x4 (&v)[4], const float* w, const float* b, int lane, float* outF, bf16* outB) {
    float s = 0.f;
#pragma unroll
    for (int j = 0; j < 4; ++j) s += (v[j].x + v[j].y) + (v[j].z + v[j].w);
    const float mean = wave_sum(s) * (1.f / D); float s2 = 0.f;
#pragma unroll
    for (int j = 0; j < 4; ++j) { v[j] = v[j] - mean; s2 += (v[j].x * v[j].x + v[j].y * v[j].y) + (v[j].z * v[j].z + v[j].w * v[j].w); }
    const float rstd = 1.f / sqrtf(wave_sum(s2) * (1.f / D) + LN_EPS);
#pragma unroll
    for (int j = 0; j < 4; ++j) { const f32x4 wv = *(const f32x4*)(w + 4 * lane + 256 * j), bv = *(const f32x4*)(b + 4 * lane + 256 * j); v[j] = v[j] * rstd * wv + bv;
        if (outF) *(f32x4*)(outF + 4 * lane + 256 * j) = v[j];
        if (outB) { u32x2v o; o.x = pg8::cvt_pk_bf16(v[j].x, v[j].y); o.y = pg8::cvt_pk_bf16(v[j].z, v[j].w); *(u32x2v*)(outB + 4 * lane + 256 * j) = o; } }
}

namespace rwk {
constexpr int OPS = 144;
constexpr int O_XL = 0, O_WL = 40960;
constexpr int O_RT = 0, O_AT = 9216, O_BT = 18432, O_KT = 27648, O_AAK = 36864, O_PART = 46080, O_RHS = 49152;
constexpr int O_XT = O_AT;
constexpr int O_BF = 81920, O_LQ = O_BF, O_KF = 98304, O_ARB = 98304, O_ARK = 107520, O_CUM = 114688;
constexpr int O_VT = 131072, O_BHT = 140288, O_KHT = 149504, O_GAMC = 158720, O_END = 158976;
static_assert(O_END <= CTRL_OFF, "RWKV arena below the LDS control area");

__device__ __forceinline__ float quad_sum(float s) {
    s += __uint_as_float(__builtin_amdgcn_update_dpp(0u, __float_as_uint(s), 0xB1, 0xf, 0xf, false));
    s += __uint_as_float(__builtin_amdgcn_update_dpp(0u, __float_as_uint(s), 0x4E, 0xf, 0xf, false));
    return s;
}
struct Ptrs { const float *proj, *mu, *w0, *w2, *a0, *a2, *g2, *k_k, *k_a, *r_k; float *G, *Bonus; bf16* Mc; float* NT; bf16* Qc; float* ZT; };

__device__ __forceinline__ void unit(LAS unsigned char* lds, const int un, const Ptrs& P) {
    const int tid = threadIdx.x, lane = tid & 63, w = __builtin_amdgcn_readfirstlane(tid >> 6);
    const int b = un >> 9, h = (un >> 6) & 7, c = un & 63; const int tok0 = b * SEQ + c * 64;
    LAS float* XL = (LAS float*)(lds + O_XL); LAS float* WL = (LAS float*)(lds + O_WL);
    LAS float* CU = (LAS float*)(lds + O_CUM); LAS float* BF = (LAS float*)(lds + O_BF); LAS float* KF = (LAS float*)(lds + O_KF);
    LAS float* RHS = (LAS float*)(lds + O_RHS); LAS float* PART = (LAS float*)(lds + O_PART); LAS float* GAMC = (LAS float*)(lds + O_GAMC);
    LAS float* LQ = (LAS float*)(lds + O_LQ);
#pragma unroll 4
    for (int i = 0; i < 20; ++i) { const int idx = tid + 512 * i, t = idx / 160, j = idx - t * 160, col = C_WD + j; const size_t tok = (size_t)(tok0 + t);
        const float p = P.proj[tok * PL + col]; const float pv = (c == 0 && t == 0) ? 0.f : P.proj[(tok - 1) * PL + col];
        float x = p + P.mu[col] * (pv - p);
        x = (j < 32) ? tanhf(x) : ((j < 64) ? x : sigmoidf_(x));
        XL[idx] = x; }
#pragma unroll 4
    for (int i = 0; i < 20; ++i) { const int idx = tid + 512 * i, j = idx >> 6, n = idx & 63;
        const float* src = (j < 32) ? (P.w2 + j * 512) : ((j < 64) ? (P.a2 + (j - 32) * 512) : (P.g2 + (j - 64) * 512));
        WL[idx] = src[h * 64 + n]; }
    const int t = tid >> 3, cg = tid & 7, n0 = 8 * cg, hn0 = h * 64 + n0;
    float r8[8], k8[8], v8[8];
    { const float* pr = P.proj + (size_t)(tok0 + t) * PL; const bool first = (c == 0 && t == 0); const float* pp = first ? pr : pr - PL;
#pragma unroll
      for (int i = 0; i < 8; ++i) { const float a = pr[C_R + hn0 + i], bq = pr[C_K + hn0 + i], cq = pr[C_V + hn0 + i];
          const float ap = first ? 0.f : pp[C_R + hn0 + i], bp = first ? 0.f : pp[C_K + hn0 + i], cp = first ? 0.f : pp[C_V + hn0 + i];
          r8[i] = a + P.mu[C_R + hn0 + i] * (ap - a); k8[i] = bq + P.mu[C_K + hn0 + i] * (bp - bq); v8[i] = cq + P.mu[C_V + hn0 + i] * (cp - cq); } }
    __syncthreads();
    float a8[8], b8[8], lw8[8];
    {
        float accw[8], acca[8], accg[8];
#pragma unroll
        for (int i = 0; i < 8; ++i) { accw[i] = 0.f; acca[i] = 0.f; accg[i] = 0.f; }
        const LAS f32x4* X4 = (const LAS f32x4*)(XL + t * 160); const LAS f32x4* W4 = (const LAS f32x4*)WL + 2 * cg;
#define RW_DOT(acc, J0, J1) _Pragma("unroll 2") for (int j4 = (J0) / 4; j4 < (J1) / 4; ++j4) { const f32x4 x4 = X4[j4]; \
            _Pragma("unroll") for (int jj = 0; jj < 4; ++jj) { const f32x4 wa = W4[(4 * j4 + jj) * 16], wb = W4[(4 * j4 + jj) * 16 + 1]; const float xv = x4[jj]; \
                acc[0] += xv * wa[0]; acc[1] += xv * wa[1]; acc[2] += xv * wa[2]; acc[3] += xv * wa[3]; acc[4] += xv * wb[0]; acc[5] += xv * wb[1]; acc[6] += xv * wb[2]; acc[7] += xv * wb[3]; } }
        RW_DOT(accw, 0, 32) RW_DOT(acca, 32, 64) RW_DOT(accg, 64, 160)
#undef RW_DOT
        float kkr[8], lr8[8], g8[8]; float ss = 0.f, dotb = 0.f;
#pragma unroll
        for (int i = 0; i < 8; ++i) { const int hn = hn0 + i;
            const float xw = P.w0[hn] + accw[i];
            const float wv = fminf(xw, 0.f) - log1pf(__expf(-fabsf(xw))) - 0.5f;
            lw8[i] = -__expf(wv);
            lr8[i] = sigmoidf_(P.a0[hn] + acca[i]); g8[i] = accg[i];
            kkr[i] = k8[i] * P.k_k[hn]; ss += kkr[i] * kkr[i];
            k8[i] = k8[i] * (1.f + (lr8[i] - 1.f) * P.k_a[hn]);
            dotb += r8[i] * k8[i] * P.r_k[hn]; }
        ss += __shfl_xor(ss, 1); ss += __shfl_xor(ss, 2); ss += __shfl_xor(ss, 4);
        dotb += __shfl_xor(dotb, 1); dotb += __shfl_xor(dotb, 2); dotb += __shfl_xor(dotb, 4);
        const float inv = 1.f / fmaxf(sqrtf(ss), 1e-12f);
        float bon[8];
#pragma unroll
        for (int i = 0; i < 8; ++i) { const float kk = kkr[i] * inv; a8[i] = -kk; b8[i] = kk * lr8[i]; bon[i] = dotb * v8[i]; }
        float* gp = P.G + (size_t)(tok0 + t) * RWW + hn0; float* bp = P.Bonus + (size_t)(tok0 + t) * RWW + hn0;
        *(f32x4*)gp = (f32x4){g8[0], g8[1], g8[2], g8[3]}; *(f32x4*)(gp + 4) = (f32x4){g8[4], g8[5], g8[6], g8[7]};
        *(f32x4*)bp = (f32x4){bon[0], bon[1], bon[2], bon[3]}; *(f32x4*)(bp + 4) = (f32x4){bon[4], bon[5], bon[6], bon[7]};
        *(LAS f32x4*)(CU + t * 64 + n0) = (f32x4){lw8[0], lw8[1], lw8[2], lw8[3]}; *(LAS f32x4*)(CU + t * 64 + n0 + 4) = (f32x4){lw8[4], lw8[5], lw8[6], lw8[7]};
        *(LAS f32x4*)(BF + t * 64 + n0) = (f32x4){b8[0], b8[1], b8[2], b8[3]}; *(LAS f32x4*)(BF + t * 64 + n0 + 4) = (f32x4){b8[4], b8[5], b8[6], b8[7]};
        *(LAS f32x4*)(KF + t * 64 + n0) = (f32x4){k8[0], k8[1], k8[2], k8[3]}; *(LAS f32x4*)(KF + t * 64 + n0 + 4) = (f32x4){k8[4], k8[5], k8[6], k8[7]};
        LAS unsigned short* VT = (LAS unsigned short*)(lds + O_VT);
#pragma unroll
        for (int i = 0; i < 8; ++i) VT[(n0 + i) * 72 + t] = f2bf16(v8[i]);
    }
    __syncthreads();
    {
        const int n = tid & 63, tg = w; float run = 0.f;
#pragma unroll
        for (int i = 0; i < 8; ++i) { run += CU[(8 * tg + i) * 64 + n]; CU[(8 * tg + i) * 64 + n] = run; }
        PART[tg * 64 + n] = run;
        __syncthreads();
        float off = 0.f;
        for (int g = 0; g < tg; ++g) off += PART[g * 64 + n];
#pragma unroll
        for (int i = 0; i < 8; ++i) CU[(8 * tg + i) * 64 + n] += off;
        if (tg == 7) GAMC[n] = __expf(run + off);
    }
    __syncthreads();
    {
        const f32x4 c0 = *(const LAS f32x4*)(CU + t * 64 + n0), c1 = *(const LAS f32x4*)(CU + t * 64 + n0 + 4);
        const float cum[8] = {c0[0], c0[1], c0[2], c0[3], c1[0], c1[1], c1[2], c1[3]};
        float rt[8], at[8], bt[8], kt[8];
#pragma unroll
        for (int i = 0; i < 8; ++i) { const float ein = __expf(cum[i]), eex = __expf(cum[i] - lw8[i]), eneg = __expf(-cum[i]);
            rt[i] = r8[i] * ein; at[i] = a8[i] * eex; bt[i] = b8[i] * eneg; kt[i] = k8[i] * eneg; }
        *(LAS v4u*)(lds + O_RT + t * OPS + cg * 16) = pack8(rt); *(LAS v4u*)(lds + O_AT + t * OPS + cg * 16) = pack8(at);
        *(LAS v4u*)(lds + O_BT + t * OPS + cg * 16) = pack8(bt); *(LAS v4u*)(lds + O_KT + t * OPS + cg * 16) = pack8(kt);
        *(LAS f32x4*)(RHS + t * 128 + n0) = (f32x4){at[0], at[1], at[2], at[3]}; *(LAS f32x4*)(RHS + t * 128 + n0 + 4) = (f32x4){at[4], at[5], at[6], at[7]};
    }
    {
        const int n = tid & 63, tg = w; const float cC = CU[63 * 64 + n]; float bh[8], kh[8];
#pragma unroll
        for (int i = 0; i < 8; ++i) { const int tt = 8 * tg + i; const float e = __expf(cC - CU[tt * 64 + n]); bh[i] = BF[tt * 64 + n] * e; kh[i] = KF[tt * 64 + n] * e; }
        *(LAS v4u*)(lds + O_BHT + n * OPS + tg * 16) = pack8(bh); *(LAS v4u*)(lds + O_KHT + n * OPS + tg * 16) = pack8(kh);
    }
    __syncthreads();
    const int fr = lane & 15, fq = lane >> 4;
#define FRAG(off, row, ks) (*(const LAS bf16x8*)(lds + (off) + (row) * OPS + (ks) * 64 + fq * 16))
    {
        const int tt = w & 3, mg = w >> 2; const int lo = mg ? O_RT : O_AT;
        LAS unsigned short* AAK = (LAS unsigned short*)(lds + O_AAK); LAS unsigned short* ARB = (LAS unsigned short*)(lds + O_ARB); LAS unsigned short* ARK = (LAS unsigned short*)(lds + O_ARK);
        const bf16x8 l0 = FRAG(lo, 16 * tt + fr, 0), l1 = FRAG(lo, 16 * tt + fr, 1);
#pragma unroll
        for (int ct = 0; ct < 4; ++ct)
#pragma unroll
            for (int rh = 0; rh < 2; ++rh) {
                f32x4 acc = {0.f, 0.f, 0.f, 0.f};
                if (ct <= tt) { const int ro = rh ? O_KT : O_BT; acc = MFMA16(l0, FRAG(ro, 16 * ct + fr, 0), acc); acc = MFMA16(l1, FRAG(ro, 16 * ct + fr, 1), acc); }
#pragma unroll
                for (int j = 0; j < 4; ++j) { const int row = 16 * tt + 4 * fq + j, col = 16 * ct + fr;
                    if (mg == 0) { const float val = (col < row) ? acc[j] : 0.f;
                        if (rh == 0) { if (ct <= tt) LQ[((col & 3) * 64 + row) * 16 + (col >> 2)] = val; } else AAK[row * 72 + col] = f2bf16(val); }
                    else { const float val = (col <= row) ? acc[j] : 0.f; if (rh == 0) ARB[row * 72 + col] = f2bf16(val); else ARK[row * 72 + col] = f2bf16(val); } }
            }
    }
    __syncthreads();
    {
        const int tt = w & 3;
#pragma unroll
        for (int vv = 0; vv < 2; ++vv) { const int vt = 2 * (w >> 2) + vv; f32x4 acc = {0.f, 0.f, 0.f, 0.f};
            acc = MFMA16(FRAG(O_AAK, 16 * tt + fr, 0), FRAG(O_VT, 16 * vt + fr, 0), acc); acc = MFMA16(FRAG(O_AAK, 16 * tt + fr, 1), FRAG(O_VT, 16 * vt + fr, 1), acc);
#pragma unroll
            for (int j = 0; j < 4; ++j) RHS[(16 * tt + 4 * fq + j) * 128 + 64 + 16 * vt + fr] = acc[j]; }
    }
    __syncthreads();
    {
        const int qq = lane & 3, colx = 16 * w + (lane >> 2);
        const LAS f32x4* L4 = (const LAS f32x4*)(LQ + qq * 1024);
        LAS unsigned short* XT = (LAS unsigned short*)(lds + O_XT);
        float X[16];
#pragma unroll
        for (int j = 0; j < 16; ++j) X[j] = 0.f;
#pragma unroll
        for (int tt = 0; tt < 64; ++tt) {
            const int nt = (tt + 3) >> 2; float s = 0.f;
#pragma unroll
            for (int j4 = 0; j4 < (nt + 3) / 4; ++j4) { const f32x4 l = L4[tt * 4 + j4];
#pragma unroll
                for (int jj = 0; jj < 4; ++jj) if (4 * j4 + jj < nt) s += l[jj] * X[4 * j4 + jj]; }
            s = quad_sum(s);
            const float x = RHS[tt * 128 + colx] + s;
            if (qq == (tt & 3)) { X[tt >> 2] = x; XT[colx * 72 + tt] = f2bf16(x); }
        }
    }
    __syncthreads();
    {
        const int rt = w & 3; const size_t ub = (size_t)un * 4096;
        const LAS unsigned short* RTb = (const LAS unsigned short*)(lds + O_RT);
#pragma unroll
        for (int cc = 0; cc < 2; ++cc) { const int ct = 2 * (w >> 2) + cc;
            const bf16x8 arb0 = FRAG(O_ARB, 16 * rt + fr, 0), arb1 = FRAG(O_ARB, 16 * rt + fr, 1), ark0 = FRAG(O_ARK, 16 * rt + fr, 0), ark1 = FRAG(O_ARK, 16 * rt + fr, 1);
            const bf16x8 bht0 = FRAG(O_BHT, 16 * rt + fr, 0), bht1 = FRAG(O_BHT, 16 * rt + fr, 1), kht0 = FRAG(O_KHT, 16 * rt + fr, 0), kht1 = FRAG(O_KHT, 16 * rt + fr, 1);
            const bf16x8 xa0 = FRAG(O_XT, 16 * ct + fr, 0), xa1 = FRAG(O_XT, 16 * ct + fr, 1), xv0 = FRAG(O_XT, 64 + 16 * ct + fr, 0), xv1 = FRAG(O_XT, 64 + 16 * ct + fr, 1);
            const bf16x8 vt0 = FRAG(O_VT, 16 * ct + fr, 0), vt1 = FRAG(O_VT, 16 * ct + fr, 1);
            f32x4 z4 = {0.f, 0.f, 0.f, 0.f};
            f32x4 q = MFMA16(arb0, xa0, z4); q = MFMA16(arb1, xa1, q);
            f32x4 z = MFMA16(arb0, xv0, z4); z = MFMA16(arb1, xv1, z); z = MFMA16(ark0, vt0, z); z = MFMA16(ark1, vt1, z);
            f32x4 m = MFMA16(bht0, xa0, z4); m = MFMA16(bht1, xa1, m);
            f32x4 nn = MFMA16(bht0, xv0, z4); nn = MFMA16(bht1, xv1, nn); nn = MFMA16(kht0, vt0, nn); nn = MFMA16(kht1, vt1, nn);
            const int col = 16 * ct + fr;
#pragma unroll
            for (int j = 0; j < 4; ++j) { const int row = 16 * rt + 4 * fq + j;
                P.Qc[ub + row * 64 + col] = f2bf16(q[j] + bf2f(RTb[row * 72 + col]));
                P.Mc[ub + row * 64 + col] = f2bf16(m[j] + ((row == col) ? GAMC[row] : 0.f)); }
            *(f32x4*)(P.ZT + ub + col * 64 + 16 * rt + 4 * fq) = z;
            *(f32x4*)(P.NT + ub + col * 64 + 16 * rt + 4 * fq) = nn;
        }
    }
#undef FRAG
    __syncthreads();
}

struct ChainFrags { u32x2v mq[2][4][2][2]; f32x4 nz[2][4]; };
__device__ __forceinline__ void chain_load(ChainFrags& F, const bf16* Mc, const bf16* Qc, const float* NT, const float* ZT, size_t ub, int vq, int fr, int fq) {
#pragma unroll
    for (int mt = 0; mt < 4; ++mt) {
#pragma unroll
        for (int ks = 0; ks < 2; ++ks)
#pragma unroll
            for (int hf = 0; hf < 2; ++hf) { const size_t o = ub + (16 * mt + fr) * 64 + 32 * ks + 16 * hf + 4 * fq;
                F.mq[0][mt][ks][hf] = *(const u32x2v*)(Mc + o); F.mq[1][mt][ks][hf] = *(const u32x2v*)(Qc + o); }
        const size_t o2 = ub + (16 * vq + fr) * 64 + 16 * mt + 4 * fq;
        F.nz[0][mt] = *(const f32x4*)(NT + o2); F.nz[1][mt] = *(const f32x4*)(ZT + o2);
    }
}
__device__ __forceinline__ void chain(int bh, int vq, const bf16* Mc, const bf16* Qc, const float* NT, const float* ZT, float* Y) {
    const int lane = threadIdx.x & 63, fr = lane & 15, fq = lane >> 4; const int b = bh >> 3, h = bh & 7;
    f32x4 S[4];
#pragma unroll
    for (int i = 0; i < 4; ++i) S[i] = (f32x4){0.f, 0.f, 0.f, 0.f};
    ChainFrags cur, nxt;
    chain_load(cur, Mc, Qc, NT, ZT, (size_t)(bh * 64) * 4096, vq, fr, fq);
    for (int c = 0; c < 64; ++c) {
        if (c + 1 < 64) chain_load(nxt, Mc, Qc, NT, ZT, (size_t)(bh * 64 + c + 1) * 4096, vq, fr, fq);
        bf16x8 bh_[2], bl_[2];
#pragma unroll
        for (int ks = 0; ks < 2; ++ks) { float hi8[8], lo8[8];
#pragma unroll
            for (int e = 0; e < 8; ++e) { const float s = S[2 * ks + (e >> 2)][e & 3]; const float hh = bf2f(f2bf16(s)); hi8[e] = hh; lo8[e] = s - hh; }
            const v4u ph = pack8(hi8), pl = pack8(lo8); bh_[ks] = __builtin_bit_cast(bf16x8, ph); bl_[ks] = __builtin_bit_cast(bf16x8, pl); }
        float* yb = Y + ((size_t)(b * SEQ + c * 64)) * RWW + h * 64 + 16 * vq + fr;
#pragma unroll
        for (int mt = 0; mt < 4; ++mt) {
            bf16x8 am[2], aq[2];
#pragma unroll
            for (int ks = 0; ks < 2; ++ks) { const v4u a = {cur.mq[0][mt][ks][0].x, cur.mq[0][mt][ks][0].y, cur.mq[0][mt][ks][1].x, cur.mq[0][mt][ks][1].y};
                const v4u q = {cur.mq[1][mt][ks][0].x, cur.mq[1][mt][ks][0].y, cur.mq[1][mt][ks][1].x, cur.mq[1][mt][ks][1].y};
                am[ks] = __builtin_bit_cast(bf16x8, a); aq[ks] = __builtin_bit_cast(bf16x8, q); }
            f32x4 y = cur.nz[1][mt];
            y = MFMA16(aq[0], bh_[0], y); y = MFMA16(aq[1], bh_[1], y); y = MFMA16(aq[0], bl_[0], y); y = MFMA16(aq[1], bl_[1], y);
#pragma unroll
            for (int j = 0; j < 4; ++j) yb[(size_t)(16 * mt + 4 * fq + j) * RWW] = y[j];
            f32x4 sn = cur.nz[0][mt];
            sn = MFMA16(am[0], bh_[0], sn); sn = MFMA16(am[1], bh_[1], sn); sn = MFMA16(am[0], bl_[0], sn); sn = MFMA16(am[1], bl_[1], sn);
            cur.nz[0][mt] = sn;
        }
#pragma unroll
        for (int mt = 0; mt < 4; ++mt) S[mt] = cur.nz[0][mt];
        if (c + 1 < 64) cur = nxt;
    }
}
}

struct Args { const float* in[29]; float* out; unsigned char* ws; int ph_lo, ph_hi; };
enum { I_X = 0, I_LNINW, I_LNINB, I_WIN, I_MU, I_W0, I_W2, I_A0, I_A2, I_G2, I_KK, I_KA, I_RK, I_GNW, I_GNB, I_BF, I_QN, I_KN, I_WO, I_LN1W, I_LN1B, I_RW, I_RB, I_W1, I_B1, I_EW2, I_B2, I_LN2W, I_LN2B };
constexpr int N_PHASES = 11;

__global__ void __launch_bounds__(NTHR, 2) fwd_kernel(Args args) {
    extern __shared__ __attribute__((aligned(16))) unsigned char lds_raw[];
    LAS unsigned char* lds = (LAS unsigned char*)lds_raw;
    volatile LAS unsigned* MISC = (volatile LAS unsigned*)(lds + CTRL_OFF + LC_MISC);
    const int tid = threadIdx.x, lane = tid & 63, wave = __builtin_amdgcn_readfirstlane(tid >> 6);
    const int G = gridDim.x, bx = blockIdx.x;
    const int gw = bx * NWAVES + wave, NGW = G * NWAVES;
    unsigned char* ws = args.ws;
    gu32* ctl = (gu32*)(ws + WS_CTL);
    for (int u = tid; u < (LDS_BYTES - CTRL_OFF) / 4; u += NTHR) ((LAS unsigned*)(lds + CTRL_OFF))[u] = 0u;
    __syncthreads();
    const int lo = args.ph_lo, hi = args.ph_hi;
    const bool multi = (hi - lo) > 1;
    XcdBarrier bar; bar.bar = (unsigned*)(ctl + CW_BAR); bar.x = 0; bar.st = nullptr;
    if (multi) bar = xcd_barrier_post((unsigned*)(ctl + CW_BAR), MISC + 8);
#define IN(k) (lo <= (k) && (k) < hi)
#define SEAM(k) do { if (IN(k) && IN((k) + 1)) xcd_barrier(bar); } while (0)

    bf16* WIN_T = (bf16*)(ws + WS_WIN); bf16* WO_T = (bf16*)(ws + WS_WO); bf16* W1T = (bf16*)(ws + WS_W1T); bf16* W2T = (bf16*)(ws + WS_W2T);
    bf16* HB = (bf16*)(ws + WS_HB); float* HF = (float*)(ws + WS_HF); float* PROJ = (float*)(ws + WS_PROJ);
    float* GB = (float*)(ws + WS_G); float* BONUS = (float*)(ws + WS_BONUS);
    bf16* QB = (bf16*)(ws + WS_QB); bf16* KB = (bf16*)(ws + WS_KB); bf16* VB = (bf16*)(ws + WS_VB); bf16* MIX = (bf16*)(ws + WS_MIX);
    bf16* MC = (bf16*)(ws + WS_MC); float* NT = (float*)(ws + WS_NT); bf16* QC = (bf16*)(ws + WS_QC); float* ZT = (float*)(ws + WS_ZT); float* YB = (float*)(ws + WS_Y);
    float* LOGF = (float*)(ws + WS_LOGF);
    int* AE = (int*)(ws + WS_AE); int* APOS = (int*)(ws + WS_APOS); float* AGATE = (float*)(ws + WS_AGATE); int* AROW = (int*)(ws + WS_AROW); float* ROWGATE = (float*)(ws + WS_ROWGATE);
    bf16* XS = (bf16*)(ws + WS_XS); bf16* ACT = (bf16*)(ws + WS_ACT); bf16* EOUT = (bf16*)(ws + WS_EOUT);

    if (IN(0)) {
        LAS float* scr = (LAS float*)(lds + wave * 16384);
        constexpr int I_IN = 16 * 120, I_O = 16 * 32, I_1 = 16 * 64, I_2 = 16 * 32;
        constexpr int NITEMS = I_IN + I_O + NE * I_1 + NE * I_2;
        for (int it = gw; it < NITEMS; it += NGW) {
            int r = it;
            if (r < I_IN) { transpose_item(args.in[I_WIN], D, IN_COLS, 120, WIN_T, scr, r, lane); continue; } r -= I_IN;
            if (r < I_O) { transpose_item(args.in[I_WO], D, D, 32, WO_T, scr, r, lane); continue; } r -= I_O;
            if (r < NE * I_1) { const int e = r / I_1; transpose_item(args.in[I_W1] + (size_t)e * D * 2048, D, 2048, 64, W1T + (size_t)e * 2048 * D, scr, r - e * I_1, lane); continue; } r -= NE * I_1;
            { const int e = r / I_2; transpose_item(args.in[I_EW2] + (size_t)e * D * D, D, D, 32, W2T + (size_t)e * D * D, scr, r - e * I_2, lane); }
        }
        for (int m = gw; m < M; m += NGW) { f32x4 v[4];
#pragma unroll
            for (int j = 0; j < 4; ++j) v[j] = *(const f32x4*)(args.in[I_X] + (size_t)m * D + 4 * lane + 256 * j);
            ln_finish(v, args.in[I_LNINW], args.in[I_LNINB], lane, HF + (size_t)m * D, HB + (size_t)m * D); }
    }
    SEAM(0);
    if (IN(1)) {
        pg8::Gemm g{HB, WIN_T, M, PL, D}; pg8::StaticOrder S; S.init(M, PL, G, bx);
        pg8::EpiF32 E{PROJ, PL};
        pg8::gemm_phase<pg8::EpiF32, pg8::StaticOrder, true, true>(lds + RING_OFF, g, S, E);
    }
    SEAM(1);
    if (IN(2)) {
        rwk::Ptrs P{PROJ, args.in[I_MU], args.in[I_W0], args.in[I_W2], args.in[I_A0], args.in[I_A2], args.in[I_G2], args.in[I_KK], args.in[I_KA], args.in[I_RK], GB, BONUS, MC, NT, QC, ZT};
        for (int un = bx; un < BATCH * NH * 64; un += G) rwk::unit(lds, un, P);
        const float* qn = args.in[I_QN]; const float* kn = args.in[I_KN]; const float* bfp = args.in[I_BF];
        for (int m = gw; m < M; m += NGW) {
            const float* pr = PROJ + (size_t)m * PL; const int d0 = (8 * lane) & 63;
            float q[8], k[8], v[8]; float sq = 0.f, sk = 0.f;
#pragma unroll
            for (int hf = 0; hf < 2; ++hf) { const f32x4 a = *(const f32x4*)(pr + C_FQ + 8 * lane + 4 * hf), b = *(const f32x4*)(pr + C_FK + 8 * lane + 4 * hf), c = *(const f32x4*)(pr + C_FV + 8 * lane + 4 * hf);
#pragma unroll
                for (int i = 0; i < 4; ++i) { q[4 * hf + i] = a[i]; k[4 * hf + i] = b[i]; v[4 * hf + i] = c[i]; sq += a[i] * a[i]; sk += b[i] * b[i]; } }
            sq += __shfl_xor(sq, 1); sq += __shfl_xor(sq, 2); sq += __shfl_xor(sq, 4);
            sk += __shfl_xor(sk, 1); sk += __shfl_xor(sk, 2); sk += __shfl_xor(sk, 4);
            const float rq = rsqrtf(sq * (1.f / 64.f) + QK_EPS) * attn_body::C2, rk = rsqrtf(sk * (1.f / 64.f) + QK_EPS);
#pragma unroll
            for (int i = 0; i < 8; ++i) { q[i] = q[i] * rq * qn[d0 + i]; k[i] = k[i] * rk * kn[d0 + i]; }
            *(v4u*)(QB + (size_t)m * 512 + 8 * lane) = pack8(q); *(v4u*)(KB + (size_t)m * 512 + 8 * lane) = pack8(k); *(v4u*)(VB + (size_t)m * 512 + 8 * lane) = pack8(v);
            if (lane < 8) { const float z = pr[C_FZ + lane] + bfp[lane]; const float lf = fminf(z, 0.f) - log1pf(__expf(-fabsf(z)));
                const int b = m >> 12, t = m & 4095; LOGF[(size_t)(b * NH + lane) * SEQ + t] = lf; }
        }
    }
    SEAM(2);
    if (IN(3)) {
        if (bx < 16) { rwk::chain(2 * bx + (wave >> 2), wave & 3, MC, QC, NT, ZT, YB); }
        else {
            const attn_body::AttnTensors AT{(const attn_body::bf16*)QB, (const attn_body::bf16*)KB, (const attn_body::bf16*)VB, (attn_body::bf16*)(MIX + 512), LOGF, PROJ};
            attn_body::attn_phase<8>((char*)lds_raw + RING_OFF, AT, (unsigned*)(ctl + CW_ATTQ), MISC + 16);
        }
    }
    SEAM(3);
    if (IN(4)) {
        const float* gnw = args.in[I_GNW]; const float* gnb = args.in[I_GNB];
        for (int m = gw; m < M; m += NGW) {
            const size_t o = (size_t)m * RWW + 8 * lane; float y[8], g[8], bo[8];
#pragma unroll
            for (int hf = 0; hf < 2; ++hf) { const f32x4 a = *(const f32x4*)(YB + o + 4 * hf), b = *(const f32x4*)(GB + o + 4 * hf), c = *(const f32x4*)(BONUS + o + 4 * hf);
#pragma unroll
                for (int i = 0; i < 4; ++i) { y[4 * hf + i] = a[i]; g[4 * hf + i] = b[i]; bo[4 * hf + i] = c[i]; } }
            float s = 0.f;
#pragma unroll
            for (int i = 0; i < 8; ++i) s += y[i];
            s += __shfl_xor(s, 1); s += __shfl_xor(s, 2); s += __shfl_xor(s, 4);
            const float mean = s * (1.f / 64.f); float s2 = 0.f;
#pragma unroll
            for (int i = 0; i < 8; ++i) { y[i] -= mean; s2 += y[i] * y[i]; }
            s2 += __shfl_xor(s2, 1); s2 += __shfl_xor(s2, 2); s2 += __shfl_xor(s2, 4);
            const float rstd = rsqrtf(s2 * (1.f / 64.f) + GN_EPS);
#pragma unroll
            for (int i = 0; i < 8; ++i) y[i] = (y[i] * rstd * gnw[8 * lane + i] + gnb[8 * lane + i] + bo[i]) * g[i];
            *(v4u*)(MIX + (size_t)m * D + 8 * lane) = pack8(y);
        }
    }
    SEAM(4);
    if (IN(5)) {
        pg8::Gemm g{MIX, WO_T, M, D, D}; pg8::StaticOrder S; S.init(M, D, G, bx);
        pg8::EpiResid E{HF, D, ALPHA};
        pg8::gemm_phase<pg8::EpiResid, pg8::StaticOrder, true, true>(lds + RING_OFF, g, S, E);
    }
    SEAM(5);
    if (IN(6)) {
        LAS float* XR = (LAS float*)lds; LAS float* LG = (LAS float*)(lds + 32768);
        LAS unsigned* HIST = (LAS unsigned*)(lds + CTRL_OFF + LC_HIST); LAS unsigned* BASE = (LAS unsigned*)(lds + CTRL_OFF + LC_BASE);
        LAS int* RI_E = (LAS int*)(lds + CTRL_OFF + LC_ROWINFO); LAS int* RI_P = RI_E + 256; LAS float* RI_G = (LAS float*)(RI_P + 256);
        const float* rw = args.in[I_RW]; const float* rb = args.in[I_RB];
        f32x4 wreg[16];
#pragma unroll
        for (int jj = 0; jj < 16; ++jj) wreg[jj] = *(const f32x4*)(rw + (size_t)(lane + 64 * jj) * NE + 4 * wave);
        if (tid < NE) HIST[tid] = 0u;
        __syncthreads();
        for (int r0 = bx * 64; r0 < M; r0 += G * 64) {
            for (int bb = 0; bb < 8; ++bb) {
                const int m = r0 + 8 * bb + wave; f32x4 v[4];
#pragma unroll
                for (int j = 0; j < 4; ++j) v[j] = *(const f32x4*)(HF + (size_t)m * D + 4 * lane + 256 * j);
                ln_finish(v, args.in[I_LN1W], args.in[I_LN1B], lane, HF + (size_t)m * D, HB + (size_t)m * D);
#pragma unroll
                for (int j = 0; j < 4; ++j) *(LAS f32x4*)(XR + wave * 1024 + 4 * lane + 256 * j) = v[j];
                __syncthreads();
                float part[32];
#pragma unroll
                for (int i = 0; i < 32; ++i) part[i] = 0.f;
#pragma unroll
                for (int rr = 0; rr < 8; ++rr)
#pragma unroll
                    for (int jj = 0; jj < 16; ++jj) { const float x = XR[rr * 1024 + lane + 64 * jj];
                        part[4 * rr + 0] += x * wreg[jj][0]; part[4 * rr + 1] += x * wreg[jj][1]; part[4 * rr + 2] += x * wreg[jj][2]; part[4 * rr + 3] += x * wreg[jj][3]; }
#define RS_STEP(N, OFF) { const bool up = (lane & (OFF)) != 0; _Pragma("unroll") for (int k = 0; k < (N); ++k) { const float send = up ? part[k] : part[k + (N)]; const float keep = up ? part[k + (N)] : part[k]; part[k] = keep + __shfl_xor(send, (OFF)); } }
                RS_STEP(16, 32) RS_STEP(8, 16) RS_STEP(4, 8) RS_STEP(2, 4) RS_STEP(1, 2)
#undef RS_STEP
                part[0] += __shfl_xor(part[0], 1);
                if ((lane & 1) == 0) { const int idx = ((lane >> 5) << 4) | (((lane >> 4) & 1) << 3) | (((lane >> 3) & 1) << 2) | (((lane >> 2) & 1) << 1) | ((lane >> 1) & 1);
                    const int rr = idx >> 2, ee = idx & 3; LG[rr * 32 + 4 * wave + ee] = part[0] + rb[4 * wave + ee]; }
                __syncthreads();
                float val = (lane < NE) ? LG[wave * 32 + lane] : -INFINITY; float tv[4]; int ti[4];
#pragma unroll
                for (int rd = 0; rd < 4; ++rd) { float bv = val; int bi = lane;
#pragma unroll
                    for (int o = 32; o >= 1; o >>= 1) { const float ov = __shfl_xor(bv, o); const int oi = __shfl_xor(bi, o); if (ov > bv || (ov == bv && oi < bi)) { bv = ov; bi = oi; } }
                    tv[rd] = bv; ti[rd] = bi; if (lane == bi) val = -INFINITY; }
                if (lane == 0) { const float e1 = __expf(tv[1] - tv[0]), e2 = __expf(tv[2] - tv[0]), e3 = __expf(tv[3] - tv[0]); const float inv = 1.f / (1.f + e1 + e2 + e3);
                    const float gt[4] = {inv, e1 * inv, e2 * inv, e3 * inv}; const int rl = 8 * bb + wave;
#pragma unroll
                    for (int j = 0; j < 4; ++j) { const unsigned p = __hip_atomic_fetch_add(HIST + ti[j], 1u, __ATOMIC_RELAXED, __HIP_MEMORY_SCOPE_WORKGROUP); RI_E[rl * 4 + j] = ti[j]; RI_P[rl * 4 + j] = (int)p; RI_G[rl * 4 + j] = gt[j]; } }
            }
            __syncthreads();
            if (tid < NE) { BASE[tid] = __hip_atomic_fetch_add((unsigned*)(ctl + CW_ECNT) + tid, HIST[tid], __ATOMIC_RELAXED, __HIP_MEMORY_SCOPE_AGENT); HIST[tid] = 0u; }
            __syncthreads();
            if (tid < 256) { const int e = RI_E[tid]; const size_t a = (size_t)r0 * 4 + tid; AE[a] = e; APOS[a] = (int)BASE[e] + RI_P[tid]; AGATE[a] = RI_G[tid]; }
            __syncthreads();
        }
    }
    SEAM(6);
#define TILE_TABLE() do { if (tid == 0) { LAS int* TS = (LAS int*)(lds + CTRL_OFF + LC_TSTART); LAS unsigned char* TE = (LAS unsigned char*)(lds + CTRL_OFF + LC_TEXP); int t_ = 0; \
        for (int e = 0; e < NE; ++e) { const int cnt = (int)__hip_atomic_load((unsigned*)(ctl + CW_ECNT) + e, __ATOMIC_RELAXED, __HIP_MEMORY_SCOPE_AGENT); TS[e] = t_; const int nt_ = (cnt + 255) >> 8; \
            for (int k = 0; k < nt_; ++k) TE[t_ + k] = (unsigned char)e; t_ += nt_; } MISC[17] = (unsigned)t_; } __syncthreads(); } while (0)
    if (IN(7)) {
        TILE_TABLE();
        const LAS int* TS = (const LAS int*)(lds + CTRL_OFF + LC_TSTART);
        for (int a = gw; a < NASSIGN; a += NGW) {
            const int e = AE[a], row = TS[e] * 256 + APOS[a];
            const v4u* src = (const v4u*)(HB + (size_t)(a >> 2) * D); v4u* dst = (v4u*)(XS + (size_t)row * D);
            dst[lane] = src[lane]; dst[lane + 64] = src[lane + 64];
            if (lane == 0) { ROWGATE[row] = AGATE[a]; AROW[a] = row; }
        }
    }
    SEAM(7);
    if (IN(8)) {
        TILE_TABLE();
        pg8::Gemm g{XS, W1T, XROWS, 2048, D}; pg8::MoeOrder S{(const PG8_LAS unsigned char*)(lds + CTRL_OFF + LC_TEXP), (int)MISC[17], 8, G, bx};
        pg8::EpiSwiglu E{ACT, D, args.in[I_B1]};
        pg8::gemm_phase<pg8::EpiSwiglu, pg8::MoeOrder, true, true>(lds + RING_OFF, g, S, E);
    }
    SEAM(8);
    if (IN(9)) {
        TILE_TABLE();
        pg8::Gemm g{ACT, W2T, XROWS, D, D}; pg8::MoeOrder S{(const PG8_LAS unsigned char*)(lds + CTRL_OFF + LC_TEXP), (int)MISC[17], 4, G, bx};
        pg8::EpiGate E{EOUT, D, args.in[I_B2], ROWGATE};
        pg8::gemm_phase<pg8::EpiGate, pg8::MoeOrder, true, true>(lds + RING_OFF, g, S, E);
    }
    SEAM(9);
    if (IN(10)) {
        for (int m = gw; m < M; m += NGW) { f32x4 v[4];
#pragma unroll
            for (int j = 0; j < 4; ++j) v[j] = *(const f32x4*)(HF + (size_t)m * D + 4 * lane + 256 * j) * ALPHA;
#pragma unroll
            for (int s = 0; s < 4; ++s) { const int row = AROW[m * 4 + s]; const bf16* er = EOUT + (size_t)row * D;
#pragma unroll
                for (int j = 0; j < 4; ++j) { const u32x2v w = *(const u32x2v*)(er + 4 * lane + 256 * j);
                    v[j].x += __uint_as_float(w.x << 16); v[j].y += __uint_as_float(w.x & 0xffff0000u); v[j].z += __uint_as_float(w.y << 16); v[j].w += __uint_as_float(w.y & 0xffff0000u); } }
            ln_finish(v, args.in[I_LN2W], args.in[I_LN2B], lane, args.out + (size_t)m * D, nullptr); }
    }
#undef IN
#undef SEAM
#undef TILE_TABLE
}

#ifndef MK_ONE_LAUNCH
#define MK_ONE_LAUNCH 0
#endif
extern "C" void kernel_launch(void* const* d_in, const int* in_sizes, int n_in, void* d_out, int out_size, void* d_ws, size_t ws_size, hipStream_t stream) {
    static int grid = 0;
    if (grid == 0) {
        if (n_in != 29 || in_sizes[0] != M * D || out_size != M * D || ws_size < WS_END) { fprintf(stderr, "kernel_launch: unexpected shapes (n_in %d, in0 %d, out %d, ws %zu); nothing launched\n", n_in, n_in > 0 ? in_sizes[0] : -1, out_size, ws_size); grid = -1; return; }
        int dev = 0, cus = 0, per_cu = 0;
        if (hipGetDevice(&dev) != hipSuccess || hipDeviceGetAttribute(&cus, hipDeviceAttributeMultiprocessorCount, dev) != hipSuccess) { grid = -1; return; }
        if (hipFuncSetAttribute((const void*)fwd_kernel, hipFuncAttributeMaxDynamicSharedMemorySize, LDS_BYTES) != hipSuccess) { fprintf(stderr, "kernel_launch: hipFuncSetAttribute failed\n"); grid = -1; return; }
        if (hipOccupancyMaxActiveBlocksPerMultiprocessor(&per_cu, (const void*)fwd_kernel, NTHR, LDS_BYTES) != hipSuccess || per_cu < 1) fprintf(stderr, "kernel_launch: occupancy query reports %d\n", per_cu);
        (void)hipGetLastError();
        grid = cus;
        if (grid < 32) { grid = -1; return; }
    }
    if (grid < 0) return;
    if (hipMemsetAsync((char*)d_ws + WS_CTL, 0, CTL_ZERO_BYTES, stream) != hipSuccess) return;
    Args a{};
    for (int i = 0; i < 29; ++i) a.in[i] = (const float*)d_in[i];
    a.out = (float*)d_out; a.ws = (unsigned char*)d_ws;
#if MK_ONE_LAUNCH
    a.ph_lo = 0; a.ph_hi = N_PHASES;
    hipLaunchKernelGGL(fwd_kernel, dim3(grid), dim3(NTHR), LDS_BYTES, stream, a);
#else
    for (int p = 0; p < N_PHASES; ++p) { a.ph_lo = p; a.ph_hi = p + 1; hipLaunchKernelGGL(fwd_kernel, dim3(grid), dim3(NTHR), LDS_BYTES, stream, a); }
#endif
}
```

```cpp
#include <hip/hip_runtime.h>
#include <hip/hip_bf16.h>
#include <cstdio>
#include <cstdint>
#include <cmath>

namespace pg8 {
#define PG8_LAS __attribute__((address_space(3)))
typedef unsigned short bf16_t;
typedef short bf16x8 __attribute__((ext_vector_type(8)));
typedef float f32x4 __attribute__((ext_vector_type(4)));
typedef unsigned u32x4 __attribute__((ext_vector_type(4)));
typedef unsigned u32x2 __attribute__((ext_vector_type(2)));
constexpr int BM = 256, BK = 64, HALF = 128, HTB = HALF * BK * 2  , STAGE_BYTES = 8 * HTB, NXCD = 8, WGM = 8;

__host__ __device__ __forceinline__ int lds_byte(int r, int c) { const int st = (r >> 4) * 2 + (c >> 5), rr = r & 15, cc = c & 31, ob = rr * 64 + cc * 2; return st * 1024 + (ob ^ (((ob >> 9) & 1) << 5)); }
__host__ __device__ __forceinline__ void stage_rc(int b, int& R, int& C) { const int st = b / 1024, sb = b % 1024, swz = sb ^ (((sb >> 9) & 1) << 5); R = (st >> 1) * 16 + swz / 64; C = (st & 1) * 32 + (swz % 64) / 2; }
__host__ __device__ __forceinline__ int perm32(int rho) { const int n = rho >> 4, i = rho & 15; return 8 * (i >> 2) + 4 * n + (i & 3); }

struct Unit { int pm, pn, pb, pe; };
struct Gemm { const bf16_t* A; const bf16_t* Bt; int M, N, K; };

struct StaticOrder {
    static constexpr bool GATHER = false, PREFETCH_B = false;
    __device__ __forceinline__ int arow(int, int) const { return 0; }
    int nM, nN, nwg, G, c;
    __host__ __device__ void init(int M, int N, int G_, int c_) { nM = M / BM; nN = N / BM; nwg = nM * nN; G = G_; c = c_; }
    __host__ __device__ bool next(int i, Unit& u) const {
        const long L = (long)i * G + c; if (L >= nwg) return false;
        int wgid = (int)L; { const int q = nwg / NXCD, r = nwg % NXCD, xcd = wgid % NXCD, off = wgid / NXCD; wgid = (xcd < r ? xcd * (q + 1) : r * (q + 1) + (xcd - r) * q) + off; }
        const int nig = WGM * nN, gid = wgid / nig, fm = gid * WGM, gsz = (nM - fm) < WGM ? (nM - fm) : WGM;
        u.pm = fm + ((wgid % nig) % gsz); u.pn = (wgid % nig) / gsz; u.pb = u.pn; u.pe = 0; return true;
    }
};
template <bool GATHER_> struct MoeOrder {
    static constexpr bool GATHER = GATHER_, PREFETCH_B = false;
    const PG8_LAS unsigned char* texp; const PG8_LAS int* ts; int ntiles, nN, G, c; const PG8_LAS int* rowtab;
    __device__ __forceinline__ int arow(int ui, int r) const { return rowtab[ui * 256 + r]; }
    __device__ __forceinline__ bool next(int i, Unit& u) const {
        int rt, pn;
        if ((G & 7) == 0) { const int x = c & 7, ng = G >> 3, t0 = (x * ntiles) >> 3, t1 = ((x + 1) * ntiles) >> 3; const int k = i * ng + (c >> 3); if (k >= (t1 - t0) * nN) return false; rt = t0 + k / nN; pn = k - (k / nN) * nN; }
        else { const int L = i * G + c; if (L >= ntiles * nN) return false; rt = L / nN; pn = L - rt * nN; }
        const int e = texp[rt];
        u.pm = rt; u.pn = pn; u.pb = e * nN + pn; u.pe = e; return true;
    }
};

typedef float f32x2c_ __attribute__((ext_vector_type(2))); typedef __bf16 bf16x2c_ __attribute__((ext_vector_type(2)));
__device__ __forceinline__ unsigned cvt_pk_bf16(float lo, float hi) { const f32x2c_ v = {lo, hi}; const bf16x2c_ b = __builtin_convertvector(v, bf16x2c_); return __builtin_bit_cast(unsigned, b); }

struct EpiF32 {
    static constexpr bool PERM = false;
    float* O; int ldc;
    __device__ __forceinline__ void operator()(const f32x4 (&acc)[2][2][4][2], const Unit& u, int wr, int wc, int fr, int fq) const {
        const int row0 = u.pm * BM + wr * 64 + fr, col0 = u.pn * BM + wc * 32 + 4 * fq;
#pragma unroll
        for (int ai = 0; ai < 2; ++ai)
#pragma unroll
            for (int m = 0; m < 4; ++m) { float* rowp = O + (size_t)(row0 + ai * HALF + m * 16) * ldc + col0;
#pragma unroll
                for (int bj = 0; bj < 2; ++bj)
#pragma unroll
                    for (int n = 0; n < 2; ++n) *(f32x4*)(rowp + bj * HALF + n * 16) = acc[ai][bj][m][n]; }
    }
};
struct EpiBf16 {
    static constexpr bool PERM = true;
    bf16_t* O; int ldc;
    __device__ __forceinline__ void operator()(const f32x4 (&acc)[2][2][4][2], const Unit& u, int wr, int wc, int fr, int fq) const {
        const int row0 = u.pm * BM + wr * 64 + fr, col0 = u.pn * BM + wc * 32 + 8 * fq;
#pragma unroll
        for (int ai = 0; ai < 2; ++ai)
#pragma unroll
            for (int m = 0; m < 4; ++m) { bf16_t* rowp = O + (size_t)(row0 + ai * HALF + m * 16) * ldc + col0;
#pragma unroll
                for (int bj = 0; bj < 2; ++bj) { const f32x4 v0 = acc[ai][bj][m][0], v1 = acc[ai][bj][m][1];
                    u32x4 w; w.x = cvt_pk_bf16(v0[0], v0[1]); w.y = cvt_pk_bf16(v0[2], v0[3]); w.z = cvt_pk_bf16(v1[0], v1[1]); w.w = cvt_pk_bf16(v1[2], v1[3]);
                    *(u32x4*)(rowp + bj * HALF) = w; } }
    }
};
struct EpiResid {
    static constexpr bool PERM = false;
    const bf16_t* I; float* O; int ldc; float alpha;
    __device__ __forceinline__ void operator()(const f32x4 (&acc)[2][2][4][2], const Unit& u, int wr, int wc, int fr, int fq) const {
        const int row0 = u.pm * BM + wr * 64 + fr, col0 = u.pn * BM + wc * 32 + 4 * fq;
#pragma unroll
        for (int ai = 0; ai < 2; ++ai)
#pragma unroll
            for (int m = 0; m < 4; ++m) { const size_t ro = (size_t)(row0 + ai * HALF + m * 16) * ldc + col0;
#pragma unroll
                for (int bj = 0; bj < 2; ++bj)
#pragma unroll
                    for (int n = 0; n < 2; ++n) { const u32x2 w = *(const u32x2*)(I + ro + bj * HALF + n * 16); const f32x4 o = {__uint_as_float(w.x << 16), __uint_as_float(w.x & 0xffff0000u), __uint_as_float(w.y << 16), __uint_as_float(w.y & 0xffff0000u)};
                        *(f32x4*)(O + ro + bj * HALF + n * 16) = o * alpha + acc[ai][bj][m][n]; } }
    }
};
__device__ __forceinline__ float swiglu1(float g, float l) {
    g = fminf(g, 7.0f); l = fminf(fmaxf(l, -7.0f), 7.0f);
    const float s = __builtin_amdgcn_rcpf(1.0f + __builtin_amdgcn_exp2f(-1.702f * 1.4426950408889634f * g));
    return g * s * (l + 1.0f);
}
struct EpiSwiglu {
    static constexpr bool PERM = true;
    bf16_t* O; int ldc; const float* b1;
    __device__ __forceinline__ void operator()(const f32x4 (&acc)[2][2][4][2], const Unit& u, int wr, int wc, int fr, int fq) const {
        const int row0 = u.pm * BM + wr * 64 + fr; const int cl0 = u.pn * BM + wc * 32 + 8 * fq;
        const float* bp = b1 + (size_t)u.pe * 2048 + cl0;
        f32x4 bv[2][2];
#pragma unroll
        for (int bj = 0; bj < 2; ++bj)
#pragma unroll
            for (int n = 0; n < 2; ++n) bv[bj][n] = *(const f32x4*)(bp + bj * HALF + 4 * n);
#pragma unroll
        for (int ai = 0; ai < 2; ++ai)
#pragma unroll
            for (int m = 0; m < 4; ++m) { bf16_t* rowp = O + (size_t)(row0 + ai * HALF + m * 16) * ldc + (cl0 >> 1);
#pragma unroll
                for (int bj = 0; bj < 2; ++bj) { const f32x4 v0 = acc[ai][bj][m][0] + bv[bj][0], v1 = acc[ai][bj][m][1] + bv[bj][1];
                    u32x2 w; w.x = cvt_pk_bf16(swiglu1(v0[0], v0[1]), swiglu1(v0[2], v0[3])); w.y = cvt_pk_bf16(swiglu1(v1[0], v1[1]), swiglu1(v1[2], v1[3]));
                    *(u32x2*)(rowp + bj * (HALF / 2)) = w; } }
    }
};
struct EpiGate {
    static constexpr bool PERM = true;
    bf16_t* O; int ldc; const float* b2; const float* gate;
    __device__ __forceinline__ void operator()(const f32x4 (&acc)[2][2][4][2], const Unit& u, int wr, int wc, int fr, int fq) const {
        const int row0 = u.pm * BM + wr * 64 + fr; const int col0 = u.pn * BM + wc * 32 + 8 * fq;
        const float* bp = b2 + (size_t)u.pe * 1024 + col0;
        f32x4 bv[2][2];
#pragma unroll
        for (int bj = 0; bj < 2; ++bj)
#pragma unroll
            for (int n = 0; n < 2; ++n) bv[bj][n] = *(const f32x4*)(bp + bj * HALF + 4 * n);
#pragma unroll
        for (int ai = 0; ai < 2; ++ai)
#pragma unroll
            for (int m = 0; m < 4; ++m) { const int row = row0 + ai * HALF + m * 16; const float gt = gate[row]; bf16_t* rowp = O + (size_t)row * ldc + col0;
#pragma unroll
                for (int bj = 0; bj < 2; ++bj) { const f32x4 v0 = (acc[ai][bj][m][0] + bv[bj][0]) * gt, v1 = (acc[ai][bj][m][1] + bv[bj][1]) * gt;
                    u32x4 w; w.x = cvt_pk_bf16(v0[0], v0[1]); w.y = cvt_pk_bf16(v0[2], v0[3]); w.z = cvt_pk_bf16(v1[0], v1[1]); w.w = cvt_pk_bf16(v1[2], v1[3]);
                    *(u32x4*)(rowp + bj * HALF) = w; } }
    }
};
struct NoSide { __device__ __forceinline__ void pre(const Unit&) {} __device__ __forceinline__ void post(const Unit&) {} };
template <class Epi, class Sched, bool ALIGN_EPI, bool SP2, class Side>
__device__ __forceinline__ void gemm_phase(PG8_LAS unsigned char* lds, const Gemm g, const Sched& S, const Epi& E, Side& side) {
    const int tid = threadIdx.x, wid = __builtin_amdgcn_readfirstlane(tid >> 6), lane = tid & 63, wr = wid >> 2, wc = wid & 3, fr = lane & 15, fq = lane >> 4;
    const int K = g.K, nt = K / BK;
    unsigned voffA[2], voffB[2]; int RA[2];
#pragma unroll
    for (int i = 0; i < 2; ++i) { int R, C; stage_rc(tid * 16 + i * 8192, R, C); const int Rb = Epi::PERM ? ((R & ~31) + perm32(R & 31)) : R; RA[i] = R;
        voffA[i] = (unsigned)(R * K + C) * 2u; voffB[i] = (unsigned)(Rb * K + C) * 2u; }
    unsigned vA[2][2], vAn[2][2];
#define PG8_AOFF(dst, UI) do { _Pragma("unroll") for (int h_ = 0; h_ < 2; ++h_) _Pragma("unroll") for (int i_ = 0; i_ < 2; ++i_) \
        dst[h_][i_] = Sched::GATHER ? ((unsigned)S.arow((UI), h_ * HALF + RA[i_]) * (unsigned)(K * 2) + (voffA[i_] - (unsigned)(RA[i_] * K) * 2u)) : (voffA[i_] + (unsigned)h_ * (unsigned)(HALF * K * 2)); } while (0)
    const size_t kstep = (size_t)(BK * 2);
    const size_t hstep = (size_t)HALF * K * 2;
    const size_t tstep = 2 * hstep;
    const unsigned ldsw = (unsigned)wid * 1024u;
    const int aoff = lds_byte(wr * 64 + fr, fq * 8), boff = lds_byte(wc * 32 + fr, fq * 8);
#define PG8_SA(b, h) (((b) * 2 + (h)) * HTB)
#define PG8_SB(b, h) ((4 + (b) * 2 + (h)) * HTB)
#define PG8_STAGE(bufoff, gbase, voff) do { _Pragma("unroll") for (int _i = 0; _i < 2; ++_i) \
        __builtin_amdgcn_global_load_lds((const unsigned*)((const char*)(gbase) + (voff)[_i]), (PG8_LAS unsigned*)(lds + (bufoff) + ldsw + _i * 8192), 16, 0, 0); } while (0)
#define PG8_LDA(dst, b, h) do { _Pragma("unroll") for (int m = 0; m < 4; ++m) _Pragma("unroll") for (int k = 0; k < 2; ++k) dst[m][k] = *(const PG8_LAS bf16x8*)(lds + PG8_SA(b, h) + aoff + m * 2048 + k * 1024); } while (0)
#define PG8_LDB(dst, b, h) do { _Pragma("unroll") for (int n = 0; n < 2; ++n) _Pragma("unroll") for (int k = 0; k < 2; ++k) dst[n][k] = *(const PG8_LAS bf16x8*)(lds + PG8_SB(b, h) + boff + n * 2048 + k * 1024); } while (0)
#define PG8_MMA(ai, bj, At, Bt) do { __builtin_amdgcn_s_setprio(1); _Pragma("unroll") for (int m = 0; m < 4; ++m) _Pragma("unroll") for (int n = 0; n < 2; ++n) _Pragma("unroll") for (int k = 0; k < 2; ++k) \
        acc[ai][bj][m][n] = __builtin_amdgcn_mfma_f32_16x16x32_bf16(Bt[n][k], At[m][k], acc[ai][bj][m][n], 0, 0, 0); __builtin_amdgcn_s_setprio(0); } while (0)
#define PG8_WAIT_V(n) asm volatile("s_waitcnt vmcnt(" #n ")" ::: "memory")
#define PG8_WAIT_L(n) asm volatile("s_waitcnt lgkmcnt(" #n ")" ::: "memory")
#define PG8_BAR __builtin_amdgcn_s_barrier()
#define PG8_SCHED __builtin_amdgcn_sched_barrier(0)
    Unit cur, nxt; int ui = 0; unsigned pfd = 0u;
    if (!S.next(0, cur)) return;
    f32x4 acc[2][2][4][2];
#pragma unroll
    for (int a = 0; a < 2; ++a)
#pragma unroll
        for (int b = 0; b < 2; ++b)
#pragma unroll
            for (int m = 0; m < 4; ++m)
#pragma unroll
                for (int n = 0; n < 2; ++n) acc[a][b][m][n] = (f32x4){0.f, 0.f, 0.f, 0.f};
    bf16x8 At[4][2], B0[2][2], B1[2][2];
    const char* cA = (const char*)g.A + (Sched::GATHER ? (size_t)0 : (size_t)cur.pm * tstep); const char* cB = (const char*)g.Bt + (size_t)cur.pb * tstep;
    PG8_AOFF(vA, 0);
    if constexpr (SP2) {
        PG8_STAGE(PG8_SB(0, 0), cB, voffB); PG8_STAGE(PG8_SB(0, 1), cB + hstep, voffB); PG8_STAGE(PG8_SA(0, 0), cA, vA[0]); PG8_STAGE(PG8_SA(0, 1), cA, vA[1]);
        if (wr == 1) PG8_BAR;
        PG8_WAIT_V(2); PG8_BAR;
        PG8_STAGE(PG8_SB(1, 0), cB + kstep, voffB); PG8_STAGE(PG8_SA(1, 0), cA + kstep, vA[0]); PG8_STAGE(PG8_SB(1, 1), cB + hstep + kstep, voffB);
        PG8_WAIT_V(6); PG8_BAR;
    } else {
        PG8_STAGE(PG8_SB(0, 0), cB, voffB); PG8_STAGE(PG8_SA(0, 0), cA, vA[0]); PG8_STAGE(PG8_SB(0, 1), cB + hstep, voffB); PG8_STAGE(PG8_SA(0, 1), cA, vA[1]);
        if (wr == 1) PG8_BAR;
        PG8_WAIT_V(4); PG8_BAR;
        PG8_STAGE(PG8_SB(1, 0), cB + kstep, voffB); PG8_STAGE(PG8_SA(1, 0), cA + kstep, vA[0]); PG8_STAGE(PG8_SB(1, 1), cB + hstep + kstep, voffB);
        PG8_WAIT_V(6); PG8_BAR;
    }
    for (;;) {
        const bool has_next = S.next(ui + 1, nxt);
        if (has_next) PG8_AOFF(vAn, ui + 1); else { vAn[0][0] = vA[0][0]; vAn[0][1] = vA[0][1]; vAn[1][0] = vA[1][0]; vAn[1][1] = vA[1][1]; }
        const char* nA = has_next ? (const char*)g.A + (Sched::GATHER ? (size_t)0 : (size_t)nxt.pm * tstep) : cA;
        if constexpr (Sched::PREFETCH_B) {
            if (has_next && nxt.pb != cur.pb) { const char* pfb = (const char*)g.Bt + (size_t)nxt.pb * tstep + (size_t)tid * 128;
#pragma unroll
                for (int j_ = 0; j_ < 8; ++j_) asm volatile("global_load_dword %0, %1, off" : "+v"(pfd) : "v"(pfb + (size_t)j_ * 65536) : "memory"); } } const char* nB = has_next ? (const char*)g.Bt + (size_t)nxt.pb * tstep : cB;
        for (int t = 0; t < nt; t += 2) {
            const bool last = (t == nt - 2);
            const char* a1 = cA + (size_t)(t + 1) * kstep;
            const char* a2 = last ? nA : cA + (size_t)(t + 2) * kstep; const char* b2 = last ? nB : cB + (size_t)(t + 2) * kstep;
            const char* a3 = a2 + kstep; const char* b3 = b2 + kstep;
            unsigned vS[2][2]; vS[0][0] = last ? vAn[0][0] : vA[0][0]; vS[0][1] = last ? vAn[0][1] : vA[0][1]; vS[1][0] = last ? vAn[1][0] : vA[1][0]; vS[1][1] = last ? vAn[1][1] : vA[1][1];

            if constexpr (SP2) {
            PG8_LDB(B0, 0, 0); PG8_LDB(B1, 0, 1); PG8_SCHED; PG8_LDA(At, 0, 0); PG8_STAGE(PG8_SA(1, 1), a1, vA[1]);
            PG8_WAIT_V(8); PG8_WAIT_L(0); PG8_BAR; PG8_MMA(0, 0, At, B0); PG8_MMA(0, 1, At, B1); PG8_BAR; PG8_SCHED;
            PG8_LDA(At, 0, 1); PG8_STAGE(PG8_SB(0, 0), b2, voffB); PG8_STAGE(PG8_SB(0, 1), b2 + hstep, voffB); PG8_STAGE(PG8_SA(0, 0), a2, vS[0]);
            PG8_WAIT_V(8); PG8_WAIT_L(0); PG8_BAR; PG8_MMA(1, 0, At, B0); PG8_MMA(1, 1, At, B1); PG8_BAR; PG8_SCHED;
            PG8_LDB(B0, 1, 0); PG8_LDB(B1, 1, 1); PG8_SCHED; PG8_LDA(At, 1, 0); PG8_STAGE(PG8_SA(0, 1), a2, vS[1]);
            PG8_WAIT_V(8); PG8_WAIT_L(0); PG8_BAR; PG8_MMA(0, 0, At, B0); PG8_MMA(0, 1, At, B1); PG8_BAR; PG8_SCHED;
            PG8_LDA(At, 1, 1); PG8_STAGE(PG8_SB(1, 0), b3, voffB); PG8_STAGE(PG8_SB(1, 1), b3 + hstep, voffB); PG8_STAGE(PG8_SA(1, 0), a3, vS[0]);
            PG8_WAIT_V(8); PG8_WAIT_L(0); PG8_BAR; PG8_MMA(1, 0, At, B0); PG8_MMA(1, 1, At, B1); PG8_BAR; PG8_SCHED;
            } else {
            PG8_LDB(B0, 0, 0); PG8_SCHED; PG8_LDA(At, 0, 0); PG8_STAGE(PG8_SA(1, 1), a1, vA[1]);
            PG8_WAIT_L(8); PG8_BAR; PG8_WAIT_L(0); PG8_MMA(0, 0, At, B0); PG8_BAR; PG8_SCHED;
            PG8_LDB(B1, 0, 1); PG8_STAGE(PG8_SB(0, 0), b2, voffB);
            PG8_BAR; PG8_WAIT_L(0); PG8_MMA(0, 1, At, B1); PG8_BAR;
            PG8_LDA(At, 0, 1); PG8_STAGE(PG8_SA(0, 0), a2, vS[0]);
            PG8_BAR; PG8_WAIT_L(0); PG8_MMA(1, 0, At, B0); PG8_BAR; PG8_SCHED;
            PG8_STAGE(PG8_SB(0, 1), b2 + hstep, voffB);
            PG8_WAIT_V(6); PG8_BAR; PG8_MMA(1, 1, At, B1); PG8_BAR;
            PG8_LDB(B0, 1, 0); PG8_SCHED; PG8_LDA(At, 1, 0); PG8_STAGE(PG8_SA(0, 1), a2, vS[1]);
            PG8_WAIT_L(8); PG8_BAR; PG8_WAIT_L(0); PG8_MMA(0, 0, At, B0); PG8_BAR; PG8_SCHED;
            PG8_LDB(B1, 1, 1); PG8_STAGE(PG8_SB(1, 0), b3, voffB);
            PG8_BAR; PG8_WAIT_L(0); PG8_MMA(0, 1, At, B1); PG8_BAR;
            PG8_LDA(At, 1, 1); PG8_STAGE(PG8_SA(1, 0), a3, vS[0]);
            PG8_BAR; PG8_WAIT_L(0); PG8_MMA(1, 0, At, B0); PG8_BAR; PG8_SCHED;
            PG8_STAGE(PG8_SB(1, 1), b3 + hstep, voffB);
            PG8_WAIT_V(6); PG8_BAR; PG8_MMA(1, 1, At, B1); PG8_BAR;
            }
        }
        if constexpr (ALIGN_EPI) { if (wr == 0) PG8_BAR; }
        side.pre(cur); E(acc, cur, wr, wc, fr, fq); side.post(cur);
        if constexpr (Sched::PREFETCH_B) asm volatile("" : "+v"(pfd));
        if (!has_next) break;
#pragma unroll
        for (int a = 0; a < 2; ++a)
#pragma unroll
            for (int b = 0; b < 2; ++b)
#pragma unroll
                for (int m = 0; m < 4; ++m)
#pragma unroll
                    for (int n = 0; n < 2; ++n) acc[a][b][m][n] = (f32x4){0.f, 0.f, 0.f, 0.f};
        cur = nxt; cA = nA; cB = nB; ++ui; vA[0][0] = vAn[0][0]; vA[0][1] = vAn[0][1]; vA[1][0] = vAn[1][0]; vA[1][1] = vAn[1][1];
        if constexpr (ALIGN_EPI) { if (wr == 1) PG8_BAR; }
    }
    PG8_WAIT_V(0);
    if constexpr (!ALIGN_EPI) { if (wr == 0) PG8_BAR; }
    PG8_BAR;
#undef PG8_SA
#undef PG8_SB
#undef PG8_STAGE
#undef PG8_AOFF
#undef PG8_LDA
#undef PG8_LDB
#undef PG8_MMA
#undef PG8_WAIT_V
#undef PG8_WAIT_L
#undef PG8_BAR
#undef PG8_SCHED
}
template <class Epi, class Sched, bool ALIGN_EPI = false, bool SP2 = false>
__device__ __forceinline__ void gemm_phase(PG8_LAS unsigned char* lds, const Gemm g, const Sched& S, const Epi& E) { NoSide ns; gemm_phase<Epi, Sched, ALIGN_EPI, SP2, NoSide>(lds, g, S, E, ns); }
}
namespace attn_body {
using bf16=__hip_bfloat16;
using bf16x8=__attribute__((ext_vector_type(8)))short;
using s16x4=__attribute__((ext_vector_type(4)))short;
using f32x16=__attribute__((ext_vector_type(16)))float;
using u32x4=__attribute__((ext_vector_type(4)))unsigned;
using f32x4=__attribute__((ext_vector_type(4)))float;
constexpr int BATCH=4,NHEAD=8,SEQ=4096,D=64,DM=NHEAD*D;
constexpr int OPITCH=1024;
constexpr int PROJ_PITCH=3840, OG_COL=3232;
constexpr int NW=8,QBLK=32,QB=QBLK*NW,KVBLK=64,NQB=SEQ/QB;
constexpr int ATTN_PITCH=DM, ATTN_UNIT_ROWS=QB;
__device__ __forceinline__ int crow(int r,int hi){return (r&3)+8*(r>>2)+4*hi;}
#define SBAR() __builtin_amdgcn_sched_barrier(0)
__device__ __forceinline__ void cmask(f32x16&p0,f32x16&p1,int jb,int qrel,int hi){
  const float NEG=-INFINITY; int kb=64*jb+4*hi;
  #pragma unroll
  for(int r=0;r<16;++r){int kv=kb+(r&3)+8*(r>>2); if(kv>qrel)p0[r]=NEG; if(kv+32>qrel)p1[r]=NEG;}
}

constexpr int NSLOT=3, SLOTB=8192;
constexpr int LDS_K=0, LDS_V=NSLOT*SLOTB, LDS_WS=2*NSLOT*SLOTB, LDS_OST=LDS_WS+NW*64*4, LDS_BIAS=LDS_OST+NW*4096, LDS_SCAN=LDS_BIAS+SEQ*4, LDS_BYTES=LDS_SCAN+64;
constexpr float C2=0.125f*1.4426950408889634f;
__device__ __forceinline__ void glds16(const void*gsrc,unsigned lds_dst){unsigned keep;
  asm volatile("s_mov_b32 %0, m0\n\ts_mov_b32 m0, %2\n\ts_nop 0\n\tglobal_load_lds_dwordx4 %1, off\n\ts_mov_b32 m0, %0":"=&s"(keep):"v"(gsrc),"s"(lds_dst):"memory");}
__device__ __forceinline__ float max3f(float a,float b,float c){float r;asm("v_max3_f32 %0, %1, %2, %3":"=v"(r):"v"(a),"v"(b),"v"(c));return r;}
__device__ __forceinline__ float max2f(float a,float b){float r;asm("v_max_f32_e32 %0, %1, %2":"=v"(r):"v"(a),"v"(b));return r;}
__device__ __forceinline__ float fadd_s(float a,float b){float r;asm("v_add_f32_e32 %0, %1, %2":"=v"(r):"v"(a),"v"(b));return r;}
__device__ __forceinline__ float fsub_s(float a,float b){float r;asm("v_sub_f32_e32 %0, %1, %2":"=v"(r):"v"(a),"v"(b));return r;}
typedef float f32x2_t __attribute__((ext_vector_type(2))); typedef __bf16 bf16x2_t __attribute__((ext_vector_type(2)));
__device__ __forceinline__ unsigned cvtpk_s(float lo,float hi){f32x2_t v={lo,hi};bf16x2_t b=__builtin_convertvector(v,bf16x2_t);return __builtin_bit_cast(unsigned,b);}
#define WAIT_BAR(N) asm volatile("s_waitcnt vmcnt(" #N ") lgkmcnt(0)\n\ts_barrier":::"memory")

__device__ __forceinline__ void qkt(f32x16&p0,f32x16&p1,const char*Kslot,const bf16x8*qr,const f32x16&c0i,const f32x16&c1i,int r32,int hi){
  const char*kb=Kslot+hi*1024+r32*16;
  #pragma unroll
  for(int d0=0;d0<4;++d0){
    const bf16x8 b0=*reinterpret_cast<const bf16x8*>(kb+d0*2048);
    const bf16x8 b1=*reinterpret_cast<const bf16x8*>(kb+d0*2048+512);
    if(d0==0){p0=__builtin_amdgcn_mfma_f32_32x32x16_bf16(b0,qr[0],c0i,0,0,0);p1=__builtin_amdgcn_mfma_f32_32x32x16_bf16(b1,qr[0],c1i,0,0,0);}
    else{p0=__builtin_amdgcn_mfma_f32_32x32x16_bf16(b0,qr[d0],p0,0,0,0);p1=__builtin_amdgcn_mfma_f32_32x32x16_bf16(b1,qr[d0],p1,0,0,0);}}
}
typedef __attribute__((address_space(3))) const char* lds_cptr;
typedef short v4i16_t __attribute__((ext_vector_type(4)));
__device__ __forceinline__ void kload8(bf16x8*kf,lds_cptr kp){
  kf[0]=*(const __attribute__((address_space(3))) bf16x8*)(kp);      kf[1]=*(const __attribute__((address_space(3))) bf16x8*)(kp+512);
  kf[2]=*(const __attribute__((address_space(3))) bf16x8*)(kp+2048); kf[3]=*(const __attribute__((address_space(3))) bf16x8*)(kp+2560);
  kf[4]=*(const __attribute__((address_space(3))) bf16x8*)(kp+4096); kf[5]=*(const __attribute__((address_space(3))) bf16x8*)(kp+4608);
  kf[6]=*(const __attribute__((address_space(3))) bf16x8*)(kp+6144); kf[7]=*(const __attribute__((address_space(3))) bf16x8*)(kp+6656);
}
__device__ __forceinline__ void kload2(bf16x8*kf,lds_cptr kp,int j){ kf[2*j]=*(const __attribute__((address_space(3))) bf16x8*)(kp+j*2048); kf[2*j+1]=*(const __attribute__((address_space(3))) bf16x8*)(kp+j*2048+512); }
__device__ __forceinline__ s16x4 vtr(lds_cptr p){ return __builtin_bit_cast(s16x4,__builtin_amdgcn_ds_read_tr16_b64_v4i16((__attribute__((address_space(3))) v4i16_t*)p)); }
__device__ __forceinline__ float rowmax(const f32x16&p0,const f32x16&p1){
  float a=max3f(p0[0],p0[1],p1[0]),b=max3f(p0[2],p0[3],p1[1]);a=max3f(a,p1[2],p1[3]);
  #pragma unroll
  for(int r=4;r<16;r+=4){a=max3f(a,p0[r],p0[r+1]);b=max3f(b,p0[r+2],p0[r+3]);a=max3f(a,p1[r],p1[r+1]);b=max3f(b,p1[r+2],p1[r+3]);}
  const float m=max2f(a,b);
  auto rr=__builtin_amdgcn_permlane32_swap(__float_as_uint(m),__float_as_uint(m),false,false);
  return max2f(__uint_as_float(rr[0]),__uint_as_float(rr[1]));
}
__device__ __forceinline__ void pv(f32x16*o,int vb,bf16x8 pa0,bf16x8 pa1,bf16x8 pa2,bf16x8 pa3){
  #pragma unroll
  for(int d0=0;d0<2;++d0){s16x4 lo[4],hi[4];
    #pragma unroll
    for(int ks=0;ks<4;++ks){
      asm volatile("ds_read_b64_tr_b16 %0,%1 offset:%c2":"=&v"(lo[ks]):"v"(vb),"i"(d0*4096+ks*1024):"memory");
      asm volatile("ds_read_b64_tr_b16 %0,%1 offset:%c2":"=&v"(hi[ks]):"v"(vb),"i"(d0*4096+ks*1024+512):"memory");}
    asm volatile("s_waitcnt lgkmcnt(0)":::"memory");SBAR();
    #define PK(k) (bf16x8){lo[k][0],lo[k][1],lo[k][2],lo[k][3],hi[k][0],hi[k][1],hi[k][2],hi[k][3]}
    o[d0]=__builtin_amdgcn_mfma_f32_32x32x16_bf16(pa0,PK(0),o[d0],0,0,0);
    o[d0]=__builtin_amdgcn_mfma_f32_32x32x16_bf16(pa1,PK(1),o[d0],0,0,0);
    o[d0]=__builtin_amdgcn_mfma_f32_32x32x16_bf16(pa2,PK(2),o[d0],0,0,0);
    o[d0]=__builtin_amdgcn_mfma_f32_32x32x16_bf16(pa3,PK(3),o[d0],0,0,0);
    #undef PK
  }
}

#ifndef ATTN_STORE16
#define ATTN_STORE16(p,v) (*(u32x4*)(p)=(v))
#endif
template<int THRL> __device__ __forceinline__ void attn_unit(int b,int h,int qb,const bf16*Q,const bf16*__restrict__ K,const bf16*__restrict__ V,bf16*O,const float*__restrict__ logf,const unsigned short*__restrict__ proj,char*shm){
  const int tid=threadIdx.x,lane=tid&63,r32=lane&31,hi=lane>>5; const int wid=__builtin_amdgcn_readfirstlane(tid>>6);
  const long rowbase=(long)b*SEQ; const int q0=qb*QB;
  { float*biasL=(float*)(shm+LDS_BIAS); float*scanL=(float*)(shm+LDS_SCAN);
    const int nk=q0+QB,i0=tid*8; const float*lf=logf+((long)(b*NHEAD+h))*SEQ;
    float v8[8]; float run=0.f;
    if(i0<nk){ const f32x4 a_=*(const f32x4*)(lf+i0),c_=*(const f32x4*)(lf+i0+4);
      v8[0]=a_[0];v8[1]=v8[0]+a_[1];v8[2]=v8[1]+a_[2];v8[3]=v8[2]+a_[3];v8[4]=v8[3]+c_[0];v8[5]=v8[4]+c_[1];v8[6]=v8[5]+c_[2];v8[7]=v8[6]+c_[3];run=v8[7]; }
    else{ _Pragma("unroll") for(int i=0;i<8;++i)v8[i]=0.f; }
    float inc=run;
    _Pragma("unroll") for(int o_=1;o_<64;o_<<=1){ const float t_=__shfl_up(inc,o_); if(lane>=o_)inc+=t_; }
    if(lane==63)scanL[wid]=inc;
    __syncthreads();
    float base=inc-run; for(int w_=0;w_<wid;++w_)base+=scanL[w_];
    if(i0<nk){ const float L2E=-1.4426950408889634f;
      *(f32x4*)(biasL+i0)=(f32x4){(base+v8[0])*L2E,(base+v8[1])*L2E,(base+v8[2])*L2E,(base+v8[3])*L2E};
      *(f32x4*)(biasL+i0+4)=(f32x4){(base+v8[4])*L2E,(base+v8[5])*L2E,(base+v8[6])*L2E,(base+v8[7])*L2E}; }
    __syncthreads(); }
  int tskip;
  { const float*biasL=(const float*)(shm+LDS_BIAS); const int NT0=(q0+QB)/KVBLK; const float bq=biasL[q0];
    const bool need=(lane<NT0)?(bq-biasL[64*lane+63]<=80.f):true;
    const unsigned long long mk=__ballot(need); int first=mk?(__ffsll((long long)mk)-1):0;
    first&=~1; if(first>NT0-4)first=NT0-4; if(first<0)first=0; tskip=__builtin_amdgcn_readfirstlane(first); }
  const bf16*Qw=Q+(rowbase+q0+wid*QBLK)*DM+h*D;
  const bf16*Kh=K+(rowbase+(long)tskip*KVBLK)*DM+h*D,*Vh=V+(rowbase+(long)tskip*KVBLK)*DM+h*D;
  const unsigned lds0=(unsigned)(uintptr_t)shm;
  float*wsf=(float*)(shm+LDS_WS)+wid*64;
  const bf16*ksrc=Kh+(long)lane*DM+wid*8;
  const bf16*vsrc=Vh+(long)(16*(wid&3)+(lane>>2))*DM+(wid>>2)*32+(lane&3)*8;
  const unsigned kdst=lds0+LDS_K+wid*1024, vdst=lds0+LDS_V+wid*1024;
  #define DMA_K(t,slot) glds16(ksrc+(long)(t)*KVBLK*DM,(unsigned)__builtin_amdgcn_readfirstlane(kdst+(slot)))
  #define DMA_V(t,slot) glds16(vsrc+(long)(t)*KVBLK*DM,(unsigned)__builtin_amdgcn_readfirstlane(vdst+(slot)))
  const int vb0=(int)(lds0+LDS_V)+((lane>>4)&1)*32+(lane&3)*8+(4*hi+((lane&15)>>2))*64;
  const char*Kbase=shm+LDS_K; bf16x8 kf[8];
  const lds_cptr shm3=(lds_cptr)shm; const lds_cptr kp0=shm3+LDS_K+hi*1024+r32*16; const lds_cptr vp0=shm3+LDS_V+((lane>>4)&1)*32+(lane&3)*8+(4*hi+((lane&15)>>2))*64;
  const int NT=(q0+QB)/KVBLK-tskip;
  #define BIASC(C0,C1,t,ng) do{ const __attribute__((address_space(3))) f32x4*bq_=(const __attribute__((address_space(3))) f32x4*)(shm3+LDS_BIAS+((t)+tskip)*256+hi*16); \
    _Pragma("unroll") for(int g_=0;g_<4;++g_){ const f32x4 x0_=bq_[2*g_],x1_=bq_[8+2*g_]; \
      _Pragma("unroll") for(int i_=0;i_<4;++i_){ C0[4*g_+i_]=x0_[i_]+(ng); C1[4*g_+i_]=x1_[i_]+(ng); } } }while(0)
  DMA_K(0,0);DMA_V(0,0);DMA_K(1,SLOTB);
  bf16x8 qr[4];
  #pragma unroll
  for(int d0=0;d0<4;++d0)qr[d0]=*reinterpret_cast<const bf16x8*>(&Qw[(long)r32*DM+d0*16+hi*8]);
  float mhat=0.f,l_reg=0.f;f32x16 o[2];o[0]=f32x16{};o[1]=f32x16{};float negm_s=0.f;
  const int qrel=wid*QBLK+r32;
  #define CMASK(P0,P1,t) do{int jb_=(t)-(NT-4); if(jb_>=0)cmask(P0,P1,jb_,qrel,hi);}while(0)
  bool resc=false;
  #define START(P0,P1) do{ const float rm=rowmax(P0,P1); resc=false; \
    { const float dl=rm; mhat=fadd_s(mhat,dl); \
      _Pragma("unroll") for(int r=0;r<16;++r){P0[r]=fsub_s(P0[r],dl);P1[r]=fsub_s(P1[r],dl);} \
      negm_s=-mhat; } \
    _Pragma("unroll") for(int r=0;r<16;++r)P0[r]=__builtin_amdgcn_exp2f(P0[r]); }while(0)
  #define RESC() do{ if(resc){ asm volatile("s_waitcnt lgkmcnt(0)":::"memory"); \
      _Pragma("unroll") for(int d_=0;d_<2;++d_) _Pragma("unroll") for(int r=0;r<16;++r)o[d_][r]*=wsf[crow(r,hi)]; } }while(0)
  f32x16 pA0,pA1,pB0,pB1;
  int sl_prev=0,sl_cur=0,sl_next=SLOTB;
  #define ROT() do{sl_prev=sl_cur;sl_cur=sl_next;sl_next=(sl_next==(NSLOT-1)*SLOTB)?0:sl_next+SLOTB;}while(0)
  DMA_K(2,2*SLOTB);
  WAIT_BAR(3);
  { f32x16 c0i_,c1i_; BIASC(c0i_,c1i_,0,0.f); qkt(pA0,pA1,Kbase,qr,c0i_,c1i_,r32,hi); }asm volatile("s_nop 15\n\ts_nop 7":"+v"(pA0),"+v"(pA1));CMASK(pA0,pA1,0);
  START(pA0,pA1);
  _Pragma("unroll") for(int r=0;r<16;++r)pA1[r]=__builtin_amdgcn_exp2f(pA1[r]);
  WAIT_BAR(0);
  DMA_K(3,0);DMA_V(1,SLOTB);
  ROT();
  kload8(kf,kp0+sl_cur);
  WAIT_BAR(2);
  s16x4 vlo[8],vhi[8]; u32x4 pw0,pw1,pw2,pw3;
  #define PKW(P,B) cvtpk_s(P[B],P[B+1])
  #define PAF(k) __builtin_bit_cast(bf16x8,pw##k)
  #define VFR(i) (bf16x8){vlo[i][0],vlo[i][1],vlo[i][2],vlo[i][3],vhi[i][0],vhi[i][1],vhi[i][2],vhi[i][3]}
  #define PIN(x) asm volatile("":"+v"(x))
  #define MX3(a,b,c) __builtin_fmaxf(__builtin_fmaxf((a),(b)),(c))
  #define GAPA(MF,A0,A1,A2,A3,W0,W1,PW) do{ MF; sacc+=A0; sacc+=A1; sacc+=A2; sacc+=A3; PIN(sacc); W0; W1; PIN(PW); SBAR(); }while(0)
  #define EX(v) __builtin_amdgcn_exp2f(v)
  #define GAPB(MF,X,B) do{ MF; X[B]=EX(X[B]); X[B+1]=EX(X[B+1]); X[B+2]=EX(X[B+2]); X[B+3]=EX(X[B+3]); PIN(X); SBAR(); }while(0)
  #define VRD(i) do{ vlo[i]=vtr(vp_+(((i)>>2)*4096+((i)&3)*1024)); vhi[i]=vtr(vp_+(((i)>>2)*4096+((i)&3)*1024+512)); }while(0)
  #define KRD(G,j) do{ if(G){ kload2(kf,kp0+sl_next,j); SBAR(); } }while(0)
  #define STEP(C0,C1,P0,P1,t,GK,GV,GL) do{ SBAR(); BIASC(C0,C1,t,negm_s); SBAR(); \
    const lds_cptr vp_=vp0+sl_prev; \
    VRD(0); SBAR(); float sacc=(P0[0]+P0[1]); \
    GAPA(C0=__builtin_amdgcn_mfma_f32_32x32x16_bf16(kf[0],qr[0],C0,0,0,0), P0[2],P0[3],P0[4],P0[5],     pw0[0]=PKW(P0,0), pw0[1]=PKW(P0,2), pw0); \
    VRD(4); SBAR(); GAPA(C1=__builtin_amdgcn_mfma_f32_32x32x16_bf16(kf[1],qr[0],C1,0,0,0), P0[6],P0[7],P0[8],P0[9],     pw0[2]=PKW(P0,4), pw0[3]=PKW(P0,6), pw0); \
    VRD(1); SBAR(); GAPA(C0=__builtin_amdgcn_mfma_f32_32x32x16_bf16(kf[2],qr[1],C0,0,0,0),   P0[10],P0[11],P0[12],P0[13], pw1[0]=PKW(P0,8), pw1[1]=PKW(P0,10), pw1); \
    VRD(5); SBAR(); GAPA(C1=__builtin_amdgcn_mfma_f32_32x32x16_bf16(kf[3],qr[1],C1,0,0,0),   P0[14],P0[15],P1[0],P1[1],   pw1[2]=PKW(P0,12),pw1[3]=PKW(P0,14), pw1); \
    VRD(2); SBAR(); GAPA(C0=__builtin_amdgcn_mfma_f32_32x32x16_bf16(kf[4],qr[2],C0,0,0,0),   P1[2],P1[3],P1[4],P1[5],     pw2[0]=PKW(P1,0), pw2[1]=PKW(P1,2), pw2); \
    VRD(6); SBAR(); GAPA(C1=__builtin_amdgcn_mfma_f32_32x32x16_bf16(kf[5],qr[2],C1,0,0,0),   P1[6],P1[7],P1[8],P1[9],     pw2[2]=PKW(P1,4), pw2[3]=PKW(P1,6), pw2); \
    VRD(3); SBAR(); GAPA(C0=__builtin_amdgcn_mfma_f32_32x32x16_bf16(kf[6],qr[3],C0,0,0,0),   P1[10],P1[11],P1[12],P1[13], pw3[0]=PKW(P1,8), pw3[1]=PKW(P1,10), pw3); \
    VRD(7); SBAR(); GAPA(C1=__builtin_amdgcn_mfma_f32_32x32x16_bf16(kf[7],qr[3],C1,0,0,0),   P1[14],P1[15],0.f,0.f,       pw3[2]=PKW(P1,12),pw3[3]=PKW(P1,14), pw3); \
    l_reg+=sacc; \
    if(GK){DMA_K((t)+3,sl_cur);} if(GV){DMA_V((t)+1,sl_next);} \
    CMASK(C0,C1,t); \
    { float a=MX3(C0[0],C0[1],C1[0]),b=MX3(C0[2],C0[3],C1[1]); a=MX3(a,C1[2],C1[3]); \
      _Pragma("unroll") for(int r=4;r<16;r+=4){a=MX3(a,C0[r],C0[r+1]);b=MX3(b,C0[r+2],C0[r+3]);a=MX3(a,C1[r],C1[r+1]);b=MX3(b,C1[r+2],C1[r+3]);} \
      float rm=__builtin_fmaxf(a,b); { auto rr=__builtin_amdgcn_permlane32_swap(__float_as_uint(rm),__float_as_uint(rm),false,false); rm=__builtin_fmaxf(__uint_as_float(rr[0]),__uint_as_float(rr[1])); } \
      resc=false; \
      if(__builtin_expect(__any(rm>(float)THRL),0)){ const float dl=__builtin_fmaxf(rm,0.f); mhat+=dl; \
        _Pragma("unroll") for(int r=0;r<16;++r){C0[r]-=dl;C1[r]-=dl;} \
        negm_s=-mhat; \
        const float f=__builtin_amdgcn_exp2f(-dl); l_reg*=f; if(hi==0)wsf[r32]=f; resc=true; } } \
    SBAR(); \
    GAPB(o[0]=__builtin_amdgcn_mfma_f32_32x32x16_bf16(PAF(0),VFR(0),o[0],0,0,0), C0,0); \
    GAPB(o[1]=__builtin_amdgcn_mfma_f32_32x32x16_bf16(PAF(0),VFR(4),o[1],0,0,0), C0,4); \
    KRD(GL,0); GAPB(o[0]=__builtin_amdgcn_mfma_f32_32x32x16_bf16(PAF(1),VFR(1),o[0],0,0,0), C0,8); \
    KRD(GL,1); GAPB(o[1]=__builtin_amdgcn_mfma_f32_32x32x16_bf16(PAF(1),VFR(5),o[1],0,0,0), C0,12); \
    KRD(GL,2); GAPB(o[0]=__builtin_amdgcn_mfma_f32_32x32x16_bf16(PAF(2),VFR(2),o[0],0,0,0), C1,0); \
    KRD(GL,3); GAPB(o[1]=__builtin_amdgcn_mfma_f32_32x32x16_bf16(PAF(2),VFR(6),o[1],0,0,0), C1,4); \
    GAPB(o[0]=__builtin_amdgcn_mfma_f32_32x32x16_bf16(PAF(3),VFR(3),o[0],0,0,0), C1,8); \
    GAPB(o[1]=__builtin_amdgcn_mfma_f32_32x32x16_bf16(PAF(3),VFR(7),o[1],0,0,0), C1,12); \
    }while(0)
  int t=1;
  #undef CMASK
  #define CMASK(P0,P1,t) do{}while(0)
  for(;t+5<NT;t+=2){
    STEP(pB0,pB1,pA0,pA1,t,true,true,true);     WAIT_BAR(2); RESC(); ROT();
    STEP(pA0,pA1,pB0,pB1,t+1,true,true,true);   WAIT_BAR(2); RESC(); ROT();
  }
  #undef CMASK
  #define CMASK(P0,P1,t) do{int jb_=(t)-(NT-4); if(jb_>=0)cmask(P0,P1,jb_,qrel,hi);}while(0)
  #define ENDW(tt) do{ if((tt)+3<NT){WAIT_BAR(2);} else if((tt)+2<NT){WAIT_BAR(1);} else {WAIT_BAR(0);} }while(0)
  for(;t+1<NT;t+=2){
    STEP(pB0,pB1,pA0,pA1,t,(t+3<NT),(t+1<NT),(t+1<NT));       ENDW(t);   RESC(); ROT();
    STEP(pA0,pA1,pB0,pB1,t+1,(t+4<NT),(t+2<NT),(t+2<NT));     ENDW(t+1); RESC(); ROT();
  }
  STEP(pB0,pB1,pA0,pA1,NT-1,false,false,false); RESC();
  { float sacc=pB0[0]+pB0[1]; _Pragma("unroll") for(int r=2;r<16;++r)sacc+=pB0[r]; _Pragma("unroll") for(int r=0;r<16;++r)sacc+=pB1[r]; l_reg+=sacc;
    pw0=(u32x4){PKW(pB0,0),PKW(pB0,2),PKW(pB0,4),PKW(pB0,6)};pw1=(u32x4){PKW(pB0,8),PKW(pB0,10),PKW(pB0,12),PKW(pB0,14)};pw2=(u32x4){PKW(pB1,0),PKW(pB1,2),PKW(pB1,4),PKW(pB1,6)};pw3=(u32x4){PKW(pB1,8),PKW(pB1,10),PKW(pB1,12),PKW(pB1,14)};
    SBAR(); pv(o,vb0+sl_cur,PAF(0),PAF(1),PAF(2),PAF(3)); }
  #undef PKW
  #undef PAF
  #undef VFR
  #undef PIN
  #undef MX3
  #undef GAPA
  #undef GAPB
  #undef EX
  #undef VRD
  #undef KRD
  #undef STEP
  #undef ENDW
  {auto rr=__builtin_amdgcn_permlane32_swap(__float_as_uint(l_reg),__float_as_uint(l_reg),false,false);l_reg=__uint_as_float(rr[0])+__uint_as_float(rr[1]);}
  if(hi==0)wsf[32+r32]=l_reg;asm volatile("s_waitcnt lgkmcnt(0)":::"memory");
  float rli[16];
  #pragma unroll
  for(int r=0;r<16;++r)rli[r]=__builtin_amdgcn_rcpf(wsf[32+crow(r,hi)]);
  bf16*Ow=O+(rowbase+q0+wid*QBLK)*OPITCH+h*D; const unsigned short*ogw=proj+(rowbase+q0+wid*QBLK)*(long)PROJ_PITCH+OG_COL+h*D;
  { bf16*stg=(bf16*)(shm+LDS_OST)+wid*2048;
    #pragma unroll
    for(int r=0;r<16;++r){const int orow=crow(r,hi);
      #pragma unroll
      for(int d0=0;d0<2;++d0)stg[orow*64+d0*32+r32]=__float2bfloat16(o[d0][r]*rli[r]);}
    asm volatile("s_waitcnt lgkmcnt(0)":::"memory");
    #pragma unroll
    for(int i=0;i<4;++i){const int row=i*8+(lane>>3),ch=lane&7; u32x4 v=*(const u32x4*)(stg+row*64+ch*8);
      const u32x4 gw_=*(const u32x4*)(ogw+(long)row*PROJ_PITCH+ch*8);
      const f32x4 g0={__uint_as_float(gw_[0]<<16),__uint_as_float(gw_[0]&0xffff0000u),__uint_as_float(gw_[1]<<16),__uint_as_float(gw_[1]&0xffff0000u)},g1={__uint_as_float(gw_[2]<<16),__uint_as_float(gw_[2]&0xffff0000u),__uint_as_float(gw_[3]<<16),__uint_as_float(gw_[3]&0xffff0000u)};
      #define SG(x) __builtin_amdgcn_rcpf(1.0f+__builtin_amdgcn_exp2f(-1.4426950408889634f*(x)))
      #define LO(w) __uint_as_float((w)<<16)
      #define HI(w) __uint_as_float((w)&0xffff0000u)
      v[0]=cvtpk_s(LO(v[0])*SG(g0[0]),HI(v[0])*SG(g0[1])); v[1]=cvtpk_s(LO(v[1])*SG(g0[2]),HI(v[1])*SG(g0[3]));
      v[2]=cvtpk_s(LO(v[2])*SG(g1[0]),HI(v[2])*SG(g1[1])); v[3]=cvtpk_s(LO(v[3])*SG(g1[2]),HI(v[3])*SG(g1[3]));
      #undef SG
      #undef LO
      #undef HI
      ATTN_STORE16(Ow+(long)row*OPITCH+ch*8,v);} }
  asm volatile("s_waitcnt lgkmcnt(0)\n\ts_barrier":::"memory");
  #undef DMA_K
  #undef DMA_V
  #undef CMASK
  #undef START
  #undef RESC
  #undef ROT
  #undef BIASC
}
constexpr int ATTN_LDS_BYTES=LDS_BYTES;
struct AttnTensors { const bf16* Q; const bf16* K; const bf16* V; bf16* O; const float* logf; const unsigned short* proj; };
constexpr int N_UNITS=BATCH*NHEAD*NQB;
template<int THRL=8> __device__ __forceinline__ void attn_phase(char*lds,const AttnTensors&T,unsigned*qhead,volatile __attribute__((address_space(3))) unsigned*qslot){
  for(;;){
    if(threadIdx.x==0)*qslot=__hip_atomic_fetch_add(qhead,1u,__ATOMIC_RELAXED,__HIP_MEMORY_SCOPE_AGENT);
    __syncthreads(); const unsigned u=*qslot; __syncthreads();
    if(u>=(unsigned)N_UNITS)break;
    const int qb=NQB-1-(int)(u>>5),bh=(int)(u&31u);
    attn_unit<THRL>(bh/NHEAD,bh%NHEAD,qb,T.Q,T.K,T.V,T.O,T.logf,T.proj,lds);
  }
}
#undef SBAR
#undef WAIT_BAR
}
#define GAS __attribute__((address_space(1)))
#define LAS __attribute__((address_space(3)))
typedef unsigned short bf16;
typedef unsigned v4u __attribute__((ext_vector_type(4)));
typedef float f32x4 __attribute__((ext_vector_type(4)));
typedef short bf16x8 __attribute__((ext_vector_type(8)));
typedef GAS unsigned gu32;
typedef GAS unsigned long long gu64;
#define RLX_AGENT __ATOMIC_RELAXED, __HIP_MEMORY_SCOPE_AGENT
#define LDS_WAIT() asm volatile("s_waitcnt lgkmcnt(0)" ::: "memory")
#define VM_WAIT() asm volatile("s_waitcnt vmcnt(0)" ::: "memory")
__device__ __forceinline__ unsigned long long rt() { return __builtin_amdgcn_s_memrealtime(); }
__device__ __forceinline__ unsigned f2bf(float f) { unsigned u = __builtin_bit_cast(unsigned, f); return (u + 0x7fffu + ((u >> 16) & 1u)) >> 16; }
__device__ __forceinline__ unsigned pk2(float lo, float hi) { return pg8::cvt_pk_bf16(lo, hi); }

#define XB_TMO      128
#define XB_XCNT(j)  (256  + 64 * (j))
#define XB_XSUB(j)  (1280 + 64 * (j))
#define XB_XGEN(j)  (2304 + 64 * (j))
#define XB_TOP      3328
#define XB_TOPGEN   3392
#define XCD_BAR_WORDS 3456
#define XB_SPIN_CAP (1u << 18)

__device__ __forceinline__ unsigned xb_ld(unsigned* p)              { return __hip_atomic_load(p, __ATOMIC_RELAXED, __HIP_MEMORY_SCOPE_AGENT); }
__device__ __forceinline__ unsigned xb_add(unsigned* p, unsigned v) { return __hip_atomic_fetch_add(p, v, __ATOMIC_RELAXED, __HIP_MEMORY_SCOPE_AGENT); }
__device__ __forceinline__ unsigned xb_xcc_id() { return (unsigned)__builtin_amdgcn_s_getreg((3 << 11) | 20) & 0xFu; }
#define XB_SPIN(cond, bar) do { unsigned _sp = 0; while (cond) { __builtin_amdgcn_s_sleep(1); \
    if ((++_sp & 255u) == 0u) { if (xb_ld(&(bar)[XB_TMO])) break; if (_sp > XB_SPIN_CAP) { atomicAdd(&(bar)[XB_TMO], 1u); break; } } } } while (0)

struct XcdBarrier {
    unsigned* bar; unsigned x;
    volatile LAS unsigned* st;
};

__device__ __forceinline__ XcdBarrier xcd_barrier_post(unsigned* bar, volatile LAS unsigned* st) {
    XcdBarrier b; b.bar = bar; b.x = xb_xcc_id(); b.st = st;
    if (threadIdx.x == 0) (void)xb_add(&bar[XB_XCNT(b.x)], 1u);
    return b;
}
__device__ __forceinline__ void xcd_barrier_complete(unsigned* bar, unsigned x, unsigned& nloc, unsigned& nx) {
    const unsigned G = gridDim.x * gridDim.y * gridDim.z;
    unsigned sum, cnt, mine, sp = 0u;
    for (;;) {
        sum = 0u; cnt = 0u; mine = 0u;
#pragma unroll
        for (unsigned j = 0; j < 16; ++j) { const unsigned c = xb_ld(&bar[XB_XCNT(j)]); sum += c; cnt += (c > 0u) ? 1u : 0u; mine = (j == x) ? c : mine; }
        if (sum == G) break;
        __builtin_amdgcn_s_sleep(1);
        if ((++sp & 255u) == 0u) { if (xb_ld(&bar[XB_TMO])) break; if (sp > XB_SPIN_CAP) { atomicAdd(&bar[XB_TMO], 1u); break; } }
    }
    nloc = mine > 0u ? mine : 1u; nx = cnt > 0u ? cnt : 1u;
}

__device__ __forceinline__ void xcd_barrier(const XcdBarrier& b) {
    asm volatile("s_waitcnt vmcnt(0)" ::: "memory");
    __syncthreads();
    if (threadIdx.x == 0) {
        unsigned* bar = b.bar;
        __builtin_amdgcn_s_waitcnt(0);
        unsigned nloc = b.st[0], nx = b.st[1];
        if (nloc == 0u) { xcd_barrier_complete(bar, b.x, nloc, nx); b.st[0] = nloc; b.st[1] = nx; }
        const unsigned old = xb_add(&bar[XB_XSUB(b.x)], 1u);
        const unsigned gen = old / nloc;
        if (old + 1u == (gen + 1u) * nloc) {
            __builtin_amdgcn_fence(__ATOMIC_RELEASE, "agent");
            asm volatile("s_waitcnt vmcnt(0)" ::: "memory");
            const unsigned og = xb_add(&bar[XB_TOP], 1u);
            const unsigned tg = og / nx;
            if (og + 1u == (tg + 1u) * nx) xb_add(&bar[XB_TOPGEN], 1u);
            else XB_SPIN(xb_ld(&bar[XB_TOPGEN]) == tg, bar);
            __builtin_amdgcn_fence(__ATOMIC_ACQUIRE, "agent");
            xb_add(&bar[XB_XGEN(b.x)], 1u);
            asm volatile("s_waitcnt vmcnt(0)" ::: "memory");
        } else {
            XB_SPIN(xb_ld(&bar[XB_XGEN(b.x)]) == gen, bar);
            __builtin_amdgcn_fence(__ATOMIC_ACQUIRE, "agent");
            asm volatile("s_waitcnt vmcnt(0)" ::: "memory");
        }
    }
    __syncthreads();
}

constexpr int NWAVES = 8, NTHR = 512;
constexpr int BATCH = 4, SEQ = 4096, D = 1024, M = BATCH * SEQ;
constexpr int NH = 8, HD = 64, RWW = 512;
constexpr int IN_COLS = 3752, PL = 3840;
constexpr int C_R = 0, C_K = 512, C_V = 1024, C_WD = 1536, C_AD = 1568, C_GD = 1600;
constexpr int C_FQ = 1696, C_FK = 2208, C_FV = 2720, C_OG = 3232, C_FZ = 3744;
constexpr int NE = 32, TOPK = 4, NASSIGN = M * TOPK, MAXTILES = NASSIGN / 256 + NE, XROWS = MAXTILES * 256;
constexpr float LN_EPS = 1e-5f, QK_EPS = 1e-6f, GN_EPS = 64e-5f, ALPHA = 1.189207115002721f;
static_assert(attn_body::PROJ_PITCH == PL && attn_body::OG_COL == C_OG, "attention body constants");

constexpr size_t MiB = 1u << 20;
constexpr size_t WS_CTL = 0, CTL_ZERO_BYTES = 1 * MiB;
constexpr size_t WS_WIN = 2 * MiB, WS_WO = 10 * MiB;
constexpr size_t WS_LOGF = 12 * MiB;
constexpr size_t WS_AE = WS_LOGF + 512 * 1024, WS_APOS = WS_AE + 256 * 1024, WS_AGATE = WS_APOS + 256 * 1024, WS_AROW = WS_AGATE + 256 * 1024, WS_ROWGATE = WS_AROW + 256 * 1024, WS_ROWTOK = WS_ROWGATE + 512 * 1024;
constexpr size_t WS_W1T = 32 * MiB, WS_W2T = 160 * MiB;
constexpr size_t WS_HB = 224 * MiB;
constexpr size_t WS_HF = 256 * MiB;
constexpr size_t WS_PROJ = 320 * MiB;
constexpr size_t WS_G = 560 * MiB, WS_BONUS = 592 * MiB;
constexpr size_t WS_QB = 624 * MiB, WS_KB = 640 * MiB, WS_VB = 656 * MiB;
constexpr size_t WS_MIX = 672 * MiB;
constexpr size_t WS_MC = 704 * MiB, WS_NT = 720 * MiB, WS_QC = 752 * MiB, WS_ZT = 768 * MiB;
constexpr size_t WS_Y = 800 * MiB;
constexpr size_t WS_XS = 320 * MiB, WS_ACT = 464 * MiB, WS_EOUT = 320 * MiB;
constexpr size_t WS_END = 832 * MiB;
static_assert(WS_ROWTOK + (size_t)XROWS * 4 <= WS_W1T && WS_XS + (size_t)XROWS * 2048 <= WS_ACT && WS_ACT + (size_t)XROWS * 2048 <= WS_QB, "d_ws map");

constexpr int CW_BAR = 4096, CW_ATTQ = 8192, CW_CVQ = 8224, CW_ECNT = 8256;

constexpr int RING_OFF = 0;
constexpr int CTRL_OFF = 159744, LDS_BYTES = 163840;
constexpr int LC_MISC = 0  , LC_HIST = 128, LC_BASE = 256, LC_TSTART = 384, LC_TEXP = 640  , LC_ROWINFO = 1024  ;
static_assert(attn_body::ATTN_LDS_BYTES <= 131072, "attention scratch inside the ring region");

typedef float f32x2 __attribute__((ext_vector_type(2)));
typedef unsigned u32x2v __attribute__((ext_vector_type(2)));
#define MFMA16(a, b, c) __builtin_amdgcn_mfma_f32_16x16x32_bf16((a), (b), (c), 0, 0, 0)
__device__ __forceinline__ float sigmoidf_(float x) { return __builtin_amdgcn_rcpf(1.0f + __builtin_amdgcn_exp2f(-1.4426950408889634f * x)); }
__device__ __forceinline__ float tanh_fast(float x) { return 1.0f - 2.0f * __builtin_amdgcn_rcpf(1.0f + __builtin_amdgcn_exp2f(2.8853900817779268f * x)); }
__device__ __forceinline__ float log1pexp_neg(float ax) { return 0.6931471805599453f * __builtin_amdgcn_logf(1.0f + __builtin_amdgcn_exp2f(-1.4426950408889634f * ax)); }
__device__ __forceinline__ float bf2f(unsigned short b) { return __uint_as_float((unsigned)b << 16); }
__device__ __forceinline__ unsigned short f2bf16(float f) { return (unsigned short)f2bf(f); }
__device__ __forceinline__ v4u pack8(const float* v) { v4u o; o.x = pg8::cvt_pk_bf16(v[0], v[1]); o.y = pg8::cvt_pk_bf16(v[2], v[3]); o.z = pg8::cvt_pk_bf16(v[4], v[5]); o.w = pg8::cvt_pk_bf16(v[6], v[7]); return o; }
__device__ __forceinline__ float wave_sum(float v) {
#pragma unroll
    for (int o = 1; o < 64; o <<= 1) v += __shfl_xor(v, o);
    return v;
}

__device__ __forceinline__ void transpose_item(const float* W, int K, int N, int nblk, bf16* WT, LAS float* scr, int item, int lane) {
    const int kb = item / nblk, nb = item - kb * nblk, k0 = 64 * kb, n0 = 32 * nb; const int nn = n0 + (lane & 31); const bool ok = nn < N;
#pragma unroll 8
    for (int i = 0; i < 32; ++i) { const int kk = 2 * i + (lane >> 5); scr[kk * 33 + (lane & 31)] = ok ? W[(size_t)(k0 + kk) * N + nn] : 0.f; }
    LDS_WAIT(); asm volatile("" ::: "memory");
    const int c = lane & 7;
#pragma unroll
    for (int j = 0; j < 4; ++j) { const int n = (lane >> 3) + 8 * j; const LAS float* s = scr + (8 * c) * 33 + n;
        v4u o; o.x = pk2(s[0 * 33], s[1 * 33]); o.y = pk2(s[2 * 33], s[3 * 33]); o.z = pk2(s[4 * 33], s[5 * 33]); o.w = pk2(s[6 * 33], s[7 * 33]);
        *(GAS v4u*)(WT + (size_t)(n0 + n) * K + k0 + 8 * c) = o; }
    LDS_WAIT(); asm volatile("" ::: "memory");
}
__device__ __forceinline__ void ln_finish(f32x4 (&v)[4], const float* w, const float* b, int lane, float* outF, bf16* outB) {
    float s = 0.f;
#pragma unroll
    for (int j = 0; j < 4; ++j) s += (v[j].x + v[j].y) + (v[j].z + v[j].w);
    const float mean = wave_sum(s) * (1.f / D); float s2 = 0.f;
#pragma unroll
    for (int j = 0; j < 4; ++j) { v[j] = v[j] - mean; s2 += (v[j].x * v[j].x + v[j].y * v[j].y) + (v[j].z * v[j].z + v[j].w * v[j].w); }
    const float rstd = 1.f / sqrtf(wave_sum(s2) * (1.f / D) + LN_EPS);
#pragma unroll
    for (int j = 0; j < 4; ++j) { const f32x4 wv = *(const f32x4*)(w + 4 * lane + 256 * j), bv = *(const f32x4*)(b + 4 * lane + 256 * j); v[j] = v[j] * rstd * wv + bv;
        if (outF) *(f32x4*)(outF + 4 * lane + 256 * j) = v[j];
        if (outB) { u32x2v o; o.x = pg8::cvt_pk_bf16(v[j].x, v[j].y); o.y = pg8::cvt_pk_bf16(v[j].z, v[j].w); *(u32x2v*)(outB + 4 * lane + 256 * j) = o; } }
}

struct CvtItem { const float* W; bf16* WT; int N; int k0, n0; };
__device__ __forceinline__ CvtItem cvt_item(int it, const float* w1, const float* w2, bf16* W1T, bf16* W2T) {
    CvtItem c;
    it = __builtin_amdgcn_readfirstlane(it);
    if (it < NE * 1024) { const int e = it >> 10, r = it & 1023; c.W = w1 + (size_t)e * D * 2048; c.WT = W1T + (size_t)e * 2048 * D; c.N = 2048; c.k0 = 64 * (r >> 6); c.n0 = 32 * (r & 63); }
    else { const int i2 = it - NE * 1024, e = i2 >> 9, r = i2 & 511; c.W = w2 + (size_t)e * D * D; c.WT = W2T + (size_t)e * D * D; c.N = D; c.k0 = 64 * (r >> 5); c.n0 = 32 * (r & 31); }
    return c;
}
__device__ __forceinline__ void cvt_load(f32x4 (&ld)[8], const CvtItem& c, int lane) {
    const int fr = lane & 15, fq = lane >> 4;
    const char* base = (const char*)(c.W + (size_t)c.k0 * c.N + c.n0);
    const unsigned lo = (unsigned)((8 * (fr >> 2) + (fr & 3)) * c.N + 8 * fq) * 4u;
#pragma unroll
    for (int p = 0; p < 2; ++p)
#pragma unroll
        for (int m = 0; m < 2; ++m) { const unsigned off = lo + (unsigned)((32 * p + 4 * m) * c.N) * 4u;
            ld[(p * 2 + m) * 2] = *(const f32x4*)(base + off); ld[(p * 2 + m) * 2 + 1] = *(const f32x4*)(base + off + 16u); }
}
__device__ __forceinline__ void cvt_finish(const f32x4 (&ld)[8], const CvtItem& c, int lane) {
    const int fr = lane & 15, fq = lane >> 4;
    bf16x8 sel[2];
#pragma unroll
    for (int h = 0; h < 2; ++h) { v4u sw;
#pragma unroll
        for (int e2 = 0; e2 < 4; ++e2) sw[e2] = ((8 * fq + 2 * e2 == 16 * h + fr) ? 0x3F80u : 0u) | ((8 * fq + 2 * e2 + 1 == 16 * h + fr) ? 0x3F800000u : 0u);
        sel[h] = __builtin_bit_cast(bf16x8, sw); }
#pragma unroll
    for (int p = 0; p < 2; ++p) { bf16x8 a[2];
#pragma unroll
        for (int m = 0; m < 2; ++m) { const f32x4 x0 = ld[(p * 2 + m) * 2], x1 = ld[(p * 2 + m) * 2 + 1]; v4u q; q.x = pk2(x0[0], x0[1]); q.y = pk2(x0[2], x0[3]); q.z = pk2(x1[0], x1[1]); q.w = pk2(x1[2], x1[3]); a[m] = __builtin_bit_cast(bf16x8, q); }
#pragma unroll
        for (int h = 0; h < 2; ++h) { const f32x4 z4 = {0.f, 0.f, 0.f, 0.f}; const f32x4 d0 = MFMA16(a[0], sel[h], z4), d1 = MFMA16(a[1], sel[h], z4);
            v4u o; o.x = pk2(d0[0], d0[1]); o.y = pk2(d0[2], d0[3]); o.z = pk2(d1[0], d1[1]); o.w = pk2(d1[2], d1[3]);
            *(v4u*)((char*)(c.WT + (size_t)c.n0 * D + c.k0) + (unsigned)((16 * h + fr) * D + 32 * p + 8 * fq) * 2u) = o; } }
}

struct CvtSide { const float* w2; bf16* W2T; int lane, wave; f32x4 cld[8]; CvtItem ci;
    __device__ __forceinline__ void pre(const pg8::Unit& u) { const int idx = ((u.pm * 8 + u.pn) * 8 + wave) & (NE * 512 - 1); ci = cvt_item(NE * 1024 + idx, nullptr, w2, nullptr, W2T); cvt_load(cld, ci, lane); }
    __device__ __forceinline__ void post(const pg8::Unit&) { cvt_finish(cld, ci, lane); } };

struct FoxRow { v4u qa, ka, va; unsigned short fz; };
struct FoxPtrs { const bf16* proj; const float *qn, *kn, *bfp; bf16 *QB, *KB, *VB; float* LOGF; };
__device__ __forceinline__ void fox_load(FoxRow& r, const FoxPtrs& F, int m, int lane) {
    const bf16* pr = F.proj + (size_t)m * PL; r.qa = *(const v4u*)(pr + C_FQ + 8 * lane); r.ka = *(const v4u*)(pr + C_FK + 8 * lane); r.va = *(const v4u*)(pr + C_FV + 8 * lane); r.fz = pr[C_FZ + (lane & 7)]; }
__device__ __forceinline__ void fox_finish(const FoxRow& r, const FoxPtrs& F, int m, int lane) {
    const int d0 = (8 * lane) & 63; float q[8], k[8]; float sq = 0.f, sk = 0.f;
    const f32x4 qn0 = *(const f32x4*)(F.qn + d0), qn1 = *(const f32x4*)(F.qn + d0 + 4), kn0 = *(const f32x4*)(F.kn + d0), kn1 = *(const f32x4*)(F.kn + d0 + 4);
    const float qnv[8] = {qn0[0], qn0[1], qn0[2], qn0[3], qn1[0], qn1[1], qn1[2], qn1[3]}, knv[8] = {kn0[0], kn0[1], kn0[2], kn0[3], kn1[0], kn1[1], kn1[2], kn1[3]};
#pragma unroll
    for (int i = 0; i < 4; ++i) { q[2 * i] = __uint_as_float(r.qa[i] << 16); q[2 * i + 1] = __uint_as_float(r.qa[i] & 0xffff0000u); k[2 * i] = __uint_as_float(r.ka[i] << 16); k[2 * i + 1] = __uint_as_float(r.ka[i] & 0xffff0000u); }
#pragma unroll
    for (int i = 0; i < 8; ++i) { sq += q[i] * q[i]; sk += k[i] * k[i]; }
    sq += __shfl_xor(sq, 1); sq += __shfl_xor(sq, 2); sq += __shfl_xor(sq, 4);
    sk += __shfl_xor(sk, 1); sk += __shfl_xor(sk, 2); sk += __shfl_xor(sk, 4);
    const float rq = rsqrtf(sq * (1.f / 64.f) + QK_EPS) * attn_body::C2, rk = rsqrtf(sk * (1.f / 64.f) + QK_EPS);
#pragma unroll
    for (int i = 0; i < 8; ++i) { q[i] = q[i] * rq * qnv[i]; k[i] = k[i] * rk * knv[i]; }
    *(v4u*)(F.QB + (size_t)m * 512 + 8 * lane) = pack8(q); *(v4u*)(F.KB + (size_t)m * 512 + 8 * lane) = pack8(k); *(v4u*)(F.VB + (size_t)m * 512 + 8 * lane) = r.va;
    if (lane < 8) { const float z = bf2f(r.fz) + F.bfp[lane]; const float lf = fminf(z, 0.f) - log1pexp_neg(fabsf(z)); const int b = m >> 12, t = m & 4095; F.LOGF[(size_t)(b * NH + lane) * SEQ + t] = lf; }
}

namespace rwk {
constexpr int OPS = 144;
constexpr int XPS = 336;
constexpr int O_WT = 0;
constexpr int O_A = 21504;
constexpr int O_XLH = O_A, O_XLL = O_A + 21504, O_PART = O_A;
constexpr int O_RT = O_A, O_AT = O_A + 9216, O_BT = O_A + 18432, O_KT = O_A + 27648;
constexpr int O_XT = O_AT;
constexpr int O_PT1 = O_KT;
constexpr int O_U2 = 64512;
constexpr int O_CUM = O_U2, O_BF = O_U2 + 16384, O_KF = O_U2 + 32768;
constexpr int O_PA0 = O_U2, O_PT0 = O_U2 + 9216, O_ARB = O_U2 + 18432, O_ARK = O_U2 + 27648, O_AAK = O_U2 + 36864, O_PA1 = O_AAK;
constexpr int O_VT = 113664, O_BHT = O_VT + 9216, O_KHT = O_VT + 18432, O_GAMC = 141312, O_RHS = 141568  , O_END = O_RHS + 16384;
static_assert(O_END <= CTRL_OFF, "RWKV arena below the LDS control area");

#define LDS_BARRIER() do { asm volatile("s_waitcnt lgkmcnt(0)" ::: "memory"); __builtin_amdgcn_s_barrier(); asm volatile("" ::: "memory"); } while (0)
struct Ptrs { const bf16* proj; const float *mu, *w0, *w2, *a0, *a2, *g2, *k_k, *k_a, *r_k; bf16 *G, *Bonus; bf16* Mc; bf16* NT; bf16* Qc; bf16* ZT; };
struct Pre { u32x2v xp[5], xq[5]; v4u rc, rp, kc, kp, vc, vp; };
struct Cvt { const float *w1, *w2; bf16 *W1T, *W2T; int it0; const FoxPtrs* fox; int foxm; };

__device__ __forceinline__ void stage_weights(LAS unsigned char* lds, int h, const Ptrs& P) {
    const int tid = threadIdx.x;
#pragma unroll
    for (int q = 0; q < 5; ++q) { const int p = tid + 512 * q, n = p & 63, j0 = 4 * (p >> 6);
        const float* src = (j0 < 32) ? (P.w2 + j0 * 512) : ((j0 < 64) ? (P.a2 + (j0 - 32) * 512) : (P.g2 + (j0 - 64) * 512));
        const float a = src[h * 64 + n], b = src[512 + h * 64 + n], c = src[1024 + h * 64 + n], d = src[1536 + h * 64 + n];
        u32x2v w; w.x = pg8::cvt_pk_bf16(a, b); w.y = pg8::cvt_pk_bf16(c, d); *(LAS u32x2v*)(lds + O_WT + n * XPS + j0 * 2) = w; }
}
__device__ __forceinline__ void prefetch(Pre& R, const int un, const Ptrs& P, const int tid) { const int b = un >> 9, h = (un >> 6) & 7, c = un & 63; const int tok0 = b * SEQ + c * 64;
    const int t = tid >> 3, hn0 = h * 64 + 8 * (tid & 7);
    const char* pb = (const char*)(P.proj + (size_t)tok0 * PL);
    const char* pbm = (c == 0) ? pb : pb - (size_t)PL * 2;
    const unsigned pshift = (c == 0) ? (unsigned)PL * 2u : 0u;
#pragma unroll
    for (int i = 0; i < 5; ++i) { const int idx = tid + 512 * i, tt = idx / 40, c4 = idx - tt * 40; const unsigned off = (unsigned)(tt * PL + C_WD + 4 * c4) * 2u;
        R.xp[i] = *(const u32x2v*)(pb + off); R.xq[i] = (c == 0 && tt == 0) ? (u32x2v){0u, 0u} : *(const u32x2v*)(pbm + (off - pshift)); }
    const bool first = (c == 0 && t == 0); const unsigned off = (unsigned)(t * PL + hn0) * 2u;
    R.rc = *(const v4u*)(pb + off + C_R * 2); R.kc = *(const v4u*)(pb + off + C_K * 2); R.vc = *(const v4u*)(pb + off + C_V * 2);
    if (first) { R.rp = (v4u){0u, 0u, 0u, 0u}; R.kp = R.rp; R.vp = R.rp; }
    else { R.rp = *(const v4u*)(pbm + (off - pshift) + C_R * 2); R.kp = *(const v4u*)(pbm + (off - pshift) + C_K * 2); R.vp = *(const v4u*)(pbm + (off - pshift) + C_V * 2); }
}

__device__ __forceinline__ void unit(LAS unsigned char* lds, const int un, const Ptrs& P, const Pre& R, Pre& Rn, const bool has_next, const int un_next, const Cvt& cv) {
    int tid_ = threadIdx.x; asm volatile("" : "+v"(tid_));
    const int tid = tid_, lane = tid & 63, w = __builtin_amdgcn_readfirstlane(tid >> 6);
    const int b = un >> 9, h = (un >> 6) & 7, c = un & 63; const int tok0 = b * SEQ + c * 64;
    LAS float* CU = (LAS float*)(lds + O_CUM); LAS float* BF = (LAS float*)(lds + O_BF); LAS float* KF = (LAS float*)(lds + O_KF);
    LAS float* RHS = (LAS float*)(lds + O_RHS); LAS float* PART = (LAS float*)(lds + O_PART); LAS float* GAMC = (LAS float*)(lds + O_GAMC);
    const int t = tid >> 3, cg = tid & 7, n0 = 8 * cg, hn0 = h * 64 + n0;
    const int fr = lane & 15, fq = lane >> 4;
    FoxRow fxr; const bool dofox = cv.foxm >= 0; if (dofox) fox_load(fxr, *cv.fox, cv.foxm, lane);
    const bool docv = cv.it0 >= 0; f32x4 cldA[8], cldB[8]; CvtItem ciA, ciB;
    if (docv) { ciA = cvt_item(cv.it0, cv.w1, cv.w2, cv.W1T, cv.W2T); cvt_load(cldA, ciA, lane); }
#define BF4(w) ((f32x4){__uint_as_float((w).x << 16), __uint_as_float((w).x & 0xffff0000u), __uint_as_float((w).y << 16), __uint_as_float((w).y & 0xffff0000u)})
#pragma unroll
    for (int i = 0; i < 5; ++i) { const int idx = tid + 512 * i, tt = idx / 40, c4 = idx - tt * 40; const f32x4 m4 = *(const f32x4*)(P.mu + C_WD + 4 * c4);
        const f32x4 xp = BF4(R.xp[i]), xq = BF4(R.xq[i]); f32x4 x = xp + m4 * (xq - xp); float hi[4], lo[4];
#pragma unroll
        for (int e = 0; e < 4; ++e) { const int j = 4 * c4 + e; const float y = (j < 32) ? tanh_fast(x[e]) : ((j < 64) ? x[e] : sigmoidf_(x[e])); hi[e] = bf2f(f2bf16(y)); lo[e] = y - hi[e]; }
        u32x2v wh, wl; wh.x = pg8::cvt_pk_bf16(hi[0], hi[1]); wh.y = pg8::cvt_pk_bf16(hi[2], hi[3]); wl.x = pg8::cvt_pk_bf16(lo[0], lo[1]); wl.y = pg8::cvt_pk_bf16(lo[2], lo[3]);
        *(LAS u32x2v*)(lds + O_XLH + tt * XPS + c4 * 8) = wh; *(LAS u32x2v*)(lds + O_XLL + tt * XPS + c4 * 8) = wl; }
    float r8[8], k8[8], v8[8];
    { u32x2v a; f32x4 rc[2], rp[2], kc[2], kp[2], vc[2], vp[2];
      a = (u32x2v){R.rc.x, R.rc.y}; rc[0] = BF4(a); a = (u32x2v){R.rc.z, R.rc.w}; rc[1] = BF4(a); a = (u32x2v){R.rp.x, R.rp.y}; rp[0] = BF4(a); a = (u32x2v){R.rp.z, R.rp.w}; rp[1] = BF4(a);
      a = (u32x2v){R.kc.x, R.kc.y}; kc[0] = BF4(a); a = (u32x2v){R.kc.z, R.kc.w}; kc[1] = BF4(a); a = (u32x2v){R.kp.x, R.kp.y}; kp[0] = BF4(a); a = (u32x2v){R.kp.z, R.kp.w}; kp[1] = BF4(a);
      a = (u32x2v){R.vc.x, R.vc.y}; vc[0] = BF4(a); a = (u32x2v){R.vc.z, R.vc.w}; vc[1] = BF4(a); a = (u32x2v){R.vp.x, R.vp.y}; vp[0] = BF4(a); a = (u32x2v){R.vp.z, R.vp.w}; vp[1] = BF4(a);
#pragma unroll
      for (int hf = 0; hf < 2; ++hf) { const f32x4 mr = *(const f32x4*)(P.mu + C_R + hn0 + 4 * hf), mk = *(const f32x4*)(P.mu + C_K + hn0 + 4 * hf), mv = *(const f32x4*)(P.mu + C_V + hn0 + 4 * hf);
          const f32x4 r = rc[hf] + mr * (rp[hf] - rc[hf]), k = kc[hf] + mk * (kp[hf] - kc[hf]), v = vc[hf] + mv * (vp[hf] - vc[hf]);
#pragma unroll
          for (int e = 0; e < 4; ++e) { r8[4 * hf + e] = r[e]; k8[4 * hf + e] = k[e]; v8[4 * hf + e] = v[e]; } } }
#undef BF4
    LDS_BARRIER();
    if (docv) { ciB = cvt_item(cv.it0 + 1, cv.w1, cv.w2, cv.W1T, cv.W2T); cvt_load(cldB, ciB, lane); }
    {
        const int tt = w & 3;
#pragma unroll
        for (int cc = 0; cc < 2; ++cc) { const int nt = 2 * (w >> 2) + cc; f32x4 acc[3];
#pragma unroll
            for (int a = 0; a < 3; ++a) acc[a] = (f32x4){0.f, 0.f, 0.f, 0.f};
#pragma unroll
            for (int ks = 0; ks < 5; ++ks) { const int a = (ks == 0) ? 0 : ((ks == 1) ? 1 : 2);
                const bf16x8 bw = *(const LAS bf16x8*)(lds + O_WT + (16 * nt + fr) * XPS + (32 * ks + 8 * fq) * 2);
                const bf16x8 xh = *(const LAS bf16x8*)(lds + O_XLH + (16 * tt + fr) * XPS + (32 * ks + 8 * fq) * 2), xl = *(const LAS bf16x8*)(lds + O_XLL + (16 * tt + fr) * XPS + (32 * ks + 8 * fq) * 2);
                acc[a] = MFMA16(xh, bw, acc[a]); acc[a] = MFMA16(xl, bw, acc[a]); }
#pragma unroll
            for (int a = 0; a < 3; ++a)
#pragma unroll
                for (int j = 0; j < 4; ++j) CU[a * 4096 + (16 * tt + 4 * fq + j) * 64 + 16 * nt + fr] = acc[a][j]; }
    }
    LDS_BARRIER();
    if (dofox) fox_finish(fxr, *cv.fox, cv.foxm, lane);
    float a8[8], b8[8], lw8[8];
    {
        float accw[8], acca[8], accg[8];
        { const f32x4 q0 = *(const LAS f32x4*)(CU + t * 64 + n0), q1 = *(const LAS f32x4*)(CU + t * 64 + n0 + 4), q2 = *(const LAS f32x4*)(BF + t * 64 + n0), q3 = *(const LAS f32x4*)(BF + t * 64 + n0 + 4), q4 = *(const LAS f32x4*)(KF + t * 64 + n0), q5 = *(const LAS f32x4*)(KF + t * 64 + n0 + 4);
#pragma unroll
          for (int e = 0; e < 4; ++e) { accw[e] = q0[e]; accw[4 + e] = q1[e]; acca[e] = q2[e]; acca[4 + e] = q3[e]; accg[e] = q4[e]; accg[4 + e] = q5[e]; } }
        float kkr[8], lr8[8], g8[8]; float ss = 0.f, dotb = 0.f;
        float pw0[8], pa0[8], pkk[8], pka[8], prk[8];
#pragma unroll
        for (int hf = 0; hf < 2; ++hf) { const f32x4 q0 = *(const f32x4*)(P.w0 + hn0 + 4 * hf), q1 = *(const f32x4*)(P.a0 + hn0 + 4 * hf), q2 = *(const f32x4*)(P.k_k + hn0 + 4 * hf), q3 = *(const f32x4*)(P.k_a + hn0 + 4 * hf), q4 = *(const f32x4*)(P.r_k + hn0 + 4 * hf);
#pragma unroll
            for (int e = 0; e < 4; ++e) { pw0[4 * hf + e] = q0[e]; pa0[4 * hf + e] = q1[e]; pkk[4 * hf + e] = q2[e]; pka[4 * hf + e] = q3[e]; prk[4 * hf + e] = q4[e]; } }
#pragma unroll
        for (int i = 0; i < 8; ++i) {
            const float xw = pw0[i] + accw[i];
            const float wv = fminf(xw, 0.f) - log1pexp_neg(fabsf(xw)) - 0.5f;
            lw8[i] = -__expf(wv);
            lr8[i] = sigmoidf_(pa0[i] + acca[i]); g8[i] = accg[i];
            kkr[i] = k8[i] * pkk[i]; ss += kkr[i] * kkr[i];
            k8[i] = k8[i] * (1.f + (lr8[i] - 1.f) * pka[i]);
            dotb += r8[i] * k8[i] * prk[i]; }
        ss += __shfl_xor(ss, 1); ss += __shfl_xor(ss, 2); ss += __shfl_xor(ss, 4);
        dotb += __shfl_xor(dotb, 1); dotb += __shfl_xor(dotb, 2); dotb += __shfl_xor(dotb, 4);
        const float inv = 1.f / fmaxf(sqrtf(ss), 1e-12f);
        float bon[8];
#pragma unroll
        for (int i = 0; i < 8; ++i) { const float kk = kkr[i] * inv; a8[i] = -kk; b8[i] = kk * lr8[i]; bon[i] = dotb * v8[i]; }
        *(v4u*)(P.G + (size_t)(tok0 + t) * RWW + hn0) = pack8(g8); *(v4u*)(P.Bonus + (size_t)(tok0 + t) * RWW + hn0) = pack8(bon);
        *(LAS f32x4*)(CU + t * 64 + n0) = (f32x4){lw8[0], lw8[1], lw8[2], lw8[3]}; *(LAS f32x4*)(CU + t * 64 + n0 + 4) = (f32x4){lw8[4], lw8[5], lw8[6], lw8[7]};
        *(LAS f32x4*)(BF + t * 64 + n0) = (f32x4){b8[0], b8[1], b8[2], b8[3]}; *(LAS f32x4*)(BF + t * 64 + n0 + 4) = (f32x4){b8[4], b8[5], b8[6], b8[7]};
        *(LAS f32x4*)(KF + t * 64 + n0) = (f32x4){k8[0], k8[1], k8[2], k8[3]}; *(LAS f32x4*)(KF + t * 64 + n0 + 4) = (f32x4){k8[4], k8[5], k8[6], k8[7]};
        LAS unsigned short* VT = (LAS unsigned short*)(lds + O_VT);
#pragma unroll
        for (int i = 0; i < 8; ++i) VT[(n0 + i) * 72 + t] = f2bf16(v8[i]);
    }
    LDS_BARRIER();
    if (docv) { cvt_finish(cldA, ciA, lane); ciA = cvt_item(cv.it0 + 2, cv.w1, cv.w2, cv.W1T, cv.W2T); cvt_load(cldA, ciA, lane); }
    {
        const int n = tid & 63, tg = w; float run = 0.f;
#pragma unroll
        for (int i = 0; i < 8; ++i) { run += CU[(8 * tg + i) * 64 + n]; CU[(8 * tg + i) * 64 + n] = run; }
        PART[tg * 64 + n] = run;
        LDS_BARRIER();
        float off = 0.f;
        for (int g = 0; g < tg; ++g) off += PART[g * 64 + n];
#pragma unroll
        for (int i = 0; i < 8; ++i) CU[(8 * tg + i) * 64 + n] += off;
        if (tg == 7) GAMC[n] = __expf(run + off);
    }
    LDS_BARRIER();
    {
        const f32x4 c0 = *(const LAS f32x4*)(CU + t * 64 + n0), c1 = *(const LAS f32x4*)(CU + t * 64 + n0 + 4);
        const float cum[8] = {c0[0], c0[1], c0[2], c0[3], c1[0], c1[1], c1[2], c1[3]};
        float rt[8], at[8], bt[8], kt[8];
#pragma unroll
        for (int i = 0; i < 8; ++i) { const float ein = __expf(cum[i]), eex = __expf(cum[i] - lw8[i]), eneg = __expf(-cum[i]);
            rt[i] = r8[i] * ein; at[i] = a8[i] * eex; bt[i] = b8[i] * eneg; kt[i] = k8[i] * eneg; }
        *(LAS v4u*)(lds + O_RT + t * OPS + cg * 16) = pack8(rt); *(LAS v4u*)(lds + O_AT + t * OPS + cg * 16) = pack8(at);
        *(LAS v4u*)(lds + O_BT + t * OPS + cg * 16) = pack8(bt); *(LAS v4u*)(lds + O_KT + t * OPS + cg * 16) = pack8(kt);
        *(LAS f32x4*)(RHS + t * 64 + n0) = (f32x4){at[0], at[1], at[2], at[3]}; *(LAS f32x4*)(RHS + t * 64 + n0 + 4) = (f32x4){at[4], at[5], at[6], at[7]};
    }
    {
        const int n = tid & 63, tg = w; const float cC = CU[63 * 64 + n]; float bh[8], kh[8];
#pragma unroll
        for (int i = 0; i < 8; ++i) { const int tt = 8 * tg + i; const float e = __expf(cC - CU[tt * 64 + n]); bh[i] = BF[tt * 64 + n] * e; kh[i] = KF[tt * 64 + n] * e; }
        *(LAS v4u*)(lds + O_BHT + n * OPS + tg * 16) = pack8(bh); *(LAS v4u*)(lds + O_KHT + n * OPS + tg * 16) = pack8(kh);
    }
    LDS_BARRIER();
    if (docv) cvt_finish(cldB, ciB, lane);
    if (has_next) prefetch(Rn, un_next, P, tid);
#define FRAG(off, row, ks) (*(const LAS bf16x8*)(lds + (off) + (row) * OPS + (ks) * 64 + fq * 16))
    {
        const int tt = w & 3, mg = w >> 2; const int lo = mg ? O_RT : O_AT;
        LAS unsigned short* AAK = (LAS unsigned short*)(lds + O_AAK); LAS unsigned short* ARB = (LAS unsigned short*)(lds + O_ARB); LAS unsigned short* ARK = (LAS unsigned short*)(lds + O_ARK);
        LAS unsigned short* PA0 = (LAS unsigned short*)(lds + O_PA0);
        const bf16x8 l0 = FRAG(lo, 16 * tt + fr, 0), l1 = FRAG(lo, 16 * tt + fr, 1);
#pragma unroll
        for (int ct = 0; ct < 4; ++ct)
#pragma unroll
            for (int rh = 0; rh < 2; ++rh) {
                f32x4 acc = {0.f, 0.f, 0.f, 0.f};
                if (ct <= tt) { const int ro = rh ? O_KT : O_BT; acc = MFMA16(l0, FRAG(ro, 16 * ct + fr, 0), acc); acc = MFMA16(l1, FRAG(ro, 16 * ct + fr, 1), acc); }
                const int col = 16 * ct + fr, rowb = 16 * tt + 4 * fq; float vv[4];
#pragma unroll
                for (int j = 0; j < 4; ++j) vv[j] = (mg == 0) ? ((col < rowb + j) ? acc[j] : 0.f) : ((col <= rowb + j) ? acc[j] : 0.f);
                LAS unsigned short* dst = (mg == 0) ? (rh == 0 ? PA0 : AAK) : (rh == 0 ? ARB : ARK);
#pragma unroll
                for (int j = 0; j < 4; ++j) dst[(rowb + j) * 72 + col] = f2bf16(vv[j]);
                if (mg == 0 && rh == 0) { u32x2v pk; pk.x = pg8::cvt_pk_bf16(vv[0], vv[1]); pk.y = pg8::cvt_pk_bf16(vv[2], vv[3]); *(LAS u32x2v*)(lds + O_PT0 + col * OPS + rowb * 2) = pk; }
            }
    }
    LDS_BARRIER();
    {
        f32x4 X[4];
        if (w < 4) {
#pragma unroll
            for (int tt = 0; tt < 4; ++tt)
#pragma unroll
                for (int j = 0; j < 4; ++j) X[tt][j] = RHS[(16 * tt + 4 * fq + j) * 64 + 16 * w + fr];
        } else {
#pragma unroll
            for (int tt = 0; tt < 4; ++tt) { f32x4 acc = {0.f, 0.f, 0.f, 0.f};
                acc = MFMA16(FRAG(O_AAK, 16 * tt + fr, 0), FRAG(O_VT, 16 * (w - 4) + fr, 0), acc); acc = MFMA16(FRAG(O_AAK, 16 * tt + fr, 1), FRAG(O_VT, 16 * (w - 4) + fr, 1), acc); X[tt] = acc; }
        }
        LDS_BARRIER();
#pragma unroll
        for (int k = 0; k < 6; ++k) {
            const int pa = (k & 1) ? O_PA1 : O_PA0, pt = (k & 1) ? O_PT1 : O_PT0, pan = (k & 1) ? O_PA0 : O_PA1, ptn = (k & 1) ? O_PT0 : O_PT1;
            bf16x8 xb[2];
#pragma unroll
            for (int ks = 0; ks < 2; ++ks) { v4u q; q.x = pk2(X[2 * ks][0], X[2 * ks][1]); q.y = pk2(X[2 * ks][2], X[2 * ks][3]); q.z = pk2(X[2 * ks + 1][0], X[2 * ks + 1][1]); q.w = pk2(X[2 * ks + 1][2], X[2 * ks + 1][3]); xb[ks] = __builtin_bit_cast(bf16x8, q); }
#pragma unroll
            for (int tt = 0; tt < 4; ++tt)
#pragma unroll
                for (int ks = 0; ks < 2; ++ks) { const LAS unsigned char* rp_ = lds + pa + (16 * tt + fr) * OPS + (32 * ks + 4 * fq) * 2;
                    const u32x2v p0 = *(const LAS u32x2v*)rp_, p1 = *(const LAS u32x2v*)(rp_ + 32); const v4u pq = {p0.x, p0.y, p1.x, p1.y};
                    X[tt] = MFMA16(__builtin_bit_cast(bf16x8, pq), xb[ks], X[tt]); }
            if (k < 5) {
                const int tt = w & 3;
#pragma unroll
                for (int cc = 0; cc < 2; ++cc) { const int ct = 2 * (w >> 2) + cc; f32x4 acc = {0.f, 0.f, 0.f, 0.f};
                    acc = MFMA16(FRAG(pa, 16 * tt + fr, 0), FRAG(pt, 16 * ct + fr, 0), acc); acc = MFMA16(FRAG(pa, 16 * tt + fr, 1), FRAG(pt, 16 * ct + fr, 1), acc);
                    const int col = 16 * ct + fr, rowb = 16 * tt + 4 * fq; LAS unsigned short* PAn = (LAS unsigned short*)(lds + pan);
#pragma unroll
                    for (int j = 0; j < 4; ++j) PAn[(rowb + j) * 72 + col] = f2bf16(acc[j]);
                    u32x2v pk; pk.x = pk2(acc[0], acc[1]); pk.y = pk2(acc[2], acc[3]); *(LAS u32x2v*)(lds + ptn + col * OPS + rowb * 2) = pk; }
            }
            LDS_BARRIER();
        }
#pragma unroll
        for (int tt = 0; tt < 4; ++tt) { u32x2v pk; pk.x = pk2(X[tt][0], X[tt][1]); pk.y = pk2(X[tt][2], X[tt][3]); *(LAS u32x2v*)(lds + O_XT + (16 * w + fr) * OPS + (16 * tt + 4 * fq) * 2) = pk; }
    }
    LDS_BARRIER();
    if (docv) cvt_finish(cldA, ciA, lane);
#ifdef RW_REP_S7
    for (int rep_ = 0; rep_ < 2; ++rep_)
#endif
    {
        asm volatile("" ::: "memory");
        const int rt = w & 3; const size_t ub = (size_t)un * 4096;
        const LAS unsigned short* RTb = (const LAS unsigned short*)(lds + O_RT);
#pragma unroll
        for (int cc = 0; cc < 2; ++cc) { const int ct = 2 * (w >> 2) + cc;
            const bf16x8 arb0 = FRAG(O_ARB, 16 * rt + fr, 0), arb1 = FRAG(O_ARB, 16 * rt + fr, 1), ark0 = FRAG(O_ARK, 16 * rt + fr, 0), ark1 = FRAG(O_ARK, 16 * rt + fr, 1);
            const bf16x8 bht0 = FRAG(O_BHT, 16 * rt + fr, 0), bht1 = FRAG(O_BHT, 16 * rt + fr, 1), kht0 = FRAG(O_KHT, 16 * rt + fr, 0), kht1 = FRAG(O_KHT, 16 * rt + fr, 1);
            const bf16x8 xa0 = FRAG(O_XT, 16 * ct + fr, 0), xa1 = FRAG(O_XT, 16 * ct + fr, 1), xv0 = FRAG(O_XT, 64 + 16 * ct + fr, 0), xv1 = FRAG(O_XT, 64 + 16 * ct + fr, 1);
            const bf16x8 vt0 = FRAG(O_VT, 16 * ct + fr, 0), vt1 = FRAG(O_VT, 16 * ct + fr, 1);
            f32x4 z4 = {0.f, 0.f, 0.f, 0.f};
            f32x4 q = MFMA16(arb0, xa0, z4); q = MFMA16(arb1, xa1, q);
            f32x4 z = MFMA16(arb0, xv0, z4); z = MFMA16(arb1, xv1, z); z = MFMA16(ark0, vt0, z); z = MFMA16(ark1, vt1, z);
            f32x4 m = MFMA16(bht0, xa0, z4); m = MFMA16(bht1, xa1, m);
            f32x4 nn = MFMA16(bht0, xv0, z4); nn = MFMA16(bht1, xv1, nn); nn = MFMA16(kht0, vt0, nn); nn = MFMA16(kht1, vt1, nn);
            const int col = 16 * ct + fr;
            const int mks = col >> 5, mfq = (col & 15) >> 2, me = 4 * ((col >> 4) & 1) + (col & 3);
#pragma unroll
            for (int j = 0; j < 4; ++j) { const int row = 16 * rt + 4 * fq + j;
                P.Qc[ub + row * 64 + col] = f2bf16(q[j] + bf2f(RTb[row * 72 + col]));
                P.Mc[ub + (((rt * 2 + mks) * 64) + mfq * 16 + (row & 15)) * 8 + me] = f2bf16(m[j] + ((row == col) ? GAMC[row] : 0.f)); }
            { u32x2v pz; pz.x = pk2(z[0], z[1]); pz.y = pk2(z[2], z[3]);     *(u32x2v*)(P.ZT + ub + col * 64 + 16 * rt + 4 * fq) = pz; }
            { u32x2v pn; pn.x = pk2(nn[0], nn[1]); pn.y = pk2(nn[2], nn[3]); *(u32x2v*)(P.NT + ub + ((ct * 4 + rt) * 64 + lane) * 4) = pn; }
        }
    }
#undef FRAG
    LDS_BARRIER();
}

constexpr int CH_SLOT = 16384, CH_NSLOT = 9, CH_AHEAD = 7;
__device__ __forceinline__ void glds16(const void* gsrc, unsigned lds_dst) { unsigned keep;
    asm volatile("s_mov_b32 %0, m0\n\ts_mov_b32 m0, %2\n\ts_nop 0\n\tglobal_load_lds_dwordx4 %1, off\n\ts_mov_b32 m0, %0" : "=&s"(keep) : "v"(gsrc), "s"(lds_dst) : "memory"); }
__device__ __forceinline__ void chain(LAS unsigned char* lds, int bh, const bf16* Mc, const bf16* NT, bf16* SH, bf16* SL) {
    const int tid = threadIdx.x, lane = tid & 63, w = __builtin_amdgcn_readfirstlane(tid >> 6), fr = lane & 15, fq = lane >> 4;
    const unsigned lds0 = (unsigned)(uintptr_t)lds;
    if (w >= 4) {
        const int k = w - 4;
#define CH_ISSUE(cc) do { const size_t ub_ = (size_t)(bh * 64 + (cc)) * 4096; const unsigned sl_ = lds0 + (unsigned)(((cc) % CH_NSLOT) * CH_SLOT); \
            _Pragma("unroll") for (int i_ = 0; i_ < 4; ++i_) { const int p_ = k + 4 * i_; \
                const void* src_ = (p_ < 8) ? (const void*)(Mc + ub_ + p_ * 512 + lane * 8) : (const void*)(NT + ub_ + (p_ - 8) * 512 + lane * 8); \
                glds16(src_, (unsigned)__builtin_amdgcn_readfirstlane(sl_ + p_ * 1024)); } } while (0)
        for (int cc = 0; cc < CH_AHEAD; ++cc) CH_ISSUE(cc);
        for (int c = 0; c < 64; ++c) {
            if (c + CH_AHEAD < 64) CH_ISSUE(c + CH_AHEAD);
            const int left = 63 - c;
            if (left >= 7) asm volatile("s_waitcnt vmcnt(28)" ::: "memory"); else if (left == 6) asm volatile("s_waitcnt vmcnt(24)" ::: "memory"); else if (left == 5) asm volatile("s_waitcnt vmcnt(20)" ::: "memory");
            else if (left == 4) asm volatile("s_waitcnt vmcnt(16)" ::: "memory"); else if (left == 3) asm volatile("s_waitcnt vmcnt(12)" ::: "memory"); else if (left == 2) asm volatile("s_waitcnt vmcnt(8)" ::: "memory");
            else if (left == 1) asm volatile("s_waitcnt vmcnt(4)" ::: "memory"); else asm volatile("s_waitcnt vmcnt(0)" ::: "memory");
            __builtin_amdgcn_s_barrier();
        }
#undef CH_ISSUE
    } else {
        const int vq = w;
        f32x4 S[4];
#pragma unroll
        for (int i = 0; i < 4; ++i) S[i] = (f32x4){0.f, 0.f, 0.f, 0.f};
        for (int c = 0; c < 64; ++c) {
            __builtin_amdgcn_s_barrier(); asm volatile("" ::: "memory");
            const LAS unsigned char* sl = lds + (c % CH_NSLOT) * CH_SLOT;
            const size_t ub = (size_t)(bh * 64 + c) * 4096;
            bf16x8 bh_[2], bl_[2];
#pragma unroll
            for (int ks = 0; ks < 2; ++ks) { float hi8[8], lo8[8];
#pragma unroll
                for (int e = 0; e < 8; ++e) { const float s = S[2 * ks + (e >> 2)][e & 3]; const float hh = bf2f(f2bf16(s)); hi8[e] = hh; lo8[e] = s - hh; }
                const v4u ph = pack8(hi8), pl = pack8(lo8); bh_[ks] = __builtin_bit_cast(bf16x8, ph); bl_[ks] = __builtin_bit_cast(bf16x8, pl);
                u32x2v h0 = {ph.x, ph.y}, h1 = {ph.z, ph.w}, l0 = {pl.x, pl.y}, l1 = {pl.z, pl.w};
                const size_t o = ub + (size_t)(16 * vq + fr) * 64 + 32 * ks + 4 * fq;
                *(u32x2v*)(SH + o) = h0; *(u32x2v*)(SH + o + 16) = h1; *(u32x2v*)(SL + o) = l0; *(u32x2v*)(SL + o + 16) = l1; }
#pragma unroll
            for (int mt = 0; mt < 4; ++mt) {
                const bf16x8 a0 = *(const LAS bf16x8*)(sl + ((mt * 2 + 0) * 64 + lane) * 16), a1 = *(const LAS bf16x8*)(sl + ((mt * 2 + 1) * 64 + lane) * 16);
                const u32x2v nw = *(const LAS u32x2v*)(sl + 8192 + ((vq * 4 + mt) * 64 + lane) * 8);
                f32x4 sn = {__uint_as_float(nw.x << 16), __uint_as_float(nw.x & 0xffff0000u), __uint_as_float(nw.y << 16), __uint_as_float(nw.y & 0xffff0000u)};
                sn = MFMA16(a0, bh_[0], sn); sn = MFMA16(a1, bh_[1], sn); sn = MFMA16(a0, bl_[0], sn); sn = MFMA16(a1, bl_[1], sn);
                S[mt] = sn;
            }
        }
    }
}
__device__ __forceinline__ void yout(int un, int tt, int lane, const bf16* Qc, const bf16* ZT, const bf16* SH, const bf16* SL, const bf16* G, const bf16* Bonus, const float* gnw, const float* gnb, bf16* MIX) {
    const int fr = lane & 15, fq = lane >> 4; const int b = un >> 9, h = (un >> 6) & 7, c = un & 63; const size_t ub = (size_t)un * 4096;
    bf16x8 qf[2];
#pragma unroll
    for (int ks = 0; ks < 2; ++ks) qf[ks] = *(const bf16x8*)(Qc + ub + (16 * tt + fr) * 64 + 32 * ks + 8 * fq);
    f32x4 y[4];
#pragma unroll
    for (int vt = 0; vt < 4; ++vt) { const u32x2v zw = *(const u32x2v*)(ZT + ub + (16 * vt + fr) * 64 + 16 * tt + 4 * fq);
        f32x4 acc = {__uint_as_float(zw.x << 16), __uint_as_float(zw.x & 0xffff0000u), __uint_as_float(zw.y << 16), __uint_as_float(zw.y & 0xffff0000u)};
#pragma unroll
        for (int ks = 0; ks < 2; ++ks) { const size_t o = ub + (16 * vt + fr) * 64 + 32 * ks + 8 * fq;
            acc = MFMA16(qf[ks], *(const bf16x8*)(SH + o), acc); acc = MFMA16(qf[ks], *(const bf16x8*)(SL + o), acc); }
        y[vt] = acc; }
    const size_t tokb = (size_t)(b * SEQ + c * 64 + 16 * tt + 4 * fq);
#pragma unroll
    for (int j = 0; j < 4; ++j) {
        float s = (y[0][j] + y[1][j]) + (y[2][j] + y[3][j]);
        s += __shfl_xor(s, 1); s += __shfl_xor(s, 2); s += __shfl_xor(s, 4); s += __shfl_xor(s, 8);
        const float mean = s * (1.f / 64.f); float d[4], s2 = 0.f;
#pragma unroll
        for (int vt = 0; vt < 4; ++vt) { d[vt] = y[vt][j] - mean; s2 += d[vt] * d[vt]; }
        s2 += __shfl_xor(s2, 1); s2 += __shfl_xor(s2, 2); s2 += __shfl_xor(s2, 4); s2 += __shfl_xor(s2, 8);
        const float rstd = rsqrtf(s2 * (1.f / 64.f) + GN_EPS);
#pragma unroll
        for (int vt = 0; vt < 4; ++vt) { const int ch = h * 64 + 16 * vt + fr; const size_t o = (tokb + j) * RWW + ch;
            const float val = (d[vt] * rstd * gnw[ch] + gnb[ch] + bf2f(Bonus[o])) * bf2f(G[o]);
            MIX[(tokb + j) * D + ch] = f2bf16(val); }
    }
}
}

struct Args { const float* in[29]; float* out; unsigned char* ws; int ph_lo, ph_hi; };
enum { I_X = 0, I_LNINW, I_LNINB, I_WIN, I_MU, I_W0, I_W2, I_A0, I_A2, I_G2, I_KK, I_KA, I_RK, I_GNW, I_GNB, I_BF, I_QN, I_KN, I_WO, I_LN1W, I_LN1B, I_RW, I_RB, I_W1, I_B1, I_EW2, I_B2, I_LN2W, I_LN2B };
constexpr int N_PHASES = 11;

__device__ __forceinline__ int fresh_tid() { int t = threadIdx.x; asm volatile("" : "+v"(t)); return t; }
__global__ void __launch_bounds__(NTHR, 2) fwd_kernel(Args args) {
    extern __shared__ __attribute__((aligned(16))) unsigned char lds_raw[];
    LAS unsigned char* lds = (LAS unsigned char*)lds_raw;
    volatile LAS unsigned* MISC = (volatile LAS unsigned*)(lds + CTRL_OFF + LC_MISC);
    const int tid = threadIdx.x, lane = tid & 63, wave = __builtin_amdgcn_readfirstlane(tid >> 6);
    const int G = gridDim.x, bx = blockIdx.x;
    const int gw = bx * NWAVES + wave, NGW = G * NWAVES;
    unsigned char* ws = args.ws;
    gu32* ctl = (gu32*)(ws + WS_CTL);
    for (int u = tid; u < (LDS_BYTES - CTRL_OFF) / 4; u += NTHR) ((LAS unsigned*)(lds + CTRL_OFF))[u] = 0u;
    __syncthreads();
    const int lo = args.ph_lo, hi = args.ph_hi;
    const bool multi = (hi - lo) > 1;
    XcdBarrier bar; bar.bar = (unsigned*)(ctl + CW_BAR); bar.x = 0; bar.st = nullptr;
    if (multi) bar = xcd_barrier_post((unsigned*)(ctl + CW_BAR), MISC + 8);
#define IN(k) (lo <= (k) && (k) < hi)
#define SEAM(k) do { if (IN(k) && IN((k) + 1)) xcd_barrier(bar); } while (0)

    bf16* WIN_T = (bf16*)(ws + WS_WIN); bf16* WO_T = (bf16*)(ws + WS_WO); bf16* W1T = (bf16*)(ws + WS_W1T); bf16* W2T = (bf16*)(ws + WS_W2T);
    bf16* HB = (bf16*)(ws + WS_HB); float* HF = (float*)(ws + WS_HF); bf16* PROJ = (bf16*)(ws + WS_PROJ); float* DEAD = (float*)(ws + WS_PROJ + 128 * MiB);
    bf16* GB = (bf16*)(ws + WS_G); bf16* BONUS = (bf16*)(ws + WS_BONUS);
    bf16* QB = (bf16*)(ws + WS_QB); bf16* KB = (bf16*)(ws + WS_KB); bf16* VB = (bf16*)(ws + WS_VB); bf16* MIX = (bf16*)(ws + WS_MIX);
    bf16* MC = (bf16*)(ws + WS_MC); bf16* NT = (bf16*)(ws + WS_NT); bf16* QC = (bf16*)(ws + WS_QC); bf16* ZT = (bf16*)(ws + WS_ZT); bf16* SH = (bf16*)(ws + WS_Y); bf16* SL = (bf16*)(ws + WS_Y + 16 * MiB);
    float* LOGF = (float*)(ws + WS_LOGF);
    int* AE = (int*)(ws + WS_AE); int* APOS = (int*)(ws + WS_APOS); float* AGATE = (float*)(ws + WS_AGATE); int* AROW = (int*)(ws + WS_AROW); float* ROWGATE = (float*)(ws + WS_ROWGATE); int* ROWTOK = (int*)(ws + WS_ROWTOK);
    bf16* XS = (bf16*)(ws + WS_XS); bf16* ACT = (bf16*)(ws + WS_ACT); bf16* EOUT = (bf16*)(ws + WS_EOUT);

    if (IN(0)) {
        const int tid = fresh_tid(), lane = tid & 63;
        LAS float* scr = (LAS float*)(lds + wave * 16384);
        constexpr int I_IN = 16 * 120, I_O = 16 * 32, I_1 = 16 * 64, I_2 = 16 * 32;
        constexpr int NITEMS = I_IN + I_O;
        for (int it = gw; it < NITEMS; it += NGW) {
            int r = it;
            if (r < I_IN) { transpose_item(args.in[I_WIN], D, IN_COLS, 120, WIN_T, scr, r, lane); continue; } r -= I_IN;
            transpose_item(args.in[I_WO], D, D, 32, WO_T, scr, r, lane);
        }
        for (int m = gw; m < M; m += NGW) { f32x4 v[4];
#pragma unroll
            for (int j = 0; j < 4; ++j) v[j] = *(const f32x4*)(args.in[I_X] + (size_t)m * D + 4 * lane + 256 * j);
            ln_finish(v, args.in[I_LNINW], args.in[I_LNINB], lane, nullptr, HB + (size_t)m * D); }
    }
    SEAM(0);
    if (IN(1)) {
        const int tid = fresh_tid(), lane = tid & 63;
        pg8::Gemm g{HB, WIN_T, M, PL, D}; pg8::StaticOrder S; S.init(M, PL, G, bx);
        pg8::EpiBf16 E{PROJ, PL};
        pg8::gemm_phase<pg8::EpiBf16, pg8::StaticOrder, true, true>(lds + RING_OFF, g, S, E);
    }
    SEAM(1);
    if (IN(2)) {
        const int tid = fresh_tid(), lane = tid & 63;
        rwk::Ptrs P{PROJ, args.in[I_MU], args.in[I_W0], args.in[I_W2], args.in[I_A0], args.in[I_A2], args.in[I_G2], args.in[I_KK], args.in[I_KA], args.in[I_RK], GB, BONUS, MC, NT, QC, ZT};
        {
            const FoxPtrs FX{PROJ, args.in[I_QN], args.in[I_KN], args.in[I_BF], QB, KB, VB, LOGF};
            const int h = bx & 7, ngrp = G >> 3; int idx = bx >> 3;
            if (idx < ngrp) {
                rwk::stage_weights(lds, h, P);
                rwk::Pre R0, R1;
#define RW_UN(i) ((((i) >> 6) * NH + h) * 64 + ((i) & 63))
                if (idx < BATCH * 64) rwk::prefetch(R0, RW_UN(idx), P, tid);
                const int nslot = (BATCH * 64 + ngrp - 1) / ngrp; int us = 0;
                for (; idx < BATCH * 64; idx += ngrp, ++us) { const int nx = idx + ngrp; const int it0 = ((bx * NWAVES + wave) * nslot + us) * 3;
                    const int fm = (bx * NWAVES + wave) * nslot + us;
                    const rwk::Cvt cv{args.in[I_W1], args.in[I_EW2], W1T, W2T, (it0 + 2 < NE * 1536) ? it0 : -1, &FX, (fm < M) ? fm : -1};
                    rwk::unit(lds, RW_UN(idx), P, R0, R1, nx < BATCH * 64, RW_UN(nx), cv); R0 = R1; }
#undef RW_UN
            }
            {
                const int ngrp2 = G >> 3, nslot = (ngrp2 > 0) ? (BATCH * 64 + ngrp2 - 1) / ngrp2 : 0; const int covered = (ngrp2 > 0 && (G & 7) == 0 && (BATCH * 64) % ngrp2 == 0) ? G * NWAVES * nslot * 3 : 0;
                for (int it = covered + gw; it < NE * 1536; it += NGW) { f32x4 cld[8]; const CvtItem ci = cvt_item(it, args.in[I_W1], args.in[I_EW2], W1T, W2T); cvt_load(cld, ci, lane); cvt_finish(cld, ci, lane); }
            }
        }
        {
            const FoxPtrs FX{PROJ, args.in[I_QN], args.in[I_KN], args.in[I_BF], QB, KB, VB, LOGF};
            const int ngrp2 = G >> 3, nslot = (ngrp2 > 0) ? (BATCH * 64 + ngrp2 - 1) / ngrp2 : 0; const int covered = (ngrp2 > 0 && (G & 7) == 0 && (BATCH * 64) % ngrp2 == 0) ? G * NWAVES * nslot : 0;
            for (int m = covered + gw; m < M; m += NGW) { FoxRow r; fox_load(r, FX, m, lane); fox_finish(r, FX, m, lane); }
        }
    }
    SEAM(2);
    if (IN(3) || lo == 100 || lo == 101) {
        const int tid = fresh_tid(), lane = tid & 63;
        if (bx < 32) { if (lo != 100) rwk::chain(lds, bx, MC, NT, SH, SL); }
        else if (lo != 101) {
            const attn_body::AttnTensors AT{(const attn_body::bf16*)QB, (const attn_body::bf16*)KB, (const attn_body::bf16*)VB, (attn_body::bf16*)(MIX + 512), LOGF, PROJ};
            attn_body::attn_phase<40>((char*)lds_raw + RING_OFF, AT, (unsigned*)(ctl + CW_ATTQ + (lo == 100 ? 32 : 0)), MISC + 16);
        }
    }
    SEAM(3);
    if (IN(4)) {
        const int tid = fresh_tid(), lane = tid & 63;
        for (int task = gw; task < BATCH * NH * 64 * 4; task += NGW) rwk::yout(task >> 2, task & 3, lane, QC, ZT, SH, SL, GB, BONUS, args.in[I_GNW], args.in[I_GNB], MIX);
    }
    SEAM(4);
    if (IN(5) || lo == 103) {
        const int tid = fresh_tid(), lane = tid & 63;
        pg8::Gemm g{MIX, WO_T, M, D, D}; pg8::StaticOrder S; S.init(M, D, G, bx);
        pg8::EpiResid E{HB, (lo == 103) ? DEAD : HF, D, ALPHA};
        pg8::gemm_phase<pg8::EpiResid, pg8::StaticOrder, true, true>(lds + RING_OFF, g, S, E);
    }
    SEAM(5);
    if (IN(6) || lo == 102) {
        const int tid = fresh_tid(), lane = tid & 63;
        const bool prb = (lo == 102);
        float* HFo = prb ? DEAD : HF; bf16* HBo = prb ? (bf16*)(ws + WS_PROJ + 64 * MiB) : HB;
        int* AEo = prb ? (int*)(ws + WS_PROJ + 100 * MiB) : AE; int* APOSo = prb ? (int*)(ws + WS_PROJ + 101 * MiB) : APOS; float* AGATEo = prb ? (float*)(ws + WS_PROJ + 102 * MiB) : AGATE;
        unsigned* ecnt = (unsigned*)(ctl + CW_ECNT) + (prb ? 64 : 0);
        constexpr int XRS = 2064, O_XH = 0, O_XLO = 16 * XRS, O_PARTL = 2 * 16 * XRS, O_LGT = O_PARTL + 8 * 2048;
        LAS float* PARTL = (LAS float*)(lds + O_PARTL); LAS float* LGT = (LAS float*)(lds + O_LGT);
        LAS unsigned* HIST = (LAS unsigned*)(lds + CTRL_OFF + LC_HIST); LAS unsigned* BASE = (LAS unsigned*)(lds + CTRL_OFF + LC_BASE);
        LAS int* RI_E = (LAS int*)(lds + CTRL_OFF + LC_ROWINFO); LAS int* RI_P = RI_E + 256; LAS float* RI_G = (LAS float*)(RI_P + 256);
        const float* rw = args.in[I_RW]; const float* rb = args.in[I_RB];
        const int fr = lane & 15, fq = lane >> 4;
        bf16x8 wh[2][4], wl[2][4];
#pragma unroll
        for (int et = 0; et < 2; ++et)
#pragma unroll
            for (int ks = 0; ks < 4; ++ks) { float hi[8], lo[8];
#pragma unroll
                for (int i = 0; i < 8; ++i) { const float v = rw[(size_t)(128 * wave + 32 * ks + 8 * fq + i) * NE + 16 * et + fr]; hi[i] = bf2f(f2bf16(v)); lo[i] = v - hi[i]; }
                const v4u ph = pack8(hi), pl = pack8(lo); wh[et][ks] = __builtin_bit_cast(bf16x8, ph); wl[et][ks] = __builtin_bit_cast(bf16x8, pl); }
        if (tid < NE) HIST[tid] = 0u;
        __syncthreads();
        for (int r0 = bx * 64; r0 < M; r0 += G * 64) {
            for (int g = 0; g < 4; ++g) {
                f32x4 v[2][4];
#pragma unroll
                for (int u = 0; u < 2; ++u)
#pragma unroll
                    for (int j = 0; j < 4; ++j) v[u][j] = *(const f32x4*)(HF + (size_t)(r0 + 16 * g + 2 * wave + u) * D + 4 * lane + 256 * j);
#pragma unroll
                for (int u = 0; u < 2; ++u) { const int rl = 2 * wave + u; const int m = r0 + 16 * g + rl;
                    ln_finish(v[u], args.in[I_LN1W], args.in[I_LN1B], lane, nullptr, HBo + (size_t)m * D);
#pragma unroll
                    for (int j = 0; j < 4; ++j) { float hi[4], lo[4];
#pragma unroll
                        for (int e = 0; e < 4; ++e) { hi[e] = bf2f(f2bf16(v[u][j][e])); lo[e] = v[u][j][e] - hi[e]; }
                        u32x2v ph, pl; ph.x = pk2(hi[0], hi[1]); ph.y = pk2(hi[2], hi[3]); pl.x = pk2(lo[0], lo[1]); pl.y = pk2(lo[2], lo[3]);
                        *(LAS u32x2v*)(lds + O_XH + rl * XRS + (4 * lane + 256 * j) * 2) = ph; *(LAS u32x2v*)(lds + O_XLO + rl * XRS + (4 * lane + 256 * j) * 2) = pl; } }
                __syncthreads();
                f32x4 acc[2] = {{0.f, 0.f, 0.f, 0.f}, {0.f, 0.f, 0.f, 0.f}};
#pragma unroll
                for (int ks = 0; ks < 4; ++ks) { const bf16x8 xh = *(const LAS bf16x8*)(lds + O_XH + fr * XRS + (128 * wave + 32 * ks + 8 * fq) * 2), xl = *(const LAS bf16x8*)(lds + O_XLO + fr * XRS + (128 * wave + 32 * ks + 8 * fq) * 2);
#pragma unroll
                    for (int et = 0; et < 2; ++et) { acc[et] = MFMA16(xh, wh[et][ks], acc[et]); acc[et] = MFMA16(xl, wh[et][ks], acc[et]); acc[et] = MFMA16(xh, wl[et][ks], acc[et]); } }
#pragma unroll
                for (int et = 0; et < 2; ++et)
#pragma unroll
                    for (int j = 0; j < 4; ++j) PARTL[wave * 512 + (4 * fq + j) * 32 + 16 * et + fr] = acc[et][j];
                __syncthreads();
                { const int row = tid >> 5, e = tid & 31; float s = rb[e];
#pragma unroll
                  for (int w8 = 0; w8 < 8; ++w8) s += PARTL[w8 * 512 + row * 32 + e];
                  LGT[e * 64 + 16 * g + row] = s; }
            }
            __syncthreads();
            if (wave == 0) {
                float t0 = -INFINITY, t1 = -INFINITY, t2 = -INFINITY, t3 = -INFINITY; int i0 = 0, i1 = 0, i2 = 0, i3 = 0;
#pragma unroll 8
                for (int e = 0; e < NE; ++e) { const float x = LGT[e * 64 + lane];
                    if (x > t3) { if (x > t2) { t3 = t2; i3 = i2; if (x > t1) { t2 = t1; i2 = i1; if (x > t0) { t1 = t0; i1 = i0; t0 = x; i0 = e; } else { t1 = x; i1 = e; } } else { t2 = x; i2 = e; } } else { t3 = x; i3 = e; } } }
                const float e1 = __expf(t1 - t0), e2 = __expf(t2 - t0), e3 = __expf(t3 - t0); const float inv = 1.f / (1.f + e1 + e2 + e3);
                const float gt[4] = {inv, e1 * inv, e2 * inv, e3 * inv}; const int ti[4] = {i0, i1, i2, i3};
#pragma unroll
                for (int j = 0; j < 4; ++j) { const unsigned p = __hip_atomic_fetch_add(HIST + ti[j], 1u, __ATOMIC_RELAXED, __HIP_MEMORY_SCOPE_WORKGROUP); RI_E[lane * 4 + j] = ti[j]; RI_P[lane * 4 + j] = (int)p; RI_G[lane * 4 + j] = gt[j]; }
            }
            __syncthreads();
            if (tid < NE) { BASE[tid] = __hip_atomic_fetch_add(ecnt + tid, HIST[tid], __ATOMIC_RELAXED, __HIP_MEMORY_SCOPE_AGENT); HIST[tid] = 0u; }
            __syncthreads();
            if (tid < 256) { const int e = RI_E[tid]; const size_t a = (size_t)r0 * 4 + tid; AEo[a] = e; APOSo[a] = (int)BASE[e] + RI_P[tid]; AGATEo[a] = RI_G[tid]; }
            __syncthreads();
        }
    }
    SEAM(6);
#define TILE_TABLE() do { if (tid < 64) { LAS int* TS = (LAS int*)(lds + CTRL_OFF + LC_TSTART); LAS unsigned char* TE = (LAS unsigned char*)(lds + CTRL_OFF + LC_TEXP); \
        const int cnt = (tid < NE) ? (int)__hip_atomic_load((unsigned*)(ctl + CW_ECNT) + tid, __ATOMIC_RELAXED, __HIP_MEMORY_SCOPE_AGENT) : 0; const int nt_ = (cnt + 255) >> 8; \
        int inc_ = nt_; _Pragma("unroll") for (int o_ = 1; o_ < 32; o_ <<= 1) { const int t_ = __shfl_up(inc_, o_); if ((tid & 63) >= o_) inc_ += t_; } \
        const int st_ = inc_ - nt_; if (tid < NE) { TS[tid] = st_; for (int k = 0; k < nt_; ++k) TE[st_ + k] = (unsigned char)tid; } if (tid == NE - 1) { MISC[17] = (unsigned)inc_; TS[NE] = inc_; } } __syncthreads(); } while (0)
    if (IN(7)) {
        const int tid = fresh_tid(), lane = tid & 63;
        TILE_TABLE();
        const LAS int* TS = (const LAS int*)(lds + CTRL_OFF + LC_TSTART);
        for (int a = bx * NTHR + tid; a < NASSIGN; a += G * NTHR) { const int e = AE[a], row = TS[e] * 256 + APOS[a]; ROWTOK[row] = a >> 2; ROWGATE[row] = AGATE[a]; AROW[a] = row; }
        for (int e = bx; e < NE; e += G) { const int cnt = (int)__hip_atomic_load((unsigned*)(ctl + CW_ECNT) + e, __ATOMIC_RELAXED, __HIP_MEMORY_SCOPE_AGENT); const int r0 = TS[e] * 256 + cnt, r1 = (TS[e] + ((cnt + 255) >> 8)) * 256;
            for (int r = r0 + tid; r < r1; r += NTHR) { ROWTOK[r] = 0; ROWGATE[r] = 0.f; } }
    }
    SEAM(7);
    if (IN(8)) {
        const int tid = fresh_tid(), lane = tid & 63;
        TILE_TABLE();
        LAS int* rowtab = (LAS int*)(lds + 131072);
        pg8::Gemm g{HB, W1T, XROWS, 2048, D}; pg8::MoeOrder<true> S{(const PG8_LAS unsigned char*)(lds + CTRL_OFF + LC_TEXP), (const PG8_LAS int*)(lds + CTRL_OFF + LC_TSTART), (int)MISC[17], 8, G, bx, rowtab};
        { pg8::Unit u; for (int i = 0; i < 28 && S.next(i, u); ++i) if (tid < 256) rowtab[i * 256 + tid] = ROWTOK[u.pm * 256 + tid]; }
        __syncthreads();
        pg8::EpiSwiglu E{ACT, D, args.in[I_B1]};
        pg8::gemm_phase<pg8::EpiSwiglu, pg8::MoeOrder<true>, true, true>(lds + RING_OFF, g, S, E);
    }
    SEAM(8);
    if (IN(9)) {
        const int tid = fresh_tid(), lane = tid & 63;
        TILE_TABLE();
        pg8::Gemm g{ACT, W2T, XROWS, D, D}; pg8::MoeOrder<false> S{(const PG8_LAS unsigned char*)(lds + CTRL_OFF + LC_TEXP), (const PG8_LAS int*)(lds + CTRL_OFF + LC_TSTART), (int)MISC[17], 4, G, bx, nullptr};
        pg8::EpiGate E{EOUT, D, args.in[I_B2], ROWGATE};
        pg8::gemm_phase<pg8::EpiGate, pg8::MoeOrder<false>, true, true>(lds + RING_OFF, g, S, E);
    }
    SEAM(9);
    if (IN(10)) {
        const int tid = fresh_tid(), lane = tid & 63;
        for (int m0 = gw; m0 < M; m0 += 2 * NGW) {
            int rows[2][4];
#pragma unroll
            for (int u = 0; u < 2; ++u)
#pragma unroll
                for (int s = 0; s < 4; ++s) rows[u][s] = AROW[(m0 + u * NGW) * 4 + s];
            u32x2v hw[2][4], ew[2][4][4];
#pragma unroll
            for (int u = 0; u < 2; ++u) {
#pragma unroll
                for (int j = 0; j < 4; ++j) hw[u][j] = *(const u32x2v*)(HB + (size_t)(m0 + u * NGW) * D + 4 * lane + 256 * j);
#pragma unroll
                for (int s = 0; s < 4; ++s)
#pragma unroll
                    for (int j = 0; j < 4; ++j) ew[u][s][j] = *(const u32x2v*)(EOUT + (size_t)rows[u][s] * D + 4 * lane + 256 * j); }
#pragma unroll
            for (int u = 0; u < 2; ++u) { f32x4 v[4];
#pragma unroll
                for (int j = 0; j < 4; ++j) { const u32x2v w = hw[u][j];
                    v[j] = (f32x4){__uint_as_float(w.x << 16), __uint_as_float(w.x & 0xffff0000u), __uint_as_float(w.y << 16), __uint_as_float(w.y & 0xffff0000u)} * ALPHA; }
#pragma unroll
                for (int s = 0; s < 4; ++s)
#pragma unroll
                    for (int j = 0; j < 4; ++j) { const u32x2v w = ew[u][s][j];
                        v[j].x += __uint_as_float(w.x << 16); v[j].y += __uint_as_float(w.x & 0xffff0000u); v[j].z += __uint_as_float(w.y << 16); v[j].w += __uint_as_float(w.y & 0xffff0000u); }
                ln_finish(v, args.in[I_LN2W], args.in[I_LN2B], lane, args.out + (size_t)(m0 + u * NGW) * D, nullptr); }
        }
    }
#undef IN
#undef SEAM
#undef TILE_TABLE
}

#ifndef MK_ONE_LAUNCH
#define MK_ONE_LAUNCH 1
#endif
extern "C" void kernel_launch(void* const* d_in, const int* in_sizes, int n_in, void* d_out, int out_size, void* d_ws, size_t ws_size, hipStream_t stream) {
    static int grid = 0;
    if (grid == 0) {
        if (n_in != 29 || in_sizes[0] != M * D || out_size != M * D || ws_size < WS_END) { fprintf(stderr, "kernel_launch: unexpected shapes (n_in %d, in0 %d, out %d, ws %zu); nothing launched\n", n_in, n_in > 0 ? in_sizes[0] : -1, out_size, ws_size); grid = -1; return; }
        int dev = 0, cus = 0, per_cu = 0;
        if (hipGetDevice(&dev) != hipSuccess || hipDeviceGetAttribute(&cus, hipDeviceAttributeMultiprocessorCount, dev) != hipSuccess) { grid = -1; return; }
        if (hipFuncSetAttribute((const void*)fwd_kernel, hipFuncAttributeMaxDynamicSharedMemorySize, LDS_BYTES) != hipSuccess) { fprintf(stderr, "kernel_launch: hipFuncSetAttribute failed\n"); grid = -1; return; }
        if (hipOccupancyMaxActiveBlocksPerMultiprocessor(&per_cu, (const void*)fwd_kernel, NTHR, LDS_BYTES) != hipSuccess || per_cu < 1) fprintf(stderr, "kernel_launch: occupancy query reports %d\n", per_cu);
        (void)hipGetLastError();
        grid = cus;
        if (grid < 32) { grid = -1; return; }
    }
    if (grid < 0) return;
    if (hipMemsetAsync((char*)d_ws + WS_CTL, 0, CTL_ZERO_BYTES, stream) != hipSuccess) return;
    Args a{};
    for (int i = 0; i < 29; ++i) a.in[i] = (const float*)d_in[i];
    a.out = (float*)d_out; a.ws = (unsigned char*)d_ws;
#if MK_ONE_LAUNCH
    a.ph_lo = 0; a.ph_hi = N_PHASES;
    hipLaunchKernelGGL(fwd_kernel, dim3(grid), dim3(NTHR), LDS_BYTES, stream, a);
#else
    for (int p = 0; p < N_PHASES; ++p) {
#ifdef PROBE_REP
        if (p == PROBE_REP && (p == 5 || p == 6)) { a.ph_lo = (p == 5) ? 103 : 102; a.ph_hi = a.ph_lo + 1; hipLaunchKernelGGL(fwd_kernel, dim3(grid), dim3(NTHR), LDS_BYTES, stream, a); }
#endif
        a.ph_lo = p; a.ph_hi = p + 1; hipLaunchKernelGGL(fwd_kernel, dim3(grid), dim3(NTHR), LDS_BYTES, stream, a);
#ifdef PROBE_REP
        if (p == PROBE_REP && p != 5 && p != 6) { if (p == 3) { a.ph_lo = PROBE_P3; a.ph_hi = PROBE_P3 + 1; } hipLaunchKernelGGL(fwd_kernel, dim3(grid), dim3(NTHR), LDS_BYTES, stream, a); }
#endif
    }
#endif
}
```

```cpp
#include <hip/hip_runtime.h>
#include <hip/hip_bf16.h>
#include <cstdio>
#include <cstdint>
#include <cmath>

namespace pg8 {
#define PG8_LAS __attribute__((address_space(3)))
typedef unsigned short bf16_t;
typedef short bf16x8 __attribute__((ext_vector_type(8)));
typedef float f32x4 __attribute__((ext_vector_type(4)));
typedef unsigned u32x4 __attribute__((ext_vector_type(4)));
typedef unsigned u32x2 __attribute__((ext_vector_type(2)));
constexpr int BM = 256, BK = 64, HALF = 128, HTB = HALF * BK * 2  , STAGE_BYTES = 8 * HTB, NXCD = 8, WGM = 8;

__host__ __device__ __forceinline__ int lds_byte(int r, int c) { const int st = (r >> 4) * 2 + (c >> 5), rr = r & 15, cc = c & 31, ob = rr * 64 + cc * 2; return st * 1024 + (ob ^ (((ob >> 9) & 1) << 5)); }
__host__ __device__ __forceinline__ void stage_rc(int b, int& R, int& C) { const int st = b / 1024, sb = b % 1024, swz = sb ^ (((sb >> 9) & 1) << 5); R = (st >> 1) * 16 + swz / 64; C = (st & 1) * 32 + (swz % 64) / 2; }
__host__ __device__ __forceinline__ int perm32(int rho) { const int n = rho >> 4, i = rho & 15; return 8 * (i >> 2) + 4 * n + (i & 3); }

struct Unit { int pm, pn, pb, pe; };
struct Gemm { const bf16_t* A; const bf16_t* Bt; int M, N, K; };

struct StaticOrder {
    static constexpr bool GATHER = false, PREFETCH_B = false;
    __device__ __forceinline__ int arow(int, int) const { return 0; }
    int nM, nN, nwg, G, c;
    __host__ __device__ void init(int M, int N, int G_, int c_) { nM = M / BM; nN = N / BM; nwg = nM * nN; G = G_; c = c_; }
    __host__ __device__ bool next(int i, Unit& u) const {
        const long L = (long)i * G + c; if (L >= nwg) return false;
        int wgid = (int)L; { const int q = nwg / NXCD, r = nwg % NXCD, xcd = wgid % NXCD, off = wgid / NXCD; wgid = (xcd < r ? xcd * (q + 1) : r * (q + 1) + (xcd - r) * q) + off; }
        const int nig = WGM * nN, gid = wgid / nig, fm = gid * WGM, gsz = (nM - fm) < WGM ? (nM - fm) : WGM;
        u.pm = fm + ((wgid % nig) % gsz); u.pn = (wgid % nig) / gsz; u.pb = u.pn; u.pe = 0; return true;
    }
};
template <bool GATHER_> struct MoeOrder {
    static constexpr bool GATHER = GATHER_, PREFETCH_B = false;
    const PG8_LAS unsigned char* texp; const PG8_LAS int* ts; int ntiles, nN, G, c; const PG8_LAS int* rowtab;
    __device__ __forceinline__ int arow(int ui, int r) const { return rowtab[ui * 256 + r]; }
    __device__ __forceinline__ bool next(int i, Unit& u) const {
        int rt, pn;
        if ((G & 7) == 0) { const int x = c & 7, ng = G >> 3, t0 = (x * ntiles) >> 3, t1 = ((x + 1) * ntiles) >> 3; const int k = i * ng + (c >> 3); if (k >= (t1 - t0) * nN) return false; rt = t0 + k / nN; pn = k - (k / nN) * nN; }
        else { const int L = i * G + c; if (L >= ntiles * nN) return false; rt = L / nN; pn = L - rt * nN; }
        const int e = texp[rt];
        u.pm = rt; u.pn = pn; u.pb = e * nN + pn; u.pe = e; return true;
    }
};

typedef float f32x2c_ __attribute__((ext_vector_type(2))); typedef __bf16 bf16x2c_ __attribute__((ext_vector_type(2)));
__device__ __forceinline__ unsigned cvt_pk_bf16(float lo, float hi) { const f32x2c_ v = {lo, hi}; const bf16x2c_ b = __builtin_convertvector(v, bf16x2c_); return __builtin_bit_cast(unsigned, b); }

struct EpiF32 {
    static constexpr bool PERM = false;
    float* O; int ldc;
    __device__ __forceinline__ void operator()(const f32x4 (&acc)[2][2][4][2], const Unit& u, int wr, int wc, int fr, int fq) const {
        const int row0 = u.pm * BM + wr * 64 + fr, col0 = u.pn * BM + wc * 32 + 4 * fq;
#pragma unroll
        for (int ai = 0; ai < 2; ++ai)
#pragma unroll
            for (int m = 0; m < 4; ++m) { float* rowp = O + (size_t)(row0 + ai * HALF + m * 16) * ldc + col0;
#pragma unroll
                for (int bj = 0; bj < 2; ++bj)
#pragma unroll
                    for (int n = 0; n < 2; ++n) *(f32x4*)(rowp + bj * HALF + n * 16) = acc[ai][bj][m][n]; }
    }
};
struct EpiBf16 {
    static constexpr bool PERM = true;
    bf16_t* O; int ldc;
    __device__ __forceinline__ void operator()(const f32x4 (&acc)[2][2][4][2], const Unit& u, int wr, int wc, int fr, int fq) const {
        const int row0 = u.pm * BM + wr * 64 + fr, col0 = u.pn * BM + wc * 32 + 8 * fq;
#pragma unroll
        for (int ai = 0; ai < 2; ++ai)
#pragma unroll
            for (int m = 0; m < 4; ++m) { bf16_t* rowp = O + (size_t)(row0 + ai * HALF + m * 16) * ldc + col0;
#pragma unroll
                for (int bj = 0; bj < 2; ++bj) { const f32x4 v0 = acc[ai][bj][m][0], v1 = acc[ai][bj][m][1];
                    u32x4 w; w.x = cvt_pk_bf16(v0[0], v0[1]); w.y = cvt_pk_bf16(v0[2], v0[3]); w.z = cvt_pk_bf16(v1[0], v1[1]); w.w = cvt_pk_bf16(v1[2], v1[3]);
                    *(u32x4*)(rowp + bj * HALF) = w; } }
    }
};
struct EpiResid {
    static constexpr bool PERM = false;
    const bf16_t* I; float* O; int ldc; float alpha;
    __device__ __forceinline__ void operator()(const f32x4 (&acc)[2][2][4][2], const Unit& u, int wr, int wc, int fr, int fq) const {
        const int row0 = u.pm * BM + wr * 64 + fr, col0 = u.pn * BM + wc * 32 + 4 * fq;
#pragma unroll
        for (int ai = 0; ai < 2; ++ai)
#pragma unroll
            for (int m = 0; m < 4; ++m) { const size_t ro = (size_t)(row0 + ai * HALF + m * 16) * ldc + col0;
#pragma unroll
                for (int bj = 0; bj < 2; ++bj)
#pragma unroll
                    for (int n = 0; n < 2; ++n) { const u32x2 w = *(const u32x2*)(I + ro + bj * HALF + n * 16); const f32x4 o = {__uint_as_float(w.x << 16), __uint_as_float(w.x & 0xffff0000u), __uint_as_float(w.y << 16), __uint_as_float(w.y & 0xffff0000u)};
                        *(f32x4*)(O + ro + bj * HALF + n * 16) = o * alpha + acc[ai][bj][m][n]; } }
    }
};
__device__ __forceinline__ float swiglu1(float g, float l) {
    g = fminf(g, 7.0f); l = fminf(fmaxf(l, -7.0f), 7.0f);
    const float s = __builtin_amdgcn_rcpf(1.0f + __builtin_amdgcn_exp2f(-1.702f * 1.4426950408889634f * g));
    return g * s * (l + 1.0f);
}
struct EpiSwiglu {
    static constexpr bool PERM = true;
    bf16_t* O; int ldc; const float* b1;
    __device__ __forceinline__ void operator()(const f32x4 (&acc)[2][2][4][2], const Unit& u, int wr, int wc, int fr, int fq) const {
        const int row0 = u.pm * BM + wr * 64 + fr; const int cl0 = u.pn * BM + wc * 32 + 8 * fq;
        const float* bp = b1 + (size_t)u.pe * 2048 + cl0;
        f32x4 bv[2][2];
#pragma unroll
        for (int bj = 0; bj < 2; ++bj)
#pragma unroll
            for (int n = 0; n < 2; ++n) bv[bj][n] = *(const f32x4*)(bp + bj * HALF + 4 * n);
#pragma unroll
        for (int ai = 0; ai < 2; ++ai)
#pragma unroll
            for (int m = 0; m < 4; ++m) { bf16_t* rowp = O + (size_t)(row0 + ai * HALF + m * 16) * ldc + (cl0 >> 1);
#pragma unroll
                for (int bj = 0; bj < 2; ++bj) { const f32x4 v0 = acc[ai][bj][m][0] + bv[bj][0], v1 = acc[ai][bj][m][1] + bv[bj][1];
                    u32x2 w; w.x = cvt_pk_bf16(swiglu1(v0[0], v0[1]), swiglu1(v0[2], v0[3])); w.y = cvt_pk_bf16(swiglu1(v1[0], v1[1]), swiglu1(v1[2], v1[3]));
                    *(u32x2*)(rowp + bj * (HALF / 2)) = w; } }
    }
};
struct EpiGate {
    static constexpr bool PERM = true;
    bf16_t* O; int ldc; const float* b2; const float* gate;
    __device__ __forceinline__ void operator()(const f32x4 (&acc)[2][2][4][2], const Unit& u, int wr, int wc, int fr, int fq) const {
        const int row0 = u.pm * BM + wr * 64 + fr; const int col0 = u.pn * BM + wc * 32 + 8 * fq;
        const float* bp = b2 + (size_t)u.pe * 1024 + col0;
        f32x4 bv[2][2];
#pragma unroll
        for (int bj = 0; bj < 2; ++bj)
#pragma unroll
            for (int n = 0; n < 2; ++n) bv[bj][n] = *(const f32x4*)(bp + bj * HALF + 4 * n);
#pragma unroll
        for (int ai = 0; ai < 2; ++ai)
#pragma unroll
            for (int m = 0; m < 4; ++m) { const int row = row0 + ai * HALF + m * 16; const float gt = gate[row]; bf16_t* rowp = O + (size_t)row * ldc + col0;
#pragma unroll
                for (int bj = 0; bj < 2; ++bj) { const f32x4 v0 = (acc[ai][bj][m][0] + bv[bj][0]) * gt, v1 = (acc[ai][bj][m][1] + bv[bj][1]) * gt;
                    u32x4 w; w.x = cvt_pk_bf16(v0[0], v0[1]); w.y = cvt_pk_bf16(v0[2], v0[3]); w.z = cvt_pk_bf16(v1[0], v1[1]); w.w = cvt_pk_bf16(v1[2], v1[3]);
                    *(u32x4*)(rowp + bj * HALF) = w; } }
    }
};
struct NoSide { __device__ __forceinline__ void pre(const Unit&) {} __device__ __forceinline__ void post(const Unit&) {} };
template <class Epi, class Sched, bool ALIGN_EPI, bool SP2, class Side>
__device__ __forceinline__ void gemm_phase(PG8_LAS unsigned char* lds, const Gemm g, const Sched& S, const Epi& E, Side& side) {
    const int tid = threadIdx.x, wid = __builtin_amdgcn_readfirstlane(tid >> 6), lane = tid & 63, wr = wid >> 2, wc = wid & 3, fr = lane & 15, fq = lane >> 4;
    const int K = g.K, nt = K / BK;
    unsigned voffA[2], voffB[2]; int RA[2];
#pragma unroll
    for (int i = 0; i < 2; ++i) { int R, C; stage_rc(tid * 16 + i * 8192, R, C); const int Rb = Epi::PERM ? ((R & ~31) + perm32(R & 31)) : R; RA[i] = R;
        voffA[i] = (unsigned)(R * K + C) * 2u; voffB[i] = (unsigned)(Rb * K + C) * 2u; }
    unsigned vA[2][2], vAn[2][2];
#define PG8_AOFF(dst, UI) do { _Pragma("unroll") for (int h_ = 0; h_ < 2; ++h_) _Pragma("unroll") for (int i_ = 0; i_ < 2; ++i_) \
        dst[h_][i_] = Sched::GATHER ? ((unsigned)S.arow((UI), h_ * HALF + RA[i_]) * (unsigned)(K * 2) + (voffA[i_] - (unsigned)(RA[i_] * K) * 2u)) : (voffA[i_] + (unsigned)h_ * (unsigned)(HALF * K * 2)); } while (0)
    const size_t kstep = (size_t)(BK * 2);
    const size_t hstep = (size_t)HALF * K * 2;
    const size_t tstep = 2 * hstep;
    const unsigned ldsw = (unsigned)wid * 1024u;
    const int aoff = lds_byte(wr * 64 + fr, fq * 8), boff = lds_byte(wc * 32 + fr, fq * 8);
#define PG8_SA(b, h) (((b) * 2 + (h)) * HTB)
#define PG8_SB(b, h) ((4 + (b) * 2 + (h)) * HTB)
#define PG8_STAGE(bufoff, gbase, voff) do { _Pragma("unroll") for (int _i = 0; _i < 2; ++_i) \
        __builtin_amdgcn_global_load_lds((const unsigned*)((const char*)(gbase) + (voff)[_i]), (PG8_LAS unsigned*)(lds + (bufoff) + ldsw + _i * 8192), 16, 0, 0); } while (0)
#define PG8_LDA(dst, b, h) do { _Pragma("unroll") for (int m = 0; m < 4; ++m) _Pragma("unroll") for (int k = 0; k < 2; ++k) dst[m][k] = *(const PG8_LAS bf16x8*)(lds + PG8_SA(b, h) + aoff + m * 2048 + k * 1024); } while (0)
#define PG8_LDB(dst, b, h) do { _Pragma("unroll") for (int n = 0; n < 2; ++n) _Pragma("unroll") for (int k = 0; k < 2; ++k) dst[n][k] = *(const PG8_LAS bf16x8*)(lds + PG8_SB(b, h) + boff + n * 2048 + k * 1024); } while (0)
#define PG8_MMA(ai, bj, At, Bt) do { __builtin_amdgcn_s_setprio(1); _Pragma("unroll") for (int m = 0; m < 4; ++m) _Pragma("unroll") for (int n = 0; n < 2; ++n) _Pragma("unroll") for (int k = 0; k < 2; ++k) \
        acc[ai][bj][m][n] = __builtin_amdgcn_mfma_f32_16x16x32_bf16(Bt[n][k], At[m][k], acc[ai][bj][m][n], 0, 0, 0); __builtin_amdgcn_s_setprio(0); } while (0)
#define PG8_WAIT_V(n) asm volatile("s_waitcnt vmcnt(" #n ")" ::: "memory")
#define PG8_WAIT_L(n) asm volatile("s_waitcnt lgkmcnt(" #n ")" ::: "memory")
#define PG8_BAR __builtin_amdgcn_s_barrier()
#define PG8_SCHED __builtin_amdgcn_sched_barrier(0)
    Unit cur, nxt; int ui = 0; unsigned pfd = 0u;
    if (!S.next(0, cur)) return;
    f32x4 acc[2][2][4][2];
#pragma unroll
    for (int a = 0; a < 2; ++a)
#pragma unroll
        for (int b = 0; b < 2; ++b)
#pragma unroll
            for (int m = 0; m < 4; ++m)
#pragma unroll
                for (int n = 0; n < 2; ++n) acc[a][b][m][n] = (f32x4){0.f, 0.f, 0.f, 0.f};
    bf16x8 At[4][2], B0[2][2], B1[2][2];
    const char* cA = (const char*)g.A + (Sched::GATHER ? (size_t)0 : (size_t)cur.pm * tstep); const char* cB = (const char*)g.Bt + (size_t)cur.pb * tstep;
    PG8_AOFF(vA, 0);
    if constexpr (SP2) {
        PG8_STAGE(PG8_SB(0, 0), cB, voffB); PG8_STAGE(PG8_SB(0, 1), cB + hstep, voffB); PG8_STAGE(PG8_SA(0, 0), cA, vA[0]); PG8_STAGE(PG8_SA(0, 1), cA, vA[1]);
        if (wr == 1) PG8_BAR;
        PG8_WAIT_V(2); PG8_BAR;
        PG8_STAGE(PG8_SB(1, 0), cB + kstep, voffB); PG8_STAGE(PG8_SA(1, 0), cA + kstep, vA[0]); PG8_STAGE(PG8_SB(1, 1), cB + hstep + kstep, voffB);
        PG8_WAIT_V(6); PG8_BAR;
    } else {
        PG8_STAGE(PG8_SB(0, 0), cB, voffB); PG8_STAGE(PG8_SA(0, 0), cA, vA[0]); PG8_STAGE(PG8_SB(0, 1), cB + hstep, voffB); PG8_STAGE(PG8_SA(0, 1), cA, vA[1]);
        if (wr == 1) PG8_BAR;
        PG8_WAIT_V(4); PG8_BAR;
        PG8_STAGE(PG8_SB(1, 0), cB + kstep, voffB); PG8_STAGE(PG8_SA(1, 0), cA + kstep, vA[0]); PG8_STAGE(PG8_SB(1, 1), cB + hstep + kstep, voffB);
        PG8_WAIT_V(6); PG8_BAR;
    }
    for (;;) {
        const bool has_next = S.next(ui + 1, nxt);
        if (has_next) PG8_AOFF(vAn, ui + 1); else { vAn[0][0] = vA[0][0]; vAn[0][1] = vA[0][1]; vAn[1][0] = vA[1][0]; vAn[1][1] = vA[1][1]; }
        const char* nA = has_next ? (const char*)g.A + (Sched::GATHER ? (size_t)0 : (size_t)nxt.pm * tstep) : cA;
        if constexpr (Sched::PREFETCH_B) {
            if (has_next && nxt.pb != cur.pb) { const char* pfb = (const char*)g.Bt + (size_t)nxt.pb * tstep + (size_t)tid * 128;
#pragma unroll
                for (int j_ = 0; j_ < 8; ++j_) asm volatile("global_load_dword %0, %1, off" : "+v"(pfd) : "v"(pfb + (size_t)j_ * 65536) : "memory"); } } const char* nB = has_next ? (const char*)g.Bt + (size_t)nxt.pb * tstep : cB;
        for (int t = 0; t < nt; t += 2) {
            const bool last = (t == nt - 2);
            const char* a1 = cA + (size_t)(t + 1) * kstep;
            const char* a2 = last ? nA : cA + (size_t)(t + 2) * kstep; const char* b2 = last ? nB : cB + (size_t)(t + 2) * kstep;
            const char* a3 = a2 + kstep; const char* b3 = b2 + kstep;
            unsigned vS[2][2]; vS[0][0] = last ? vAn[0][0] : vA[0][0]; vS[0][1] = last ? vAn[0][1] : vA[0][1]; vS[1][0] = last ? vAn[1][0] : vA[1][0]; vS[1][1] = last ? vAn[1][1] : vA[1][1];

            if constexpr (SP2) {
            PG8_LDB(B0, 0, 0); PG8_LDB(B1, 0, 1); PG8_SCHED; PG8_LDA(At, 0, 0); PG8_STAGE(PG8_SA(1, 1), a1, vA[1]);
            PG8_WAIT_V(8); PG8_WAIT_L(0); PG8_BAR; PG8_MMA(0, 0, At, B0); PG8_MMA(0, 1, At, B1); PG8_BAR; PG8_SCHED;
            PG8_LDA(At, 0, 1); PG8_STAGE(PG8_SB(0, 0), b2, voffB); PG8_STAGE(PG8_SB(0, 1), b2 + hstep, voffB); PG8_STAGE(PG8_SA(0, 0), a2, vS[0]);
            PG8_WAIT_V(8); PG8_WAIT_L(0); PG8_BAR; PG8_MMA(1, 0, At, B0); PG8_MMA(1, 1, At, B1); PG8_BAR; PG8_SCHED;
            PG8_LDB(B0, 1, 0); PG8_LDB(B1, 1, 1); PG8_SCHED; PG8_LDA(At, 1, 0); PG8_STAGE(PG8_SA(0, 1), a2, vS[1]);
            PG8_WAIT_V(8); PG8_WAIT_L(0); PG8_BAR; PG8_MMA(0, 0, At, B0); PG8_MMA(0, 1, At, B1); PG8_BAR; PG8_SCHED;
            PG8_LDA(At, 1, 1); PG8_STAGE(PG8_SB(1, 0), b3, voffB); PG8_STAGE(PG8_SB(1, 1), b3 + hstep, voffB); PG8_STAGE(PG8_SA(1, 0), a3, vS[0]);
            PG8_WAIT_V(8); PG8_WAIT_L(0); PG8_BAR; PG8_MMA(1, 0, At, B0); PG8_MMA(1, 1, At, B1); PG8_BAR; PG8_SCHED;
            } else {
            PG8_LDB(B0, 0, 0); PG8_SCHED; PG8_LDA(At, 0, 0); PG8_STAGE(PG8_SA(1, 1), a1, vA[1]);
            PG8_WAIT_L(8); PG8_BAR; PG8_WAIT_L(0); PG8_MMA(0, 0, At, B0); PG8_BAR; PG8_SCHED;
            PG8_LDB(B1, 0, 1); PG8_STAGE(PG8_SB(0, 0), b2, voffB);
            PG8_BAR; PG8_WAIT_L(0); PG8_MMA(0, 1, At, B1); PG8_BAR;
            PG8_LDA(At, 0, 1); PG8_STAGE(PG8_SA(0, 0), a2, vS[0]);
            PG8_BAR; PG8_WAIT_L(0); PG8_MMA(1, 0, At, B0); PG8_BAR; PG8_SCHED;
            PG8_STAGE(PG8_SB(0, 1), b2 + hstep, voffB);
            PG8_WAIT_V(6); PG8_BAR; PG8_MMA(1, 1, At, B1); PG8_BAR;
            PG8_LDB(B0, 1, 0); PG8_SCHED; PG8_LDA(At, 1, 0); PG8_STAGE(PG8_SA(0, 1), a2, vS[1]);
            PG8_WAIT_L(8); PG8_BAR; PG8_WAIT_L(0); PG8_MMA(0, 0, At, B0); PG8_BAR; PG8_SCHED;
            PG8_LDB(B1, 1, 1); PG8_STAGE(PG8_SB(1, 0), b3, voffB);
            PG8_BAR; PG8_WAIT_L(0); PG8_MMA(0, 1, At, B1); PG8_BAR;
            PG8_LDA(At, 1, 1); PG8_STAGE(PG8_SA(1, 0), a3, vS[0]);
            PG8_BAR; PG8_WAIT_L(0); PG8_MMA(1, 0, At, B0); PG8_BAR; PG8_SCHED;
            PG8_STAGE(PG8_SB(1, 1), b3 + hstep, voffB);
            PG8_WAIT_V(6); PG8_BAR; PG8_MMA(1, 1, At, B1); PG8_BAR;
            }
        }
        if constexpr (ALIGN_EPI) { if (wr == 0) PG8_BAR; }
        side.pre(cur); E(acc, cur, wr, wc, fr, fq); side.post(cur);
        if constexpr (Sched::PREFETCH_B) asm volatile("" : "+v"(pfd));
        if (!has_next) break;
#pragma unroll
        for (int a = 0; a < 2; ++a)
#pragma unroll
            for (int b = 0; b < 2; ++b)
#pragma unroll
                for (int m = 0; m < 4; ++m)
#pragma unroll
                    for (int n = 0; n < 2; ++n) acc[a][b][m][n] = (f32x4){0.f, 0.f, 0.f, 0.f};
        cur = nxt; cA = nA; cB = nB; ++ui; vA[0][0] = vAn[0][0]; vA[0][1] = vAn[0][1]; vA[1][0] = vAn[1][0]; vA[1][1] = vAn[1][1];
        if constexpr (ALIGN_EPI) { if (wr == 1) PG8_BAR; }
    }
    PG8_WAIT_V(0);
    if constexpr (!ALIGN_EPI) { if (wr == 0) PG8_BAR; }
    PG8_BAR;
#undef PG8_SA
#undef PG8_SB
#undef PG8_STAGE
#undef PG8_AOFF
#undef PG8_LDA
#undef PG8_LDB
#undef PG8_MMA
#undef PG8_WAIT_V
#undef PG8_WAIT_L
#undef PG8_BAR
#undef PG8_SCHED
}
template <class Epi, class Sched, bool ALIGN_EPI = false, bool SP2 = false>
__device__ __forceinline__ void gemm_phase(PG8_LAS unsigned char* lds, const Gemm g, const Sched& S, const Epi& E) { NoSide ns; gemm_phase<Epi, Sched, ALIGN_EPI, SP2, NoSide>(lds, g, S, E, ns); }
}
namespace attn_body {
using bf16=__hip_bfloat16;
using bf16x8=__attribute__((ext_vector_type(8)))short;
using s16x4=__attribute__((ext_vector_type(4)))short;
using f32x16=__attribute__((ext_vector_type(16)))float;
using u32x4=__attribute__((ext_vector_type(4)))unsigned;
using f32x4=__attribute__((ext_vector_type(4)))float;
constexpr int BATCH=4,NHEAD=8,SEQ=4096,D=64,DM=NHEAD*D;
constexpr int OPITCH=1024;
constexpr int PROJ_PITCH=3840, OG_COL=3232;
constexpr int NW=8,QBLK=32,QB=QBLK*NW,KVBLK=64,NQB=SEQ/QB;
constexpr int ATTN_PITCH=DM, ATTN_UNIT_ROWS=QB;
__device__ __forceinline__ int crow(int r,int hi){return (r&3)+8*(r>>2)+4*hi;}
#define SBAR() __builtin_amdgcn_sched_barrier(0)
__device__ __forceinline__ void cmask(f32x16&p0,f32x16&p1,int jb,int qrel,int hi){
  const float NEG=-INFINITY; int kb=64*jb+4*hi;
  #pragma unroll
  for(int r=0;r<16;++r){int kv=kb+(r&3)+8*(r>>2); if(kv>qrel)p0[r]=NEG; if(kv+32>qrel)p1[r]=NEG;}
}

constexpr int NSLOT=3, SLOTB=8192;
constexpr int LDS_K=0, LDS_V=NSLOT*SLOTB, LDS_WS=2*NSLOT*SLOTB, LDS_OST=LDS_WS+NW*64*4, LDS_BIAS=LDS_OST+NW*4096, LDS_SCAN=LDS_BIAS+SEQ*4, LDS_BYTES=LDS_SCAN+64;
constexpr float C2=0.125f*1.4426950408889634f;
__device__ __forceinline__ void glds16(const void*gsrc,unsigned lds_dst){unsigned keep;
  asm volatile("s_mov_b32 %0, m0\n\ts_mov_b32 m0, %2\n\ts_nop 0\n\tglobal_load_lds_dwordx4 %1, off\n\ts_mov_b32 m0, %0":"=&s"(keep):"v"(gsrc),"s"(lds_dst):"memory");}
__device__ __forceinline__ float max3f(float a,float b,float c){float r;asm("v_max3_f32 %0, %1, %2, %3":"=v"(r):"v"(a),"v"(b),"v"(c));return r;}
__device__ __forceinline__ float max2f(float a,float b){float r;asm("v_max_f32_e32 %0, %1, %2":"=v"(r):"v"(a),"v"(b));return r;}
__device__ __forceinline__ float fadd_s(float a,float b){float r;asm("v_add_f32_e32 %0, %1, %2":"=v"(r):"v"(a),"v"(b));return r;}
__device__ __forceinline__ float fsub_s(float a,float b){float r;asm("v_sub_f32_e32 %0, %1, %2":"=v"(r):"v"(a),"v"(b));return r;}
typedef float f32x2_t __attribute__((ext_vector_type(2))); typedef __bf16 bf16x2_t __attribute__((ext_vector_type(2)));
__device__ __forceinline__ unsigned cvtpk_s(float lo,float hi){f32x2_t v={lo,hi};bf16x2_t b=__builtin_convertvector(v,bf16x2_t);return __builtin_bit_cast(unsigned,b);}
#define WAIT_BAR(N) asm volatile("s_waitcnt vmcnt(" #N ") lgkmcnt(0)\n\ts_barrier":::"memory")

__device__ __forceinline__ void qkt(f32x16&p0,f32x16&p1,const char*Kslot,const bf16x8*qr,const f32x16&c0i,const f32x16&c1i,int r32,int hi){
  const char*kb=Kslot+hi*1024+r32*16;
  #pragma unroll
  for(int d0=0;d0<4;++d0){
    const bf16x8 b0=*reinterpret_cast<const bf16x8*>(kb+d0*2048);
    const bf16x8 b1=*reinterpret_cast<const bf16x8*>(kb+d0*2048+512);
    if(d0==0){p0=__builtin_amdgcn_mfma_f32_32x32x16_bf16(b0,qr[0],c0i,0,0,0);p1=__builtin_amdgcn_mfma_f32_32x32x16_bf16(b1,qr[0],c1i,0,0,0);}
    else{p0=__builtin_amdgcn_mfma_f32_32x32x16_bf16(b0,qr[d0],p0,0,0,0);p1=__builtin_amdgcn_mfma_f32_32x32x16_bf16(b1,qr[d0],p1,0,0,0);}}
}
typedef __attribute__((address_space(3))) const char* lds_cptr;
typedef short v4i16_t __attribute__((ext_vector_type(4)));
__device__ __forceinline__ void kload8(bf16x8*kf,lds_cptr kp){
  kf[0]=*(const __attribute__((address_space(3))) bf16x8*)(kp);      kf[1]=*(const __attribute__((address_space(3))) bf16x8*)(kp+512);
  kf[2]=*(const __attribute__((address_space(3))) bf16x8*)(kp+2048); kf[3]=*(const __attribute__((address_space(3))) bf16x8*)(kp+2560);
  kf[4]=*(const __attribute__((address_space(3))) bf16x8*)(kp+4096); kf[5]=*(const __attribute__((address_space(3))) bf16x8*)(kp+4608);
  kf[6]=*(const __attribute__((address_space(3))) bf16x8*)(kp+6144); kf[7]=*(const __attribute__((address_space(3))) bf16x8*)(kp+6656);
}
__device__ __forceinline__ void kload2(bf16x8*kf,lds_cptr kp,int j){ kf[2*j]=*(const __attribute__((address_space(3))) bf16x8*)(kp+j*2048); kf[2*j+1]=*(const __attribute__((address_space(3))) bf16x8*)(kp+j*2048+512); }
__device__ __forceinline__ s16x4 vtr(lds_cptr p){ return __builtin_bit_cast(s16x4,__builtin_amdgcn_ds_read_tr16_b64_v4i16((__attribute__((address_space(3))) v4i16_t*)p)); }
__device__ __forceinline__ float rowmax(const f32x16&p0,const f32x16&p1){
  float a=max3f(p0[0],p0[1],p1[0]),b=max3f(p0[2],p0[3],p1[1]);a=max3f(a,p1[2],p1[3]);
  #pragma unroll
  for(int r=4;r<16;r+=4){a=max3f(a,p0[r],p0[r+1]);b=max3f(b,p0[r+2],p0[r+3]);a=max3f(a,p1[r],p1[r+1]);b=max3f(b,p1[r+2],p1[r+3]);}
  const float m=max2f(a,b);
  auto rr=__builtin_amdgcn_permlane32_swap(__float_as_uint(m),__float_as_uint(m),false,false);
  return max2f(__uint_as_float(rr[0]),__uint_as_float(rr[1]));
}
__device__ __forceinline__ void pv(f32x16*o,int vb,bf16x8 pa0,bf16x8 pa1,bf16x8 pa2,bf16x8 pa3){
  #pragma unroll
  for(int d0=0;d0<2;++d0){s16x4 lo[4],hi[4];
    #pragma unroll
    for(int ks=0;ks<4;++ks){
      asm volatile("ds_read_b64_tr_b16 %0,%1 offset:%c2":"=&v"(lo[ks]):"v"(vb),"i"(d0*4096+ks*1024):"memory");
      asm volatile("ds_read_b64_tr_b16 %0,%1 offset:%c2":"=&v"(hi[ks]):"v"(vb),"i"(d0*4096+ks*1024+512):"memory");}
    asm volatile("s_waitcnt lgkmcnt(0)":::"memory");SBAR();
    #define PK(k) (bf16x8){lo[k][0],lo[k][1],lo[k][2],lo[k][3],hi[k][0],hi[k][1],hi[k][2],hi[k][3]}
    o[d0]=__builtin_amdgcn_mfma_f32_32x32x16_bf16(pa0,PK(0),o[d0],0,0,0);
    o[d0]=__builtin_amdgcn_mfma_f32_32x32x16_bf16(pa1,PK(1),o[d0],0,0,0);
    o[d0]=__builtin_amdgcn_mfma_f32_32x32x16_bf16(pa2,PK(2),o[d0],0,0,0);
    o[d0]=__builtin_amdgcn_mfma_f32_32x32x16_bf16(pa3,PK(3),o[d0],0,0,0);
    #undef PK
  }
}

#ifndef ATTN_STORE16
#define ATTN_STORE16(p,v) (*(u32x4*)(p)=(v))
#endif
template<int THRL> __device__ __forceinline__ void attn_unit(int b,int h,int qb,const bf16*Q,const bf16*__restrict__ K,const bf16*__restrict__ V,bf16*O,const float*__restrict__ logf,const unsigned short*__restrict__ proj,char*shm){
  const int tid=threadIdx.x,lane=tid&63,r32=lane&31,hi=lane>>5; const int wid=__builtin_amdgcn_readfirstlane(tid>>6);
  const long rowbase=(long)b*SEQ; const int q0=qb*QB;
  { float*biasL=(float*)(shm+LDS_BIAS); float*scanL=(float*)(shm+LDS_SCAN);
    const int nk=q0+QB,i0=tid*8; const float*lf=logf+((long)(b*NHEAD+h))*SEQ;
    float v8[8]; float run=0.f;
    if(i0<nk){ const f32x4 a_=*(const f32x4*)(lf+i0),c_=*(const f32x4*)(lf+i0+4);
      v8[0]=a_[0];v8[1]=v8[0]+a_[1];v8[2]=v8[1]+a_[2];v8[3]=v8[2]+a_[3];v8[4]=v8[3]+c_[0];v8[5]=v8[4]+c_[1];v8[6]=v8[5]+c_[2];v8[7]=v8[6]+c_[3];run=v8[7]; }
    else{ _Pragma("unroll") for(int i=0;i<8;++i)v8[i]=0.f; }
    float inc=run;
    _Pragma("unroll") for(int o_=1;o_<64;o_<<=1){ const float t_=__shfl_up(inc,o_); if(lane>=o_)inc+=t_; }
    if(lane==63)scanL[wid]=inc;
    __syncthreads();
    float base=inc-run; for(int w_=0;w_<wid;++w_)base+=scanL[w_];
    if(i0<nk){ const float L2E=-1.4426950408889634f;
      *(f32x4*)(biasL+i0)=(f32x4){(base+v8[0])*L2E,(base+v8[1])*L2E,(base+v8[2])*L2E,(base+v8[3])*L2E};
      *(f32x4*)(biasL+i0+4)=(f32x4){(base+v8[4])*L2E,(base+v8[5])*L2E,(base+v8[6])*L2E,(base+v8[7])*L2E}; }
    __syncthreads(); }
  int tskip;
  { const float*biasL=(const float*)(shm+LDS_BIAS); const int NT0=(q0+QB)/KVBLK; const float bq=biasL[q0];
    const bool need=(lane<NT0)?(bq-biasL[64*lane+63]<=80.f):true;
    const unsigned long long mk=__ballot(need); int first=mk?(__ffsll((long long)mk)-1):0;
    first&=~1; if(first>NT0-4)first=NT0-4; if(first<0)first=0; tskip=__builtin_amdgcn_readfirstlane(first); }
  const bf16*Qw=Q+(rowbase+q0+wid*QBLK)*DM+h*D;
  const bf16*Kh=K+(rowbase+(long)tskip*KVBLK)*DM+h*D,*Vh=V+(rowbase+(long)tskip*KVBLK)*DM+h*D;
  const unsigned lds0=(unsigned)(uintptr_t)shm;
  float*wsf=(float*)(shm+LDS_WS)+wid*64;
  const bf16*ksrc=Kh+(long)lane*DM+wid*8;
  const bf16*vsrc=Vh+(long)(16*(wid&3)+(lane>>2))*DM+(wid>>2)*32+(lane&3)*8;
  const unsigned kdst=lds0+LDS_K+wid*1024, vdst=lds0+LDS_V+wid*1024;
  #define DMA_K(t,slot) glds16(ksrc+(long)(t)*KVBLK*DM,(unsigned)__builtin_amdgcn_readfirstlane(kdst+(slot)))
  #define DMA_V(t,slot) glds16(vsrc+(long)(t)*KVBLK*DM,(unsigned)__builtin_amdgcn_readfirstlane(vdst+(slot)))
  const int vb0=(int)(lds0+LDS_V)+((lane>>4)&1)*32+(lane&3)*8+(4*hi+((lane&15)>>2))*64;
  const char*Kbase=shm+LDS_K; bf16x8 kf[8];
  const lds_cptr shm3=(lds_cptr)shm; const lds_cptr kp0=shm3+LDS_K+hi*1024+r32*16; const lds_cptr vp0=shm3+LDS_V+((lane>>4)&1)*32+(lane&3)*8+(4*hi+((lane&15)>>2))*64;
  const int NT=(q0+QB)/KVBLK-tskip;
  #define BIASC(C0,C1,t,ng) do{ const __attribute__((address_space(3))) f32x4*bq_=(const __attribute__((address_space(3))) f32x4*)(shm3+LDS_BIAS+((t)+tskip)*256+hi*16); \
    _Pragma("unroll") for(int g_=0;g_<4;++g_){ const f32x4 x0_=bq_[2*g_],x1_=bq_[8+2*g_]; \
      _Pragma("unroll") for(int i_=0;i_<4;++i_){ C0[4*g_+i_]=x0_[i_]+(ng); C1[4*g_+i_]=x1_[i_]+(ng); } } }while(0)
  DMA_K(0,0);DMA_V(0,0);DMA_K(1,SLOTB);
  bf16x8 qr[4];
  #pragma unroll
  for(int d0=0;d0<4;++d0)qr[d0]=*reinterpret_cast<const bf16x8*>(&Qw[(long)r32*DM+d0*16+hi*8]);
  float mhat=0.f,l_reg=0.f;f32x16 o[2];o[0]=f32x16{};o[1]=f32x16{};float negm_s=0.f;
  const int qrel=wid*QBLK+r32;
  #define CMASK(P0,P1,t) do{int jb_=(t)-(NT-4); if(jb_>=0)cmask(P0,P1,jb_,qrel,hi);}while(0)
  bool resc=false;
  #define START(P0,P1) do{ const float rm=rowmax(P0,P1); resc=false; \
    { const float dl=rm; mhat=fadd_s(mhat,dl); \
      _Pragma("unroll") for(int r=0;r<16;++r){P0[r]=fsub_s(P0[r],dl);P1[r]=fsub_s(P1[r],dl);} \
      negm_s=-mhat; } \
    _Pragma("unroll") for(int r=0;r<16;++r)P0[r]=__builtin_amdgcn_exp2f(P0[r]); }while(0)
  #define RESC() do{ if(resc){ asm volatile("s_waitcnt lgkmcnt(0)":::"memory"); \
      _Pragma("unroll") for(int d_=0;d_<2;++d_) _Pragma("unroll") for(int r=0;r<16;++r)o[d_][r]*=wsf[crow(r,hi)]; } }while(0)
  f32x16 pA0,pA1,pB0,pB1;
  int sl_prev=0,sl_cur=0,sl_next=SLOTB;
  #define ROT() do{sl_prev=sl_cur;sl_cur=sl_next;sl_next=(sl_next==(NSLOT-1)*SLOTB)?0:sl_next+SLOTB;}while(0)
  DMA_K(2,2*SLOTB);
  WAIT_BAR(3);
  { f32x16 c0i_,c1i_; BIASC(c0i_,c1i_,0,0.f); qkt(pA0,pA1,Kbase,qr,c0i_,c1i_,r32,hi); }asm volatile("s_nop 15\n\ts_nop 7":"+v"(pA0),"+v"(pA1));CMASK(pA0,pA1,0);
  START(pA0,pA1);
  _Pragma("unroll") for(int r=0;r<16;++r)pA1[r]=__builtin_amdgcn_exp2f(pA1[r]);
  WAIT_BAR(0);
  DMA_K(3,0);DMA_V(1,SLOTB);
  ROT();
  kload8(kf,kp0+sl_cur);
  WAIT_BAR(2);
  s16x4 vlo[8],vhi[8]; u32x4 pw0,pw1,pw2,pw3;
  #define PKW(P,B) cvtpk_s(P[B],P[B+1])
  #define PAF(k) __builtin_bit_cast(bf16x8,pw##k)
  #define VFR(i) (bf16x8){vlo[i][0],vlo[i][1],vlo[i][2],vlo[i][3],vhi[i][0],vhi[i][1],vhi[i][2],vhi[i][3]}
  #define PIN(x) asm volatile("":"+v"(x))
  #define MX3(a,b,c) __builtin_fmaxf(__builtin_fmaxf((a),(b)),(c))
  #define GAPA(MF,A0,A1,A2,A3,W0,W1,PW) do{ MF; sacc+=A0; sacc+=A1; sacc+=A2; sacc+=A3; PIN(sacc); W0; W1; PIN(PW); SBAR(); }while(0)
  #define EX(v) __builtin_amdgcn_exp2f(v)
  #define GAPB(MF,X,B) do{ MF; X[B]=EX(X[B]); X[B+1]=EX(X[B+1]); X[B+2]=EX(X[B+2]); X[B+3]=EX(X[B+3]); PIN(X); SBAR(); }while(0)
  #define VRD(i) do{ vlo[i]=vtr(vp_+(((i)>>2)*4096+((i)&3)*1024)); vhi[i]=vtr(vp_+(((i)>>2)*4096+((i)&3)*1024+512)); }while(0)
  #define KRD(G,j) do{ if(G){ kload2(kf,kp0+sl_next,j); SBAR(); } }while(0)
  #define STEP(C0,C1,P0,P1,t,GK,GV,GL) do{ SBAR(); BIASC(C0,C1,t,negm_s); SBAR(); \
    const lds_cptr vp_=vp0+sl_prev; \
    VRD(0); SBAR(); float sacc=(P0[0]+P0[1]); \
    GAPA(C0=__builtin_amdgcn_mfma_f32_32x32x16_bf16(kf[0],qr[0],C0,0,0,0), P0[2],P0[3],P0[4],P0[5],     pw0[0]=PKW(P0,0), pw0[1]=PKW(P0,2), pw0); \
    VRD(4); SBAR(); GAPA(C1=__builtin_amdgcn_mfma_f32_32x32x16_bf16(kf[1],qr[0],C1,0,0,0), P0[6],P0[7],P0[8],P0[9],     pw0[2]=PKW(P0,4), pw0[3]=PKW(P0,6), pw0); \
    VRD(1); SBAR(); GAPA(C0=__builtin_amdgcn_mfma_f32_32x32x16_bf16(kf[2],qr[1],C0,0,0,0),   P0[10],P0[11],P0[12],P0[13], pw1[0]=PKW(P0,8), pw1[1]=PKW(P0,10), pw1); \
    VRD(5); SBAR(); GAPA(C1=__builtin_amdgcn_mfma_f32_32x32x16_bf16(kf[3],qr[1],C1,0,0,0),   P0[14],P0[15],P1[0],P1[1],   pw1[2]=PKW(P0,12),pw1[3]=PKW(P0,14), pw1); \
    VRD(2); SBAR(); GAPA(C0=__builtin_amdgcn_mfma_f32_32x32x16_bf16(kf[4],qr[2],C0,0,0,0),   P1[2],P1[3],P1[4],P1[5],     pw2[0]=PKW(P1,0), pw2[1]=PKW(P1,2), pw2); \
    VRD(6); SBAR(); GAPA(C1=__builtin_amdgcn_mfma_f32_32x32x16_bf16(kf[5],qr[2],C1,0,0,0),   P1[6],P1[7],P1[8],P1[9],     pw2[2]=PKW(P1,4), pw2[3]=PKW(P1,6), pw2); \
    VRD(3); SBAR(); GAPA(C0=__builtin_amdgcn_mfma_f32_32x32x16_bf16(kf[6],qr[3],C0,0,0,0),   P1[10],P1[11],P1[12],P1[13], pw3[0]=PKW(P1,8), pw3[1]=PKW(P1,10), pw3); \
    VRD(7); SBAR(); GAPA(C1=__builtin_amdgcn_mfma_f32_32x32x16_bf16(kf[7],qr[3],C1,0,0,0),   P1[14],P1[15],0.f,0.f,       pw3[2]=PKW(P1,12),pw3[3]=PKW(P1,14), pw3); \
    l_reg+=sacc; \
    if(GK){DMA_K((t)+3,sl_cur);} if(GV){DMA_V((t)+1,sl_next);} \
    CMASK(C0,C1,t); \
    { float a=MX3(C0[0],C0[1],C1[0]),b=MX3(C0[2],C0[3],C1[1]); a=MX3(a,C1[2],C1[3]); \
      _Pragma("unroll") for(int r=4;r<16;r+=4){a=MX3(a,C0[r],C0[r+1]);b=MX3(b,C0[r+2],C0[r+3]);a=MX3(a,C1[r],C1[r+1]);b=MX3(b,C1[r+2],C1[r+3]);} \
      float rm=__builtin_fmaxf(a,b); { auto rr=__builtin_amdgcn_permlane32_swap(__float_as_uint(rm),__float_as_uint(rm),false,false); rm=__builtin_fmaxf(__uint_as_float(rr[0]),__uint_as_float(rr[1])); } \
      resc=false; \
      if(__builtin_expect(__any(rm>(float)THRL),0)){ const float dl=__builtin_fmaxf(rm,0.f); mhat+=dl; \
        _Pragma("unroll") for(int r=0;r<16;++r){C0[r]-=dl;C1[r]-=dl;} \
        negm_s=-mhat; \
        const float f=__builtin_amdgcn_exp2f(-dl); l_reg*=f; if(hi==0)wsf[r32]=f; resc=true; } } \
    SBAR(); \
    GAPB(o[0]=__builtin_amdgcn_mfma_f32_32x32x16_bf16(PAF(0),VFR(0),o[0],0,0,0), C0,0); \
    GAPB(o[1]=__builtin_amdgcn_mfma_f32_32x32x16_bf16(PAF(0),VFR(4),o[1],0,0,0), C0,4); \
    KRD(GL,0); GAPB(o[0]=__builtin_amdgcn_mfma_f32_32x32x16_bf16(PAF(1),VFR(1),o[0],0,0,0), C0,8); \
    KRD(GL,1); GAPB(o[1]=__builtin_amdgcn_mfma_f32_32x32x16_bf16(PAF(1),VFR(5),o[1],0,0,0), C0,12); \
    KRD(GL,2); GAPB(o[0]=__builtin_amdgcn_mfma_f32_32x32x16_bf16(PAF(2),VFR(2),o[0],0,0,0), C1,0); \
    KRD(GL,3); GAPB(o[1]=__builtin_amdgcn_mfma_f32_32x32x16_bf16(PAF(2),VFR(6),o[1],0,0,0), C1,4); \
    GAPB(o[0]=__builtin_amdgcn_mfma_f32_32x32x16_bf16(PAF(3),VFR(3),o[0],0,0,0), C1,8); \
    GAPB(o[1]=__builtin_amdgcn_mfma_f32_32x32x16_bf16(PAF(3),VFR(7),o[1],0,0,0), C1,12); \
    }while(0)
  int t=1;
  #undef CMASK
  #define CMASK(P0,P1,t) do{}while(0)
  for(;t+5<NT;t+=2){
    STEP(pB0,pB1,pA0,pA1,t,true,true,true);     WAIT_BAR(2); RESC(); ROT();
    STEP(pA0,pA1,pB0,pB1,t+1,true,true,true);   WAIT_BAR(2); RESC(); ROT();
  }
  #undef CMASK
  #define CMASK(P0,P1,t) do{int jb_=(t)-(NT-4); if(jb_>=0)cmask(P0,P1,jb_,qrel,hi);}while(0)
  #define ENDW(tt) do{ if((tt)+3<NT){WAIT_BAR(2);} else if((tt)+2<NT){WAIT_BAR(1);} else {WAIT_BAR(0);} }while(0)
  for(;t+1<NT;t+=2){
    STEP(pB0,pB1,pA0,pA1,t,(t+3<NT),(t+1<NT),(t+1<NT));       ENDW(t);   RESC(); ROT();
    STEP(pA0,pA1,pB0,pB1,t+1,(t+4<NT),(t+2<NT),(t+2<NT));     ENDW(t+1); RESC(); ROT();
  }
  STEP(pB0,pB1,pA0,pA1,NT-1,false,false,false); RESC();
  { float sacc=pB0[0]+pB0[1]; _Pragma("unroll") for(int r=2;r<16;++r)sacc+=pB0[r]; _Pragma("unroll") for(int r=0;r<16;++r)sacc+=pB1[r]; l_reg+=sacc;
    pw0=(u32x4){PKW(pB0,0),PKW(pB0,2),PKW(pB0,4),PKW(pB0,6)};pw1=(u32x4){PKW(pB0,8),PKW(pB0,10),PKW(pB0,12),PKW(pB0,14)};pw2=(u32x4){PKW(pB1,0),PKW(pB1,2),PKW(pB1,4),PKW(pB1,6)};pw3=(u32x4){PKW(pB1,8),PKW(pB1,10),PKW(pB1,12),PKW(pB1,14)};
    SBAR(); pv(o,vb0+sl_cur,PAF(0),PAF(1),PAF(2),PAF(3)); }
  #undef PKW
  #undef PAF
  #undef VFR
  #undef PIN
  #undef MX3
  #undef GAPA
  #undef GAPB
  #undef EX
  #undef VRD
  #undef KRD
  #undef STEP
  #undef ENDW
  {auto rr=__builtin_amdgcn_permlane32_swap(__float_as_uint(l_reg),__float_as_uint(l_reg),false,false);l_reg=__uint_as_float(rr[0])+__uint_as_float(rr[1]);}
  if(hi==0)wsf[32+r32]=l_reg;asm volatile("s_waitcnt lgkmcnt(0)":::"memory");
  float rli[16];
  #pragma unroll
  for(int r=0;r<16;++r)rli[r]=__builtin_amdgcn_rcpf(wsf[32+crow(r,hi)]);
  bf16*Ow=O+(rowbase+q0+wid*QBLK)*OPITCH+h*D; const unsigned short*ogw=proj+(rowbase+q0+wid*QBLK)*(long)PROJ_PITCH+OG_COL+h*D;
  { bf16*stg=(bf16*)(shm+LDS_OST)+wid*2048;
    #pragma unroll
    for(int r=0;r<16;++r){const int orow=crow(r,hi);
      #pragma unroll
      for(int d0=0;d0<2;++d0)stg[orow*64+d0*32+r32]=__float2bfloat16(o[d0][r]*rli[r]);}
    asm volatile("s_waitcnt lgkmcnt(0)":::"memory");
    #pragma unroll
    for(int i=0;i<4;++i){const int row=i*8+(lane>>3),ch=lane&7; u32x4 v=*(const u32x4*)(stg+row*64+ch*8);
      const u32x4 gw_=*(const u32x4*)(ogw+(long)row*PROJ_PITCH+ch*8);
      const f32x4 g0={__uint_as_float(gw_[0]<<16),__uint_as_float(gw_[0]&0xffff0000u),__uint_as_float(gw_[1]<<16),__uint_as_float(gw_[1]&0xffff0000u)},g1={__uint_as_float(gw_[2]<<16),__uint_as_float(gw_[2]&0xffff0000u),__uint_as_float(gw_[3]<<16),__uint_as_float(gw_[3]&0xffff0000u)};
      #define SG(x) __builtin_amdgcn_rcpf(1.0f+__builtin_amdgcn_exp2f(-1.4426950408889634f*(x)))
      #define LO(w) __uint_as_float((w)<<16)
      #define HI(w) __uint_as_float((w)&0xffff0000u)
      v[0]=cvtpk_s(LO(v[0])*SG(g0[0]),HI(v[0])*SG(g0[1])); v[1]=cvtpk_s(LO(v[1])*SG(g0[2]),HI(v[1])*SG(g0[3]));
      v[2]=cvtpk_s(LO(v[2])*SG(g1[0]),HI(v[2])*SG(g1[1])); v[3]=cvtpk_s(LO(v[3])*SG(g1[2]),HI(v[3])*SG(g1[3]));
      #undef SG
      #undef LO
      #undef HI
      ATTN_STORE16(Ow+(long)row*OPITCH+ch*8,v);} }
  asm volatile("s_waitcnt lgkmcnt(0)\n\ts_barrier":::"memory");
  #undef DMA_K
  #undef DMA_V
  #undef CMASK
  #undef START
  #undef RESC
  #undef ROT
  #undef BIASC
}
constexpr int ATTN_LDS_BYTES=LDS_BYTES;
struct AttnTensors { const bf16* Q; const bf16* K; const bf16* V; bf16* O; const float* logf; const unsigned short* proj; };
constexpr int N_UNITS=BATCH*NHEAD*NQB;
template<int THRL=8> __device__ __forceinline__ void attn_phase(char*lds,const AttnTensors&T,unsigned*qhead,volatile __attribute__((address_space(3))) unsigned*qslot){
  for(;;){
    if(threadIdx.x==0)*qslot=__hip_atomic_fetch_add(qhead,1u,__ATOMIC_RELAXED,__HIP_MEMORY_SCOPE_AGENT);
    __syncthreads(); const unsigned u=*qslot; __syncthreads();
    if(u>=(unsigned)N_UNITS)break;
    const int qb=NQB-1-(int)(u>>5),bh=(int)(u&31u);
    attn_unit<THRL>(bh/NHEAD,bh%NHEAD,qb,T.Q,T.K,T.V,T.O,T.logf,T.proj,lds);
  }
}
#undef SBAR
#undef WAIT_BAR
}
#define GAS __attribute__((address_space(1)))
#define LAS __attribute__((address_space(3)))
typedef unsigned short bf16;
typedef unsigned v4u __attribute__((ext_vector_type(4)));
typedef float f32x4 __attribute__((ext_vector_type(4)));
typedef short bf16x8 __attribute__((ext_vector_type(8)));
typedef GAS unsigned gu32;
typedef GAS unsigned long long gu64;
#define RLX_AGENT __ATOMIC_RELAXED, __HIP_MEMORY_SCOPE_AGENT
#define LDS_WAIT() asm volatile("s_waitcnt lgkmcnt(0)" ::: "memory")
#define VM_WAIT() asm volatile("s_waitcnt vmcnt(0)" ::: "memory")
__device__ __forceinline__ unsigned long long rt() { return __builtin_amdgcn_s_memrealtime(); }
__device__ __forceinline__ unsigned f2bf(float f) { unsigned u = __builtin_bit_cast(unsigned, f); return (u + 0x7fffu + ((u >> 16) & 1u)) >> 16; }
__device__ __forceinline__ unsigned pk2(float lo, float hi) { return pg8::cvt_pk_bf16(lo, hi); }

#define XB_TMO      128
#define XB_XCNT(j)  (256  + 64 * (j))
#define XB_XSUB(j)  (1280 + 64 * (j))
#define XB_XGEN(j)  (2304 + 64 * (j))
#define XB_TOP      3328
#define XB_TOPGEN   3392
#define XCD_BAR_WORDS 3456
#define XB_SPIN_CAP (1u << 18)

__device__ __forceinline__ unsigned xb_ld(unsigned* p)              { return __hip_atomic_load(p, __ATOMIC_RELAXED, __HIP_MEMORY_SCOPE_AGENT); }
__device__ __forceinline__ unsigned xb_add(unsigned* p, unsigned v) { return __hip_atomic_fetch_add(p, v, __ATOMIC_RELAXED, __HIP_MEMORY_SCOPE_AGENT); }
__device__ __forceinline__ unsigned xb_xcc_id() { return (unsigned)__builtin_amdgcn_s_getreg((3 << 11) | 20) & 0xFu; }
#define XB_SPIN(cond, bar) do { unsigned _sp = 0; while (cond) { __builtin_amdgcn_s_sleep(1); \
    if ((++_sp & 255u) == 0u) { if (xb_ld(&(bar)[XB_TMO])) break; if (_sp > XB_SPIN_CAP) { atomicAdd(&(bar)[XB_TMO], 1u); break; } } } } while (0)

struct XcdBarrier {
    unsigned* bar; unsigned x;
    volatile LAS unsigned* st;
};

__device__ __forceinline__ XcdBarrier xcd_barrier_post(unsigned* bar, volatile LAS unsigned* st) {
    XcdBarrier b; b.bar = bar; b.x = xb_xcc_id(); b.st = st;
    if (threadIdx.x == 0) (void)xb_add(&bar[XB_XCNT(b.x)], 1u);
    return b;
}
__device__ __forceinline__ void xcd_barrier_complete(unsigned* bar, unsigned x, unsigned& nloc, unsigned& nx) {
    const unsigned G = gridDim.x * gridDim.y * gridDim.z;
    unsigned sum, cnt, mine, sp = 0u;
    for (;;) {
        sum = 0u; cnt = 0u; mine = 0u;
#pragma unroll
        for (unsigned j = 0; j < 16; ++j) { const unsigned c = xb_ld(&bar[XB_XCNT(j)]); sum += c; cnt += (c > 0u) ? 1u : 0u; mine = (j == x) ? c : mine; }
        if (sum == G) break;
        __builtin_amdgcn_s_sleep(1);
        if ((++sp & 255u) == 0u) { if (xb_ld(&bar[XB_TMO])) break; if (sp > XB_SPIN_CAP) { atomicAdd(&bar[XB_TMO], 1u); break; } }
    }
    nloc = mine > 0u ? mine : 1u; nx = cnt > 0u ? cnt : 1u;
}

__device__ __forceinline__ void xcd_barrier(const XcdBarrier& b) {
    asm volatile("s_waitcnt vmcnt(0)" ::: "memory");
    __syncthreads();
    if (threadIdx.x == 0) {
        unsigned* bar = b.bar;
        __builtin_amdgcn_s_waitcnt(0);
        unsigned nloc = b.st[0], nx = b.st[1];
        if (nloc == 0u) { xcd_barrier_complete(bar, b.x, nloc, nx); b.st[0] = nloc; b.st[1] = nx; }
        const unsigned old = xb_add(&bar[XB_XSUB(b.x)], 1u);
        const unsigned gen = old / nloc;
        if (old + 1u == (gen + 1u) * nloc) {
            __builtin_amdgcn_fence(__ATOMIC_RELEASE, "agent");
            asm volatile("s_waitcnt vmcnt(0)" ::: "memory");
            const unsigned og = xb_add(&bar[XB_TOP], 1u);
            const unsigned tg = og / nx;
            if (og + 1u == (tg + 1u) * nx) xb_add(&bar[XB_TOPGEN], 1u);
            else XB_SPIN(xb_ld(&bar[XB_TOPGEN]) == tg, bar);
            __builtin_amdgcn_fence(__ATOMIC_ACQUIRE, "agent");
            xb_add(&bar[XB_XGEN(b.x)], 1u);
            asm volatile("s_waitcnt vmcnt(0)" ::: "memory");
        } else {
            XB_SPIN(xb_ld(&bar[XB_XGEN(b.x)]) == gen, bar);
            __builtin_amdgcn_fence(__ATOMIC_ACQUIRE, "agent");
            asm volatile("s_waitcnt vmcnt(0)" ::: "memory");
        }
    }
    __syncthreads();
}

constexpr int NWAVES = 8, NTHR = 512;
constexpr int BATCH = 4, SEQ = 4096, D = 1024, M = BATCH * SEQ;
constexpr int NH = 8, HD = 64, RWW = 512;
constexpr int IN_COLS = 3752, PL = 3840;
constexpr int C_R = 0, C_K = 512, C_V = 1024, C_WD = 1536, C_AD = 1568, C_GD = 1600;
constexpr int C_FQ = 1696, C_FK = 2208, C_FV = 2720, C_OG = 3232, C_FZ = 3744;
constexpr int NE = 32, TOPK = 4, NASSIGN = M * TOPK, MAXTILES = NASSIGN / 256 + NE, XROWS = MAXTILES * 256;
constexpr float LN_EPS = 1e-5f, QK_EPS = 1e-6f, GN_EPS = 64e-5f, ALPHA = 1.189207115002721f;
static_assert(attn_body::PROJ_PITCH == PL && attn_body::OG_COL == C_OG, "attention body constants");

constexpr size_t MiB = 1u << 20;
constexpr size_t WS_CTL = 0, CTL_ZERO_BYTES = 1 * MiB;
constexpr size_t WS_WIN = 2 * MiB, WS_WO = 10 * MiB;
constexpr size_t WS_LOGF = 12 * MiB;
constexpr size_t WS_AE = WS_LOGF + 512 * 1024, WS_APOS = WS_AE + 256 * 1024, WS_AGATE = WS_APOS + 256 * 1024, WS_AROW = WS_AGATE + 256 * 1024, WS_ROWGATE = WS_AROW + 256 * 1024, WS_ROWTOK = WS_ROWGATE + 512 * 1024;
constexpr size_t WS_W1T = 32 * MiB, WS_W2T = 160 * MiB;
constexpr size_t WS_HB = 224 * MiB;
constexpr size_t WS_HF = 256 * MiB;
constexpr size_t WS_PROJ = 320 * MiB;
constexpr size_t WS_G = 560 * MiB, WS_BONUS = 592 * MiB;
constexpr size_t WS_QB = 624 * MiB, WS_KB = 640 * MiB, WS_VB = 656 * MiB;
constexpr size_t WS_MIX = 672 * MiB;
constexpr size_t WS_MC = 704 * MiB, WS_NT = 720 * MiB, WS_QC = 752 * MiB, WS_ZT = 768 * MiB;
constexpr size_t WS_Y = 800 * MiB;
constexpr size_t WS_XS = 320 * MiB, WS_ACT = 464 * MiB, WS_EOUT = 320 * MiB;
constexpr size_t WS_END = 832 * MiB;
static_assert(WS_ROWTOK + (size_t)XROWS * 4 <= WS_W1T && WS_XS + (size_t)XROWS * 2048 <= WS_ACT && WS_ACT + (size_t)XROWS * 2048 <= WS_QB, "d_ws map");

constexpr int CW_BAR = 4096, CW_ATTQ = 8192, CW_CVQ = 8224, CW_ECNT = 8256;

constexpr int RING_OFF = 0;
constexpr int CTRL_OFF = 159744, LDS_BYTES = 163840;
constexpr int LC_MISC = 0  , LC_HIST = 128, LC_BASE = 256, LC_TSTART = 384, LC_TEXP = 640  , LC_ROWINFO = 1024  ;
static_assert(attn_body::ATTN_LDS_BYTES <= 131072, "attention scratch inside the ring region");

typedef float f32x2 __attribute__((ext_vector_type(2)));
typedef unsigned u32x2v __attribute__((ext_vector_type(2)));
#define MFMA16(a, b, c) __builtin_amdgcn_mfma_f32_16x16x32_bf16((a), (b), (c), 0, 0, 0)
__device__ __forceinline__ float sigmoidf_(float x) { return __builtin_amdgcn_rcpf(1.0f + __builtin_amdgcn_exp2f(-1.4426950408889634f * x)); }
__device__ __forceinline__ float tanh_fast(float x) { return 1.0f - 2.0f * __builtin_amdgcn_rcpf(1.0f + __builtin_amdgcn_exp2f(2.8853900817779268f * x)); }
__device__ __forceinline__ float log1pexp_neg(float ax) { return 0.6931471805599453f * __builtin_amdgcn_logf(1.0f + __builtin_amdgcn_exp2f(-1.4426950408889634f * ax)); }
__device__ __forceinline__ float bf2f(unsigned short b) { return __uint_as_float((unsigned)b << 16); }
__device__ __forceinline__ unsigned short f2bf16(float f) { return (unsigned short)f2bf(f); }
__device__ __forceinline__ v4u pack8(const float* v) { v4u o; o.x = pg8::cvt_pk_bf16(v[0], v[1]); o.y = pg8::cvt_pk_bf16(v[2], v[3]); o.z = pg8::cvt_pk_bf16(v[4], v[5]); o.w = pg8::cvt_pk_bf16(v[6], v[7]); return o; }
__device__ __forceinline__ float wave_sum(float v) {
#pragma unroll
    for (int o = 1; o < 64; o <<= 1) v += __shfl_xor(v, o);
    return v;
}

__device__ __forceinline__ void transpose_item(const float* W, int K, int N, int nblk, bf16* WT, LAS float* scr, int item, int lane) {
    const int kb = item / nblk, nb = item - kb * nblk, k0 = 64 * kb, n0 = 32 * nb; const int nn = n0 + (lane & 31); const bool ok = nn < N;
#pragma unroll 8
    for (int i = 0; i < 32; ++i) { const int kk = 2 * i + (lane >> 5); scr[kk * 33 + (lane & 31)] = ok ? W[(size_t)(k0 + kk) * N + nn] : 0.f; }
    LDS_WAIT(); asm volatile("" ::: "memory");
    const int c = lane & 7;
#pragma unroll
    for (int j = 0; j < 4; ++j) { const int n = (lane >> 3) + 8 * j; const LAS float* s = scr + (8 * c) * 33 + n;
        v4u o; o.x = pk2(s[0 * 33], s[1 * 33]); o.y = pk2(s[2 * 33], s[3 * 33]); o.z = pk2(s[4 * 33], s[5 * 33]); o.w = pk2(s[6 * 33], s[7 * 33]);
        *(GAS v4u*)(WT + (size_t)(n0 + n) * K + k0 + 8 * c) = o; }
    LDS_WAIT(); asm volatile("" ::: "memory");
}
__device__ __forceinline__ void ln_finish(f32x4 (&v)[4], const float* w, const float* b, int lane, float* outF, bf16* outB) {
    float s = 0.f;
#pragma unroll
    for (int j = 0; j < 4; ++j) s += (v[j].x + v[j].y) + (v[j].z + v[j].w);
    const float mean = wave_sum(s) * (1.f / D); float s2 = 0.f;
#pragma unroll
    for (int j = 0; j < 4; ++j) { v[j] = v[j] - mean; s2 += (v[j].x * v[j].x + v[j].y * v[j].y) + (v[j].z * v[j].z + v[j].w * v[j].w); }
    const float rstd = 1.f / sqrtf(wave_sum(s2) * (1.f / D) + LN_EPS);
#pragma unroll
    for (int j = 0; j < 4; ++j) { const f32x4 wv = *(const f32x4*)(w + 4 * lane + 256 * j), bv = *(const f32x4*)(b + 4 * lane + 256 * j); v[j] = v[j] * rstd * wv + bv;
        if (outF) *(f32x4*)(outF + 4 * lane + 256 * j) = v[j];
        if (outB) { u32x2v o; o.x = pg8::cvt_pk_bf16(v[j].x, v[j].y); o.y = pg8::cvt_pk_bf16(v[j].z, v[j].w); *(u32x2v*)(outB + 4 * lane + 256 * j) = o; } }
}

struct CvtItem { const float* W; bf16* WT; int N; int k0, n0; };
__device__ __forceinline__ CvtItem cvt_item(int it, const float* w1, const float* w2, bf16* W1T, bf16* W2T) {
    CvtItem c;
    it = __builtin_amdgcn_readfirstlane(it);
    if (it < NE * 1024) { const int e = it >> 10, r = it & 1023; c.W = w1 + (size_t)e * D * 2048; c.WT = W1T + (size_t)e * 2048 * D; c.N = 2048; c.k0 = 64 * (r >> 6); c.n0 = 32 * (r & 63); }
    else { const int i2 = it - NE * 1024, e = i2 >> 9, r = i2 & 511; c.W = w2 + (size_t)e * D * D; c.WT = W2T + (size_t)e * D * D; c.N = D; c.k0 = 64 * (r >> 5); c.n0 = 32 * (r & 31); }
    return c;
}
__device__ __forceinline__ void cvt_load(f32x4 (&ld)[8], const CvtItem& c, int lane) {
    const int fr = lane & 15, fq = lane >> 4;
    const char* base = (const char*)(c.W + (size_t)c.k0 * c.N + c.n0);
    const unsigned lo = (unsigned)((8 * (fr >> 2) + (fr & 3)) * c.N + 8 * fq) * 4u;
#pragma unroll
    for (int p = 0; p < 2; ++p)
#pragma unroll
        for (int m = 0; m < 2; ++m) { const unsigned off = lo + (unsigned)((32 * p + 4 * m) * c.N) * 4u;
            ld[(p * 2 + m) * 2] = *(const f32x4*)(base + off); ld[(p * 2 + m) * 2 + 1] = *(const f32x4*)(base + off + 16u); }
}
__device__ __forceinline__ void cvt_finish(const f32x4 (&ld)[8], const CvtItem& c, int lane) {
    const int fr = lane & 15, fq = lane >> 4;
    bf16x8 sel[2];
#pragma unroll
    for (int h = 0; h < 2; ++h) { v4u sw;
#pragma unroll
        for (int e2 = 0; e2 < 4; ++e2) sw[e2] = ((8 * fq + 2 * e2 == 16 * h + fr) ? 0x3F80u : 0u) | ((8 * fq + 2 * e2 + 1 == 16 * h + fr) ? 0x3F800000u : 0u);
        sel[h] = __builtin_bit_cast(bf16x8, sw); }
#pragma unroll
    for (int p = 0; p < 2; ++p) { bf16x8 a[2];
#pragma unroll
        for (int m = 0; m < 2; ++m) { const f32x4 x0 = ld[(p * 2 + m) * 2], x1 = ld[(p * 2 + m) * 2 + 1]; v4u q; q.x = pk2(x0[0], x0[1]); q.y = pk2(x0[2], x0[3]); q.z = pk2(x1[0], x1[1]); q.w = pk2(x1[2], x1[3]); a[m] = __builtin_bit_cast(bf16x8, q); }
#pragma unroll
        for (int h = 0; h < 2; ++h) { const f32x4 z4 = {0.f, 0.f, 0.f, 0.f}; const f32x4 d0 = MFMA16(a[0], sel[h], z4), d1 = MFMA16(a[1], sel[h], z4);
            v4u o; o.x = pk2(d0[0], d0[1]); o.y = pk2(d0[2], d0[3]); o.z = pk2(d1[0], d1[1]); o.w = pk2(d1[2], d1[3]);
            *(v4u*)((char*)(c.WT + (size_t)c.n0 * D + c.k0) + (unsigned)((16 * h + fr) * D + 32 * p + 8 * fq) * 2u) = o; } }
}

struct CvtSide { const float* w2; bf16* W2T; int lane, wave; f32x4 cld[8]; CvtItem ci;
    __device__ __forceinline__ void pre(const pg8::Unit& u) { const int idx = ((u.pm * 8 + u.pn) * 8 + wave) & (NE * 512 - 1); ci = cvt_item(NE * 1024 + idx, nullptr, w2, nullptr, W2T); cvt_load(cld, ci, lane); }
    __device__ __forceinline__ void post(const pg8::Unit&) { cvt_finish(cld, ci, lane); } };

struct FoxRow { v4u qa, ka, va; unsigned short fz; };
struct FoxPtrs { const bf16* proj; const float *qn, *kn, *bfp; bf16 *QB, *KB, *VB; float* LOGF; };
__device__ __forceinline__ void fox_load(FoxRow& r, const FoxPtrs& F, int m, int lane) {
    const bf16* pr = F.proj + (size_t)m * PL; r.qa = *(const v4u*)(pr + C_FQ + 8 * lane); r.ka = *(const v4u*)(pr + C_FK + 8 * lane); r.va = *(const v4u*)(pr + C_FV + 8 * lane); r.fz = pr[C_FZ + (lane & 7)]; }
__device__ __forceinline__ void fox_finish(const FoxRow& r, const FoxPtrs& F, int m, int lane) {
    const int d0 = (8 * lane) & 63; float q[8], k[8]; float sq = 0.f, sk = 0.f;
    const f32x4 qn0 = *(const f32x4*)(F.qn + d0), qn1 = *(const f32x4*)(F.qn + d0 + 4), kn0 = *(const f32x4*)(F.kn + d0), kn1 = *(const f32x4*)(F.kn + d0 + 4);
    const float qnv[8] = {qn0[0], qn0[1], qn0[2], qn0[3], qn1[0], qn1[1], qn1[2], qn1[3]}, knv[8] = {kn0[0], kn0[1], kn0[2], kn0[3], kn1[0], kn1[1], kn1[2], kn1[3]};
#pragma unroll
    for (int i = 0; i < 4; ++i) { q[2 * i] = __uint_as_float(r.qa[i] << 16); q[2 * i + 1] = __uint_as_float(r.qa[i] & 0xffff0000u); k[2 * i] = __uint_as_float(r.ka[i] << 16); k[2 * i + 1] = __uint_as_float(r.ka[i] & 0xffff0000u); }
#pragma unroll
    for (int i = 0; i < 8; ++i) { sq += q[i] * q[i]; sk += k[i] * k[i]; }
    sq += __shfl_xor(sq, 1); sq += __shfl_xor(sq, 2); sq += __shfl_xor(sq, 4);
    sk += __shfl_xor(sk, 1); sk += __shfl_xor(sk, 2); sk += __shfl_xor(sk, 4);
    const float rq = rsqrtf(sq * (1.f / 64.f) + QK_EPS) * attn_body::C2, rk = rsqrtf(sk * (1.f / 64.f) + QK_EPS);
#pragma unroll
    for (int i = 0; i < 8; ++i) { q[i] = q[i] * rq * qnv[i]; k[i] = k[i] * rk * knv[i]; }
    *(v4u*)(F.QB + (size_t)m * 512 + 8 * lane) = pack8(q); *(v4u*)(F.KB + (size_t)m * 512 + 8 * lane) = pack8(k); *(v4u*)(F.VB + (size_t)m * 512 + 8 * lane) = r.va;
    if (lane < 8) { const float z = bf2f(r.fz) + F.bfp[lane]; const float lf = fminf(z, 0.f) - log1pexp_neg(fabsf(z)); const int b = m >> 12, t = m & 4095; F.LOGF[(size_t)(b * NH + lane) * SEQ + t] = lf; }
}

namespace rwk {
constexpr int OPS = 144;
constexpr int XPS = 336;
constexpr int O_WT = 0;
constexpr int O_A = 21504;
constexpr int O_XLH = O_A, O_XLL = O_A + 21504, O_PART = O_A;
constexpr int O_RT = O_A, O_AT = O_A + 9216, O_BT = O_A + 18432, O_KT = O_A + 27648;
constexpr int O_XT = O_AT;
constexpr int O_PT1 = O_KT;
constexpr int O_U2 = 64512;
constexpr int O_CUM = O_U2, O_BF = O_U2 + 16384, O_KF = O_U2 + 32768;
constexpr int O_PA0 = O_U2, O_PT0 = O_U2 + 9216, O_ARB = O_U2 + 18432, O_ARK = O_U2 + 27648, O_AAK = O_U2 + 36864, O_PA1 = O_AAK;
constexpr int O_VT = 113664, O_BHT = O_VT + 9216, O_KHT = O_VT + 18432, O_GAMC = 141312, O_RHS = 141568  , O_END = O_RHS + 16384;
static_assert(O_END <= CTRL_OFF, "RWKV arena below the LDS control area");

#define LDS_BARRIER() do { asm volatile("s_waitcnt lgkmcnt(0)" ::: "memory"); __builtin_amdgcn_s_barrier(); asm volatile("" ::: "memory"); } while (0)
struct Ptrs { const bf16* proj; const float *mu, *w0, *w2, *a0, *a2, *g2, *k_k, *k_a, *r_k; bf16 *G, *Bonus; bf16* Mc; bf16* NT; bf16* Qc; bf16* ZT; };
struct Pre { u32x2v xp[5], xq[5]; v4u rc, rp, kc, kp, vc, vp; };
struct Cvt { const float *w1, *w2; bf16 *W1T, *W2T; int it0; const FoxPtrs* fox; int foxm; };

__device__ __forceinline__ void stage_weights(LAS unsigned char* lds, int h, const Ptrs& P) {
    const int tid = threadIdx.x;
#pragma unroll
    for (int q = 0; q < 5; ++q) { const int p = tid + 512 * q, n = p & 63, j0 = 4 * (p >> 6);
        const float* src = (j0 < 32) ? (P.w2 + j0 * 512) : ((j0 < 64) ? (P.a2 + (j0 - 32) * 512) : (P.g2 + (j0 - 64) * 512));
        const float a = src[h * 64 + n], b = src[512 + h * 64 + n], c = src[1024 + h * 64 + n], d = src[1536 + h * 64 + n];
        u32x2v w; w.x = pg8::cvt_pk_bf16(a, b); w.y = pg8::cvt_pk_bf16(c, d); *(LAS u32x2v*)(lds + O_WT + n * XPS + j0 * 2) = w; }
}
__device__ __forceinline__ void prefetch(Pre& R, const int un, const Ptrs& P, const int tid) { const int b = un >> 9, h = (un >> 6) & 7, c = un & 63; const int tok0 = b * SEQ + c * 64;
    const int t = tid >> 3, hn0 = h * 64 + 8 * (tid & 7);
    const char* pb = (const char*)(P.proj + (size_t)tok0 * PL);
    const char* pbm = (c == 0) ? pb : pb - (size_t)PL * 2;
    const unsigned pshift = (c == 0) ? (unsigned)PL * 2u : 0u;
#pragma unroll
    for (int i = 0; i < 5; ++i) { const int idx = tid + 512 * i, tt = idx / 40, c4 = idx - tt * 40; const unsigned off = (unsigned)(tt * PL + C_WD + 4 * c4) * 2u;
        R.xp[i] = *(const u32x2v*)(pb + off); R.xq[i] = (c == 0 && tt == 0) ? (u32x2v){0u, 0u} : *(const u32x2v*)(pbm + (off - pshift)); }
    const bool first = (c == 0 && t == 0); const unsigned off = (unsigned)(t * PL + hn0) * 2u;
    R.rc = *(const v4u*)(pb + off + C_R * 2); R.kc = *(const v4u*)(pb + off + C_K * 2); R.vc = *(const v4u*)(pb + off + C_V * 2);
    if (first) { R.rp = (v4u){0u, 0u, 0u, 0u}; R.kp = R.rp; R.vp = R.rp; }
    else { R.rp = *(const v4u*)(pbm + (off - pshift) + C_R * 2); R.kp = *(const v4u*)(pbm + (off - pshift) + C_K * 2); R.vp = *(const v4u*)(pbm + (off - pshift) + C_V * 2); }
}

__device__ __forceinline__ void unit(LAS unsigned char* lds, const int un, const Ptrs& P, const Pre& R, Pre& Rn, const bool has_next, const int un_next, const Cvt& cv) {
    int tid_ = threadIdx.x; asm volatile("" : "+v"(tid_));
    const int tid = tid_, lane = tid & 63, w = __builtin_amdgcn_readfirstlane(tid >> 6);
    const int b = un >> 9, h = (un >> 6) & 7, c = un & 63; const int tok0 = b * SEQ + c * 64;
    LAS float* CU = (LAS float*)(lds + O_CUM); LAS float* BF = (LAS float*)(lds + O_BF); LAS float* KF = (LAS float*)(lds + O_KF);
    LAS float* RHS = (LAS float*)(lds + O_RHS); LAS float* PART = (LAS float*)(lds + O_PART); LAS float* GAMC = (LAS float*)(lds + O_GAMC);
    const int t = tid >> 3, cg = tid & 7, n0 = 8 * cg, hn0 = h * 64 + n0;
    const int fr = lane & 15, fq = lane >> 4;
    FoxRow fxr; const bool dofox = cv.foxm >= 0; if (dofox) fox_load(fxr, *cv.fox, cv.foxm, lane);
    const bool docv = cv.it0 >= 0; f32x4 cldA[8], cldB[8]; CvtItem ciA, ciB;
    if (docv) { ciA = cvt_item(cv.it0, cv.w1, cv.w2, cv.W1T, cv.W2T); cvt_load(cldA, ciA, lane); }
#define BF4(w) ((f32x4){__uint_as_float((w).x << 16), __uint_as_float((w).x & 0xffff0000u), __uint_as_float((w).y << 16), __uint_as_float((w).y & 0xffff0000u)})
#pragma unroll
    for (int i = 0; i < 5; ++i) { const int idx = tid + 512 * i, tt = idx / 40, c4 = idx - tt * 40; const f32x4 m4 = *(const f32x4*)(P.mu + C_WD + 4 * c4);
        const f32x4 xp = BF4(R.xp[i]), xq = BF4(R.xq[i]); f32x4 x = xp + m4 * (xq - xp); float hi[4], lo[4];
#pragma unroll
        for (int e = 0; e < 4; ++e) { const int j = 4 * c4 + e; const float y = (j < 32) ? tanh_fast(x[e]) : ((j < 64) ? x[e] : sigmoidf_(x[e])); hi[e] = bf2f(f2bf16(y)); lo[e] = y - hi[e]; }
        u32x2v wh, wl; wh.x = pg8::cvt_pk_bf16(hi[0], hi[1]); wh.y = pg8::cvt_pk_bf16(hi[2], hi[3]); wl.x = pg8::cvt_pk_bf16(lo[0], lo[1]); wl.y = pg8::cvt_pk_bf16(lo[2], lo[3]);
        *(LAS u32x2v*)(lds + O_XLH + tt * XPS + c4 * 8) = wh; *(LAS u32x2v*)(lds + O_XLL + tt * XPS + c4 * 8) = wl; }
    float r8[8], k8[8], v8[8];
    { u32x2v a; f32x4 rc[2], rp[2], kc[2], kp[2], vc[2], vp[2];
      a = (u32x2v){R.rc.x, R.rc.y}; rc[0] = BF4(a); a = (u32x2v){R.rc.z, R.rc.w}; rc[1] = BF4(a); a = (u32x2v){R.rp.x, R.rp.y}; rp[0] = BF4(a); a = (u32x2v){R.rp.z, R.rp.w}; rp[1] = BF4(a);
      a = (u32x2v){R.kc.x, R.kc.y}; kc[0] = BF4(a); a = (u32x2v){R.kc.z, R.kc.w}; kc[1] = BF4(a); a = (u32x2v){R.kp.x, R.kp.y}; kp[0] = BF4(a); a = (u32x2v){R.kp.z, R.kp.w}; kp[1] = BF4(a);
      a = (u32x2v){R.vc.x, R.vc.y}; vc[0] = BF4(a); a = (u32x2v){R.vc.z, R.vc.w}; vc[1] = BF4(a); a = (u32x2v){R.vp.x, R.vp.y}; vp[0] = BF4(a); a = (u32x2v){R.vp.z, R.vp.w}; vp[1] = BF4(a);
#pragma unroll
      for (int hf = 0; hf < 2; ++hf) { const f32x4 mr = *(const f32x4*)(P.mu + C_R + hn0 + 4 * hf), mk = *(const f32x4*)(P.mu + C_K + hn0 + 4 * hf), mv = *(const f32x4*)(P.mu + C_V + hn0 + 4 * hf);
          const f32x4 r = rc[hf] + mr * (rp[hf] - rc[hf]), k = kc[hf] + mk * (kp[hf] - kc[hf]), v = vc[hf] + mv * (vp[hf] - vc[hf]);
#pragma unroll
          for (int e = 0; e < 4; ++e) { r8[4 * hf + e] = r[e]; k8[4 * hf + e] = k[e]; v8[4 * hf + e] = v[e]; } } }
#undef BF4
    LDS_BARRIER();
    if (docv) { ciB = cvt_item(cv.it0 + 1, cv.w1, cv.w2, cv.W1T, cv.W2T); cvt_load(cldB, ciB, lane); }
    {
        const int tt = w & 3;
#pragma unroll
        for (int cc = 0; cc < 2; ++cc) { const int nt = 2 * (w >> 2) + cc; f32x4 acc[3];
#pragma unroll
            for (int a = 0; a < 3; ++a) acc[a] = (f32x4){0.f, 0.f, 0.f, 0.f};
#pragma unroll
            for (int ks = 0; ks < 5; ++ks) { const int a = (ks == 0) ? 0 : ((ks == 1) ? 1 : 2);
                const bf16x8 bw = *(const LAS bf16x8*)(lds + O_WT + (16 * nt + fr) * XPS + (32 * ks + 8 * fq) * 2);
                const bf16x8 xh = *(const LAS bf16x8*)(lds + O_XLH + (16 * tt + fr) * XPS + (32 * ks + 8 * fq) * 2), xl = *(const LAS bf16x8*)(lds + O_XLL + (16 * tt + fr) * XPS + (32 * ks + 8 * fq) * 2);
                acc[a] = MFMA16(xh, bw, acc[a]); acc[a] = MFMA16(xl, bw, acc[a]); }
#pragma unroll
            for (int a = 0; a < 3; ++a)
#pragma unroll
                for (int j = 0; j < 4; ++j) CU[a * 4096 + (16 * tt + 4 * fq + j) * 64 + 16 * nt + fr] = acc[a][j]; }
    }
    LDS_BARRIER();
    if (dofox) fox_finish(fxr, *cv.fox, cv.foxm, lane);
    float a8[8], b8[8], lw8[8];
    {
        float accw[8], acca[8], accg[8];
        { const f32x4 q0 = *(const LAS f32x4*)(CU + t * 64 + n0), q1 = *(const LAS f32x4*)(CU + t * 64 + n0 + 4), q2 = *(const LAS f32x4*)(BF + t * 64 + n0), q3 = *(const LAS f32x4*)(BF + t * 64 + n0 + 4), q4 = *(const LAS f32x4*)(KF + t * 64 + n0), q5 = *(const LAS f32x4*)(KF + t * 64 + n0 + 4);
#pragma unroll
          for (int e = 0; e < 4; ++e) { accw[e] = q0[e]; accw[4 + e] = q1[e]; acca[e] = q2[e]; acca[4 + e] = q3[e]; accg[e] = q4[e]; accg[4 + e] = q5[e]; } }
        float kkr[8], lr8[8], g8[8]; float ss = 0.f, dotb = 0.f;
        float pw0[8], pa0[8], pkk[8], pka[8], prk[8];
#pragma unroll
        for (int hf = 0; hf < 2; ++hf) { const f32x4 q0 = *(const f32x4*)(P.w0 + hn0 + 4 * hf), q1 = *(const f32x4*)(P.a0 + hn0 + 4 * hf), q2 = *(const f32x4*)(P.k_k + hn0 + 4 * hf), q3 = *(const f32x4*)(P.k_a + hn0 + 4 * hf), q4 = *(const f32x4*)(P.r_k + hn0 + 4 * hf);
#pragma unroll
            for (int e = 0; e < 4; ++e) { pw0[4 * hf + e] = q0[e]; pa0[4 * hf + e] = q1[e]; pkk[4 * hf + e] = q2[e]; pka[4 * hf + e] = q3[e]; prk[4 * hf + e] = q4[e]; } }
#pragma unroll
        for (int i = 0; i < 8; ++i) {
            const float xw = pw0[i] + accw[i];
            const float wv = fminf(xw, 0.f) - log1pexp_neg(fabsf(xw)) - 0.5f;
            lw8[i] = -__expf(wv);
            lr8[i] = sigmoidf_(pa0[i] + acca[i]); g8[i] = accg[i];
            kkr[i] = k8[i] * pkk[i]; ss += kkr[i] * kkr[i];
            k8[i] = k8[i] * (1.f + (lr8[i] - 1.f) * pka[i]);
            dotb += r8[i] * k8[i] * prk[i]; }
        ss += __shfl_xor(ss, 1); ss += __shfl_xor(ss, 2); ss += __shfl_xor(ss, 4);
        dotb += __shfl_xor(dotb, 1); dotb += __shfl_xor(dotb, 2); dotb += __shfl_xor(dotb, 4);
        const float inv = 1.f / fmaxf(sqrtf(ss), 1e-12f);
        float bon[8];
#pragma unroll
        for (int i = 0; i < 8; ++i) { const float kk = kkr[i] * inv; a8[i] = -kk; b8[i] = kk * lr8[i]; bon[i] = dotb * v8[i]; }
        *(v4u*)(P.G + (size_t)(tok0 + t) * RWW + hn0) = pack8(g8); *(v4u*)(P.Bonus + (size_t)(tok0 + t) * RWW + hn0) = pack8(bon);
        *(LAS f32x4*)(CU + t * 64 + n0) = (f32x4){lw8[0], lw8[1], lw8[2], lw8[3]}; *(LAS f32x4*)(CU + t * 64 + n0 + 4) = (f32x4){lw8[4], lw8[5], lw8[6], lw8[7]};
        *(LAS f32x4*)(BF + t * 64 + n0) = (f32x4){b8[0], b8[1], b8[2], b8[3]}; *(LAS f32x4*)(BF + t * 64 + n0 + 4) = (f32x4){b8[4], b8[5], b8[6], b8[7]};
        *(LAS f32x4*)(KF + t * 64 + n0) = (f32x4){k8[0], k8[1], k8[2], k8[3]}; *(LAS f32x4*)(KF + t * 64 + n0 + 4) = (f32x4){k8[4], k8[5], k8[6], k8[7]};
        LAS unsigned short* VT = (LAS unsigned short*)(lds + O_VT);
#pragma unroll
        for (int i = 0; i < 8; ++i) VT[(n0 + i) * 72 + t] = f2bf16(v8[i]);
    }
    LDS_BARRIER();
    if (docv) { cvt_finish(cldA, ciA, lane); ciA = cvt_item(cv.it0 + 2, cv.w1, cv.w2, cv.W1T, cv.W2T); cvt_load(cldA, ciA, lane); }
    {
        const int n = tid & 63, tg = w; float run = 0.f;
#pragma unroll
        for (int i = 0; i < 8; ++i) { run += CU[(8 * tg + i) * 64 + n]; CU[(8 * tg + i) * 64 + n] = run; }
        PART[tg * 64 + n] = run;
        LDS_BARRIER();
        float off = 0.f;
        for (int g = 0; g < tg; ++g) off += PART[g * 64 + n];
#pragma unroll
        for (int i = 0; i < 8; ++i) CU[(8 * tg + i) * 64 + n] += off;
        if (tg == 7) GAMC[n] = __expf(run + off);
    }
    LDS_BARRIER();
    {
        const f32x4 c0 = *(const LAS f32x4*)(CU + t * 64 + n0), c1 = *(const LAS f32x4*)(CU + t * 64 + n0 + 4);
        const float cum[8] = {c0[0], c0[1], c0[2], c0[3], c1[0], c1[1], c1[2], c1[3]};
        float rt[8], at[8], bt[8], kt[8];
#pragma unroll
        for (int i = 0; i < 8; ++i) { const float ein = __expf(cum[i]), eex = __expf(cum[i] - lw8[i]), eneg = __expf(-cum[i]);
            rt[i] = r8[i] * ein; at[i] = a8[i] * eex; bt[i] = b8[i] * eneg; kt[i] = k8[i] * eneg; }
        *(LAS v4u*)(lds + O_RT + t * OPS + cg * 16) = pack8(rt); *(LAS v4u*)(lds + O_AT + t * OPS + cg * 16) = pack8(at);
        *(LAS v4u*)(lds + O_BT + t * OPS + cg * 16) = pack8(bt); *(LAS v4u*)(lds + O_KT + t * OPS + cg * 16) = pack8(kt);
        *(LAS f32x4*)(RHS + t * 64 + n0) = (f32x4){at[0], at[1], at[2], at[3]}; *(LAS f32x4*)(RHS + t * 64 + n0 + 4) = (f32x4){at[4], at[5], at[6], at[7]};
    }
    {
        const int n = tid & 63, tg = w; const float cC = CU[63 * 64 + n]; float bh[8], kh[8];
#pragma unroll
        for (int i = 0; i < 8; ++i) { const int tt = 8 * tg + i; const float e = __expf(cC - CU[tt * 64 + n]); bh[i] = BF[tt * 64 + n] * e; kh[i] = KF[tt * 64 + n] * e; }
        *(LAS v4u*)(lds + O_BHT + n * OPS + tg * 16) = pack8(bh); *(LAS v4u*)(lds + O_KHT + n * OPS + tg * 16) = pack8(kh);
    }
    LDS_BARRIER();
    if (docv) cvt_finish(cldB, ciB, lane);
    if (has_next) prefetch(Rn, un_next, P, tid);
#define FRAG(off, row, ks) (*(const LAS bf16x8*)(lds + (off) + (row) * OPS + (ks) * 64 + fq * 16))
    {
        const int tt = w & 3, mg = w >> 2; const int lo = mg ? O_RT : O_AT;
        LAS unsigned short* AAK = (LAS unsigned short*)(lds + O_AAK); LAS unsigned short* ARB = (LAS unsigned short*)(lds + O_ARB); LAS unsigned short* ARK = (LAS unsigned short*)(lds + O_ARK);
        LAS unsigned short* PA0 = (LAS unsigned short*)(lds + O_PA0);
        const bf16x8 l0 = FRAG(lo, 16 * tt + fr, 0), l1 = FRAG(lo, 16 * tt + fr, 1);
#pragma unroll
        for (int ct = 0; ct < 4; ++ct)
#pragma unroll
            for (int rh = 0; rh < 2; ++rh) {
                f32x4 acc = {0.f, 0.f, 0.f, 0.f};
                if (ct <= tt) { const int ro = rh ? O_KT : O_BT; acc = MFMA16(l0, FRAG(ro, 16 * ct + fr, 0), acc); acc = MFMA16(l1, FRAG(ro, 16 * ct + fr, 1), acc); }
                const int col = 16 * ct + fr, rowb = 16 * tt + 4 * fq; float vv[4];
#pragma unroll
                for (int j = 0; j < 4; ++j) vv[j] = (mg == 0) ? ((col < rowb + j) ? acc[j] : 0.f) : ((col <= rowb + j) ? acc[j] : 0.f);
                LAS unsigned short* dst = (mg == 0) ? (rh == 0 ? PA0 : AAK) : (rh == 0 ? ARB : ARK);
#pragma unroll
                for (int j = 0; j < 4; ++j) dst[(rowb + j) * 72 + col] = f2bf16(vv[j]);
                if (mg == 0 && rh == 0) { u32x2v pk; pk.x = pg8::cvt_pk_bf16(vv[0], vv[1]); pk.y = pg8::cvt_pk_bf16(vv[2], vv[3]); *(LAS u32x2v*)(lds + O_PT0 + col * OPS + rowb * 2) = pk; }
            }
    }
    LDS_BARRIER();
    {
        f32x4 X[4];
        if (w < 4) {
#pragma unroll
            for (int tt = 0; tt < 4; ++tt)
#pragma unroll
                for (int j = 0; j < 4; ++j) X[tt][j] = RHS[(16 * tt + 4 * fq + j) * 64 + 16 * w + fr];
        } else {
#pragma unroll
            for (int tt = 0; tt < 4; ++tt) { f32x4 acc = {0.f, 0.f, 0.f, 0.f};
                acc = MFMA16(FRAG(O_AAK, 16 * tt + fr, 0), FRAG(O_VT, 16 * (w - 4) + fr, 0), acc); acc = MFMA16(FRAG(O_AAK, 16 * tt + fr, 1), FRAG(O_VT, 16 * (w - 4) + fr, 1), acc); X[tt] = acc; }
        }
        LDS_BARRIER();
#pragma unroll
        for (int k = 0; k < 6; ++k) {
            const int pa = (k & 1) ? O_PA1 : O_PA0, pt = (k & 1) ? O_PT1 : O_PT0, pan = (k & 1) ? O_PA0 : O_PA1, ptn = (k & 1) ? O_PT0 : O_PT1;
            bf16x8 xb[2];
#pragma unroll
            for (int ks = 0; ks < 2; ++ks) { v4u q; q.x = pk2(X[2 * ks][0], X[2 * ks][1]); q.y = pk2(X[2 * ks][2], X[2 * ks][3]); q.z = pk2(X[2 * ks + 1][0], X[2 * ks + 1][1]); q.w = pk2(X[2 * ks + 1][2], X[2 * ks + 1][3]); xb[ks] = __builtin_bit_cast(bf16x8, q); }
#pragma unroll
            for (int tt = 0; tt < 4; ++tt)
#pragma unroll
                for (int ks = 0; ks < 2; ++ks) { const LAS unsigned char* rp_ = lds + pa + (16 * tt + fr) * OPS + (32 * ks + 4 * fq) * 2;
                    const u32x2v p0 = *(const LAS u32x2v*)rp_, p1 = *(const LAS u32x2v*)(rp_ + 32); const v4u pq = {p0.x, p0.y, p1.x, p1.y};
                    X[tt] = MFMA16(__builtin_bit_cast(bf16x8, pq), xb[ks], X[tt]); }
            if (k < 5) {
                const int tt = w & 3;
#pragma unroll
                for (int cc = 0; cc < 2; ++cc) { const int ct = 2 * (w >> 2) + cc; f32x4 acc = {0.f, 0.f, 0.f, 0.f};
                    acc = MFMA16(FRAG(pa, 16 * tt + fr, 0), FRAG(pt, 16 * ct + fr, 0), acc); acc = MFMA16(FRAG(pa, 16 * tt + fr, 1), FRAG(pt, 16 * ct + fr, 1), acc);
                    const int col = 16 * ct + fr, rowb = 16 * tt + 4 * fq; LAS unsigned short* PAn = (LAS unsigned short*)(lds + pan);
#pragma unroll
                    for (int j = 0; j < 4; ++j) PAn[(rowb + j) * 72 + col] = f2bf16(acc[j]);
                    u32x2v pk; pk.x = pk2(acc[0], acc[1]); pk.y = pk2(acc[2], acc[3]); *(LAS u32x2v*)(lds + ptn + col * OPS + rowb * 2) = pk; }
            }
            LDS_BARRIER();
        }
#pragma unroll
        for (int tt = 0; tt < 4; ++tt) { u32x2v pk; pk.x = pk2(X[tt][0], X[tt][1]); pk.y = pk2(X[tt][2], X[tt][3]); *(LAS u32x2v*)(lds + O_XT + (16 * w + fr) * OPS + (16 * tt + 4 * fq) * 2) = pk; }
    }
    LDS_BARRIER();
    if (docv) cvt_finish(cldA, ciA, lane);
#ifdef RW_REP_S7
    for (int rep_ = 0; rep_ < 2; ++rep_)
#endif
    {
        asm volatile("" ::: "memory");
        const int rt = w & 3; const size_t ub = (size_t)un * 4096;
        const LAS unsigned short* RTb = (const LAS unsigned short*)(lds + O_RT);
#pragma unroll
        for (int cc = 0; cc < 2; ++cc) { const int ct = 2 * (w >> 2) + cc;
            const bf16x8 arb0 = FRAG(O_ARB, 16 * rt + fr, 0), arb1 = FRAG(O_ARB, 16 * rt + fr, 1), ark0 = FRAG(O_ARK, 16 * rt + fr, 0), ark1 = FRAG(O_ARK, 16 * rt + fr, 1);
            const bf16x8 bht0 = FRAG(O_BHT, 16 * rt + fr, 0), bht1 = FRAG(O_BHT, 16 * rt + fr, 1), kht0 = FRAG(O_KHT, 16 * rt + fr, 0), kht1 = FRAG(O_KHT, 16 * rt + fr, 1);
            const bf16x8 xa0 = FRAG(O_XT, 16 * ct + fr, 0), xa1 = FRAG(O_XT, 16 * ct + fr, 1), xv0 = FRAG(O_XT, 64 + 16 * ct + fr, 0), xv1 = FRAG(O_XT, 64 + 16 * ct + fr, 1);
            const bf16x8 vt0 = FRAG(O_VT, 16 * ct + fr, 0), vt1 = FRAG(O_VT, 16 * ct + fr, 1);
            f32x4 z4 = {0.f, 0.f, 0.f, 0.f};
            f32x4 q = MFMA16(arb0, xa0, z4); q = MFMA16(arb1, xa1, q);
            f32x4 z = MFMA16(arb0, xv0, z4); z = MFMA16(arb1, xv1, z); z = MFMA16(ark0, vt0, z); z = MFMA16(ark1, vt1, z);
            f32x4 m = MFMA16(bht0, xa0, z4); m = MFMA16(bht1, xa1, m);
            f32x4 nn = MFMA16(bht0, xv0, z4); nn = MFMA16(bht1, xv1, nn); nn = MFMA16(kht0, vt0, nn); nn = MFMA16(kht1, vt1, nn);
            const int col = 16 * ct + fr;
            const int mks = col >> 5, mfq = (col & 15) >> 2, me = 4 * ((col >> 4) & 1) + (col & 3);
#pragma unroll
            for (int j = 0; j < 4; ++j) { const int row = 16 * rt + 4 * fq + j;
                P.Qc[ub + row * 64 + col] = f2bf16(q[j] + bf2f(RTb[row * 72 + col]));
                P.Mc[ub + (((rt * 2 + mks) * 64) + mfq * 16 + (row & 15)) * 8 + me] = f2bf16(m[j] + ((row == col) ? GAMC[row] : 0.f)); }
            { u32x2v pz; pz.x = pk2(z[0], z[1]); pz.y = pk2(z[2], z[3]);     *(u32x2v*)(P.ZT + ub + col * 64 + 16 * rt + 4 * fq) = pz; }
            { u32x2v pn; pn.x = pk2(nn[0], nn[1]); pn.y = pk2(nn[2], nn[3]); *(u32x2v*)(P.NT + ub + ((ct * 4 + rt) * 64 + lane) * 4) = pn; }
        }
    }
#undef FRAG
    LDS_BARRIER();
}

constexpr int CH_SLOT = 16384, CH_NSLOT = 9, CH_AHEAD = 7;
__device__ __forceinline__ void glds16(const void* gsrc, unsigned lds_dst) { unsigned keep;
    asm volatile("s_mov_b32 %0, m0\n\ts_mov_b32 m0, %2\n\ts_nop 0\n\tglobal_load_lds_dwordx4 %1, off\n\ts_mov_b32 m0, %0" : "=&s"(keep) : "v"(gsrc), "s"(lds_dst) : "memory"); }
__device__ __forceinline__ void chain(LAS unsigned char* lds, int bh, const bf16* Mc, const bf16* NT, bf16* SH, bf16* SL) {
    const int tid = threadIdx.x, lane = tid & 63, w = __builtin_amdgcn_readfirstlane(tid >> 6), fr = lane & 15, fq = lane >> 4;
    const unsigned lds0 = (unsigned)(uintptr_t)lds;
    if (w >= 4) {
        const int k = w - 4;
#define CH_ISSUE(cc) do { const size_t ub_ = (size_t)(bh * 64 + (cc)) * 4096; const unsigned sl_ = lds0 + (unsigned)(((cc) % CH_NSLOT) * CH_SLOT); \
            _Pragma("unroll") for (int i_ = 0; i_ < 4; ++i_) { const int p_ = k + 4 * i_; \
                const void* src_ = (p_ < 8) ? (const void*)(Mc + ub_ + p_ * 512 + lane * 8) : (const void*)(NT + ub_ + (p_ - 8) * 512 + lane * 8); \
                glds16(src_, (unsigned)__builtin_amdgcn_readfirstlane(sl_ + p_ * 1024)); } } while (0)
        for (int cc = 0; cc < CH_AHEAD; ++cc) CH_ISSUE(cc);
        for (int c = 0; c < 64; ++c) {
            if (c + CH_AHEAD < 64) CH_ISSUE(c + CH_AHEAD);
            const int left = 63 - c;
            if (left >= 7) asm volatile("s_waitcnt vmcnt(28)" ::: "memory"); else if (left == 6) asm volatile("s_waitcnt vmcnt(24)" ::: "memory"); else if (left == 5) asm volatile("s_waitcnt vmcnt(20)" ::: "memory");
            else if (left == 4) asm volatile("s_waitcnt vmcnt(16)" ::: "memory"); else if (left == 3) asm volatile("s_waitcnt vmcnt(12)" ::: "memory"); else if (left == 2) asm volatile("s_waitcnt vmcnt(8)" ::: "memory");
            else if (left == 1) asm volatile("s_waitcnt vmcnt(4)" ::: "memory"); else asm volatile("s_waitcnt vmcnt(0)" ::: "memory");
            __builtin_amdgcn_s_barrier();
        }
#undef CH_ISSUE
    } else {
        const int vq = w;
        f32x4 S[4];
#pragma unroll
        for (int i = 0; i < 4; ++i) S[i] = (f32x4){0.f, 0.f, 0.f, 0.f};
        for (int c = 0; c < 64; ++c) {
            __builtin_amdgcn_s_barrier(); asm volatile("" ::: "memory");
            const LAS unsigned char* sl = lds + (c % CH_NSLOT) * CH_SLOT;
            const size_t ub = (size_t)(bh * 64 + c) * 4096;
            bf16x8 bh_[2], bl_[2];
#pragma unroll
            for (int ks = 0; ks < 2; ++ks) { float hi8[8], lo8[8];
#pragma unroll
                for (int e = 0; e < 8; ++e) { const float s = S[2 * ks + (e >> 2)][e & 3]; const float hh = bf2f(f2bf16(s)); hi8[e] = hh; lo8[e] = s - hh; }
                const v4u ph = pack8(hi8), pl = pack8(lo8); bh_[ks] = __builtin_bit_cast(bf16x8, ph); bl_[ks] = __builtin_bit_cast(bf16x8, pl);
                const size_t o = ub + (size_t)((vq * 2 + ks) * 64 + lane) * 8;
                *(v4u*)(SH + o) = ph; *(v4u*)(SL + o) = pl; }
#pragma unroll
            for (int mt = 0; mt < 4; ++mt) {
                const bf16x8 a0 = *(const LAS bf16x8*)(sl + ((mt * 2 + 0) * 64 + lane) * 16), a1 = *(const LAS bf16x8*)(sl + ((mt * 2 + 1) * 64 + lane) * 16);
                const u32x2v nw = *(const LAS u32x2v*)(sl + 8192 + ((vq * 4 + mt) * 64 + lane) * 8);
                f32x4 sn = {__uint_as_float(nw.x << 16), __uint_as_float(nw.x & 0xffff0000u), __uint_as_float(nw.y << 16), __uint_as_float(nw.y & 0xffff0000u)};
                sn = MFMA16(a0, bh_[0], sn); sn = MFMA16(a1, bh_[1], sn); sn = MFMA16(a0, bl_[0], sn); sn = MFMA16(a1, bl_[1], sn);
                S[mt] = sn;
            }
        }
    }
}
__device__ __forceinline__ void yout(int un, int tt, int lane, const bf16* Qc, const bf16* ZT, const bf16* SH, const bf16* SL, const bf16* G, const bf16* Bonus, const float* gnw, const float* gnb, bf16* MIX) {
    const int fr = lane & 15, fq = lane >> 4; const int b = un >> 9, h = (un >> 6) & 7, c = un & 63; const size_t ub = (size_t)un * 4096;
    bf16x8 qf[2];
#pragma unroll
    for (int ks = 0; ks < 2; ++ks) { const bf16* qp = Qc + ub + (16 * tt + fr) * 64 + 32 * ks + 4 * fq; const u32x2v q0 = *(const u32x2v*)qp, q1 = *(const u32x2v*)(qp + 16);
        const v4u qq = {q0.x, q0.y, q1.x, q1.y}; qf[ks] = __builtin_bit_cast(bf16x8, qq); }
    f32x4 y[4];
#pragma unroll
    for (int vt = 0; vt < 4; ++vt) { const u32x2v zw = *(const u32x2v*)(ZT + ub + (16 * vt + fr) * 64 + 16 * tt + 4 * fq);
        f32x4 acc = {__uint_as_float(zw.x << 16), __uint_as_float(zw.x & 0xffff0000u), __uint_as_float(zw.y << 16), __uint_as_float(zw.y & 0xffff0000u)};
#pragma unroll
        for (int ks = 0; ks < 2; ++ks) { const size_t o = ub + (size_t)((vt * 2 + ks) * 64 + lane) * 8;
            acc = MFMA16(qf[ks], *(const bf16x8*)(SH + o), acc); acc = MFMA16(qf[ks], *(const bf16x8*)(SL + o), acc); }
        y[vt] = acc; }
    const size_t tokb = (size_t)(b * SEQ + c * 64 + 16 * tt + 4 * fq);
#pragma unroll
    for (int j = 0; j < 4; ++j) {
        float s = (y[0][j] + y[1][j]) + (y[2][j] + y[3][j]);
        s += __shfl_xor(s, 1); s += __shfl_xor(s, 2); s += __shfl_xor(s, 4); s += __shfl_xor(s, 8);
        const float mean = s * (1.f / 64.f); float d[4], s2 = 0.f;
#pragma unroll
        for (int vt = 0; vt < 4; ++vt) { d[vt] = y[vt][j] - mean; s2 += d[vt] * d[vt]; }
        s2 += __shfl_xor(s2, 1); s2 += __shfl_xor(s2, 2); s2 += __shfl_xor(s2, 4); s2 += __shfl_xor(s2, 8);
        const float rstd = rsqrtf(s2 * (1.f / 64.f) + GN_EPS);
#pragma unroll
        for (int vt = 0; vt < 4; ++vt) { const int ch = h * 64 + 16 * vt + fr; const size_t o = (tokb + j) * RWW + ch;
            const float val = (d[vt] * rstd * gnw[ch] + gnb[ch] + bf2f(Bonus[o])) * bf2f(G[o]);
            MIX[(tokb + j) * D + ch] = f2bf16(val); }
    }
}
}

struct Args { const float* in[29]; float* out; unsigned char* ws; int ph_lo, ph_hi; };
enum { I_X = 0, I_LNINW, I_LNINB, I_WIN, I_MU, I_W0, I_W2, I_A0, I_A2, I_G2, I_KK, I_KA, I_RK, I_GNW, I_GNB, I_BF, I_QN, I_KN, I_WO, I_LN1W, I_LN1B, I_RW, I_RB, I_W1, I_B1, I_EW2, I_B2, I_LN2W, I_LN2B };
constexpr int N_PHASES = 11;

__device__ __forceinline__ int fresh_tid() { int t = threadIdx.x; asm volatile("" : "+v"(t)); return t; }
__global__ void __launch_bounds__(NTHR, 2) fwd_kernel(Args args) {
    extern __shared__ __attribute__((aligned(16))) unsigned char lds_raw[];
    LAS unsigned char* lds = (LAS unsigned char*)lds_raw;
    volatile LAS unsigned* MISC = (volatile LAS unsigned*)(lds + CTRL_OFF + LC_MISC);
    const int tid = threadIdx.x, lane = tid & 63, wave = __builtin_amdgcn_readfirstlane(tid >> 6);
    const int G = gridDim.x, bx = blockIdx.x;
    const int gw = bx * NWAVES + wave, NGW = G * NWAVES;
    unsigned char* ws = args.ws;
    gu32* ctl = (gu32*)(ws + WS_CTL);
    for (int u = tid; u < (LDS_BYTES - CTRL_OFF) / 4; u += NTHR) ((LAS unsigned*)(lds + CTRL_OFF))[u] = 0u;
    __syncthreads();
    const int lo = args.ph_lo, hi = args.ph_hi;
    const bool multi = (hi - lo) > 1;
    XcdBarrier bar; bar.bar = (unsigned*)(ctl + CW_BAR); bar.x = 0; bar.st = nullptr;
    if (multi) bar = xcd_barrier_post((unsigned*)(ctl + CW_BAR), MISC + 8);
#define IN(k) (lo <= (k) && (k) < hi)
#define SEAM(k) do { if (IN(k) && IN((k) + 1)) xcd_barrier(bar); } while (0)

    bf16* WIN_T = (bf16*)(ws + WS_WIN); bf16* WO_T = (bf16*)(ws + WS_WO); bf16* W1T = (bf16*)(ws + WS_W1T); bf16* W2T = (bf16*)(ws + WS_W2T);
    bf16* HB = (bf16*)(ws + WS_HB); float* HF = (float*)(ws + WS_HF); bf16* PROJ = (bf16*)(ws + WS_PROJ); float* DEAD = (float*)(ws + WS_PROJ + 128 * MiB);
    bf16* GB = (bf16*)(ws + WS_G); bf16* BONUS = (bf16*)(ws + WS_BONUS);
    bf16* QB = (bf16*)(ws + WS_QB); bf16* KB = (bf16*)(ws + WS_KB); bf16* VB = (bf16*)(ws + WS_VB); bf16* MIX = (bf16*)(ws + WS_MIX);
    bf16* MC = (bf16*)(ws + WS_MC); bf16* NT = (bf16*)(ws + WS_NT); bf16* QC = (bf16*)(ws + WS_QC); bf16* ZT = (bf16*)(ws + WS_ZT); bf16* SH = (bf16*)(ws + WS_Y); bf16* SL = (bf16*)(ws + WS_Y + 16 * MiB);
    float* LOGF = (float*)(ws + WS_LOGF);
    int* AE = (int*)(ws + WS_AE); int* APOS = (int*)(ws + WS_APOS); float* AGATE = (float*)(ws + WS_AGATE); int* AROW = (int*)(ws + WS_AROW); float* ROWGATE = (float*)(ws + WS_ROWGATE); int* ROWTOK = (int*)(ws + WS_ROWTOK);
    bf16* XS = (bf16*)(ws + WS_XS); bf16* ACT = (bf16*)(ws + WS_ACT); bf16* EOUT = (bf16*)(ws + WS_EOUT);

    if (IN(0)) {
        const int tid = fresh_tid(), lane = tid & 63;
        LAS float* scr = (LAS float*)(lds + wave * 16384);
        constexpr int I_IN = 16 * 120, I_O = 16 * 32, I_1 = 16 * 64, I_2 = 16 * 32;
        constexpr int NITEMS = I_IN + I_O;
        for (int it = gw; it < NITEMS; it += NGW) {
            int r = it;
            if (r < I_IN) { transpose_item(args.in[I_WIN], D, IN_COLS, 120, WIN_T, scr, r, lane); continue; } r -= I_IN;
            transpose_item(args.in[I_WO], D, D, 32, WO_T, scr, r, lane);
        }
        for (int m = gw; m < M; m += NGW) { f32x4 v[4];
#pragma unroll
            for (int j = 0; j < 4; ++j) v[j] = *(const f32x4*)(args.in[I_X] + (size_t)m * D + 4 * lane + 256 * j);
            ln_finish(v, args.in[I_LNINW], args.in[I_LNINB], lane, nullptr, HB + (size_t)m * D); }
    }
    SEAM(0);
    if (IN(1)) {
        const int tid = fresh_tid(), lane = tid & 63;
        pg8::Gemm g{HB, WIN_T, M, PL, D}; pg8::StaticOrder S; S.init(M, PL, G, bx);
        pg8::EpiBf16 E{PROJ, PL};
        pg8::gemm_phase<pg8::EpiBf16, pg8::StaticOrder, true, true>(lds + RING_OFF, g, S, E);
    }
    SEAM(1);
    if (IN(2)) {
        const int tid = fresh_tid(), lane = tid & 63;
        rwk::Ptrs P{PROJ, args.in[I_MU], args.in[I_W0], args.in[I_W2], args.in[I_A0], args.in[I_A2], args.in[I_G2], args.in[I_KK], args.in[I_KA], args.in[I_RK], GB, BONUS, MC, NT, QC, ZT};
        {
            const FoxPtrs FX{PROJ, args.in[I_QN], args.in[I_KN], args.in[I_BF], QB, KB, VB, LOGF};
            const int h = bx & 7, ngrp = G >> 3; int idx = bx >> 3;
            if (idx < ngrp) {
                rwk::stage_weights(lds, h, P);
                rwk::Pre R0, R1;
#define RW_UN(i) ((((i) >> 6) * NH + h) * 64 + ((i) & 63))
                if (idx < BATCH * 64) rwk::prefetch(R0, RW_UN(idx), P, tid);
                const int nslot = (BATCH * 64 + ngrp - 1) / ngrp; int us = 0;
                for (; idx < BATCH * 64; idx += ngrp, ++us) { const int nx = idx + ngrp; const int it0 = ((bx * NWAVES + wave) * nslot + us) * 3;
                    const int fm = (bx * NWAVES + wave) * nslot + us;
                    const rwk::Cvt cv{args.in[I_W1], args.in[I_EW2], W1T, W2T, (it0 + 2 < NE * 1536) ? it0 : -1, &FX, (fm < M) ? fm : -1};
                    rwk::unit(lds, RW_UN(idx), P, R0, R1, nx < BATCH * 64, RW_UN(nx), cv); R0 = R1; }
#undef RW_UN
            }
            {
                const int ngrp2 = G >> 3, nslot = (ngrp2 > 0) ? (BATCH * 64 + ngrp2 - 1) / ngrp2 : 0; const int covered = (ngrp2 > 0 && (G & 7) == 0 && (BATCH * 64) % ngrp2 == 0) ? G * NWAVES * nslot * 3 : 0;
                for (int it = covered + gw; it < NE * 1536; it += NGW) { f32x4 cld[8]; const CvtItem ci = cvt_item(it, args.in[I_W1], args.in[I_EW2], W1T, W2T); cvt_load(cld, ci, lane); cvt_finish(cld, ci, lane); }
            }
        }
        {
            const FoxPtrs FX{PROJ, args.in[I_QN], args.in[I_KN], args.in[I_BF], QB, KB, VB, LOGF};
            const int ngrp2 = G >> 3, nslot = (ngrp2 > 0) ? (BATCH * 64 + ngrp2 - 1) / ngrp2 : 0; const int covered = (ngrp2 > 0 && (G & 7) == 0 && (BATCH * 64) % ngrp2 == 0) ? G * NWAVES * nslot : 0;
            for (int m = covered + gw; m < M; m += NGW) { FoxRow r; fox_load(r, FX, m, lane); fox_finish(r, FX, m, lane); }
        }
    }
    SEAM(2);
    if (IN(3) || lo == 100 || lo == 101) {
        const int tid = fresh_tid(), lane = tid & 63;
        if (bx < 32 && lo != 100) { rwk::chain(lds, bx, MC, NT, SH, SL); __syncthreads(); }
        if (lo != 101) {
            const attn_body::AttnTensors AT{(const attn_body::bf16*)QB, (const attn_body::bf16*)KB, (const attn_body::bf16*)VB, (attn_body::bf16*)(MIX + 512), LOGF, PROJ};
            attn_body::attn_phase<40>((char*)lds_raw + RING_OFF, AT, (unsigned*)(ctl + CW_ATTQ + (lo == 100 ? 32 : 0)), MISC + 16);
        }
    }
    SEAM(3);
    if (IN(4)) {
        const int tid = fresh_tid(), lane = tid & 63;
        for (int task = gw; task < BATCH * NH * 64 * 4; task += NGW) rwk::yout(task >> 2, task & 3, lane, QC, ZT, SH, SL, GB, BONUS, args.in[I_GNW], args.in[I_GNB], MIX);
    }
    SEAM(4);
    if (IN(5) || lo == 103) {
        const int tid = fresh_tid(), lane = tid & 63;
        pg8::Gemm g{MIX, WO_T, M, D, D}; pg8::StaticOrder S; S.init(M, D, G, bx);
        pg8::EpiResid E{HB, (lo == 103) ? DEAD : HF, D, ALPHA};
        pg8::gemm_phase<pg8::EpiResid, pg8::StaticOrder, true, true>(lds + RING_OFF, g, S, E);
    }
    SEAM(5);
    if (IN(6) || lo == 102) {
        const int tid = fresh_tid(), lane = tid & 63;
        const bool prb = (lo == 102);
        float* HFo = prb ? DEAD : HF; bf16* HBo = prb ? (bf16*)(ws + WS_PROJ + 64 * MiB) : HB;
        int* AEo = prb ? (int*)(ws + WS_PROJ + 100 * MiB) : AE; int* APOSo = prb ? (int*)(ws + WS_PROJ + 101 * MiB) : APOS; float* AGATEo = prb ? (float*)(ws + WS_PROJ + 102 * MiB) : AGATE;
        unsigned* ecnt = (unsigned*)(ctl + CW_ECNT) + (prb ? 64 : 0);
        constexpr int XRS = 2064, O_XH = 0, O_XLO = 16 * XRS, O_PARTL = 2 * 16 * XRS, O_LGT = O_PARTL + 8 * 2048;
        LAS float* PARTL = (LAS float*)(lds + O_PARTL); LAS float* LGT = (LAS float*)(lds + O_LGT);
        LAS unsigned* HIST = (LAS unsigned*)(lds + CTRL_OFF + LC_HIST); LAS unsigned* BASE = (LAS unsigned*)(lds + CTRL_OFF + LC_BASE);
        LAS int* RI_E = (LAS int*)(lds + CTRL_OFF + LC_ROWINFO); LAS int* RI_P = RI_E + 256; LAS float* RI_G = (LAS float*)(RI_P + 256);
        const float* rw = args.in[I_RW]; const float* rb = args.in[I_RB];
        const int fr = lane & 15, fq = lane >> 4;
        bf16x8 wh[2][4], wl[2][4];
#pragma unroll
        for (int et = 0; et < 2; ++et)
#pragma unroll
            for (int ks = 0; ks < 4; ++ks) { float hi[8], lo[8];
#pragma unroll
                for (int i = 0; i < 8; ++i) { const float v = rw[(size_t)(128 * wave + 32 * ks + 8 * fq + i) * NE + 16 * et + fr]; hi[i] = bf2f(f2bf16(v)); lo[i] = v - hi[i]; }
                const v4u ph = pack8(hi), pl = pack8(lo); wh[et][ks] = __builtin_bit_cast(bf16x8, ph); wl[et][ks] = __builtin_bit_cast(bf16x8, pl); }
        if (tid < NE) HIST[tid] = 0u;
        __syncthreads();
        for (int r0 = bx * 64; r0 < M; r0 += G * 64) {
            for (int g = 0; g < 4; ++g) {
                f32x4 v[2][4];
#pragma unroll
                for (int u = 0; u < 2; ++u)
#pragma unroll
                    for (int j = 0; j < 4; ++j) v[u][j] = *(const f32x4*)(HF + (size_t)(r0 + 16 * g + 2 * wave + u) * D + 4 * lane + 256 * j);
#pragma unroll
                for (int u = 0; u < 2; ++u) { const int rl = 2 * wave + u; const int m = r0 + 16 * g + rl;
                    ln_finish(v[u], args.in[I_LN1W], args.in[I_LN1B], lane, nullptr, HBo + (size_t)m * D);
#pragma unroll
                    for (int j = 0; j < 4; ++j) { float hi[4], lo[4];
#pragma unroll
                        for (int e = 0; e < 4; ++e) { hi[e] = bf2f(f2bf16(v[u][j][e])); lo[e] = v[u][j][e] - hi[e]; }
                        u32x2v ph, pl; ph.x = pk2(hi[0], hi[1]); ph.y = pk2(hi[2], hi[3]); pl.x = pk2(lo[0], lo[1]); pl.y = pk2(lo[2], lo[3]);
                        *(LAS u32x2v*)(lds + O_XH + rl * XRS + (4 * lane + 256 * j) * 2) = ph; *(LAS u32x2v*)(lds + O_XLO + rl * XRS + (4 * lane + 256 * j) * 2) = pl; } }
                __syncthreads();
                f32x4 acc[2] = {{0.f, 0.f, 0.f, 0.f}, {0.f, 0.f, 0.f, 0.f}};
#pragma unroll
                for (int ks = 0; ks < 4; ++ks) { const bf16x8 xh = *(const LAS bf16x8*)(lds + O_XH + fr * XRS + (128 * wave + 32 * ks + 8 * fq) * 2), xl = *(const LAS bf16x8*)(lds + O_XLO + fr * XRS + (128 * wave + 32 * ks + 8 * fq) * 2);
#pragma unroll
                    for (int et = 0; et < 2; ++et) { acc[et] = MFMA16(xh, wh[et][ks], acc[et]); acc[et] = MFMA16(xl, wh[et][ks], acc[et]); acc[et] = MFMA16(xh, wl[et][ks], acc[et]); } }
#pragma unroll
                for (int et = 0; et < 2; ++et)
#pragma unroll
                    for (int j = 0; j < 4; ++j) PARTL[wave * 512 + (4 * fq + j) * 32 + 16 * et + fr] = acc[et][j];
                __syncthreads();
                { const int row = tid >> 5, e = tid & 31; float s = rb[e];
#pragma unroll
                  for (int w8 = 0; w8 < 8; ++w8) s += PARTL[w8 * 512 + row * 32 + e];
                  LGT[e * 64 + 16 * g + row] = s; }
            }
            __syncthreads();
            if (wave == 0) {
                float t0 = -INFINITY, t1 = -INFINITY, t2 = -INFINITY, t3 = -INFINITY; int i0 = 0, i1 = 0, i2 = 0, i3 = 0;
#pragma unroll 8
                for (int e = 0; e < NE; ++e) { const float x = LGT[e * 64 + lane];
                    if (x > t3) { if (x > t2) { t3 = t2; i3 = i2; if (x > t1) { t2 = t1; i2 = i1; if (x > t0) { t1 = t0; i1 = i0; t0 = x; i0 = e; } else { t1 = x; i1 = e; } } else { t2 = x; i2 = e; } } else { t3 = x; i3 = e; } } }
                const float e1 = __expf(t1 - t0), e2 = __expf(t2 - t0), e3 = __expf(t3 - t0); const float inv = 1.f / (1.f + e1 + e2 + e3);
                const float gt[4] = {inv, e1 * inv, e2 * inv, e3 * inv}; const int ti[4] = {i0, i1, i2, i3};
#pragma unroll
                for (int j = 0; j < 4; ++j) { const unsigned p = __hip_atomic_fetch_add(HIST + ti[j], 1u, __ATOMIC_RELAXED, __HIP_MEMORY_SCOPE_WORKGROUP); RI_E[lane * 4 + j] = ti[j]; RI_P[lane * 4 + j] = (int)p; RI_G[lane * 4 + j] = gt[j]; }
            }
            __syncthreads();
            if (tid < NE) { BASE[tid] = __hip_atomic_fetch_add(ecnt + tid, HIST[tid], __ATOMIC_RELAXED, __HIP_MEMORY_SCOPE_AGENT); HIST[tid] = 0u; }
            __syncthreads();
            if (tid < 256) { const int e = RI_E[tid]; const size_t a = (size_t)r0 * 4 + tid; AEo[a] = e; APOSo[a] = (int)BASE[e] + RI_P[tid]; AGATEo[a] = RI_G[tid]; }
            __syncthreads();
        }
    }
    SEAM(6);
#define TILE_TABLE() do { if (tid < 64) { LAS int* TS = (LAS int*)(lds + CTRL_OFF + LC_TSTART); LAS unsigned char* TE = (LAS unsigned char*)(lds + CTRL_OFF + LC_TEXP); \
        const int cnt = (tid < NE) ? (int)__hip_atomic_load((unsigned*)(ctl + CW_ECNT) + tid, __ATOMIC_RELAXED, __HIP_MEMORY_SCOPE_AGENT) : 0; const int nt_ = (cnt + 255) >> 8; \
        int inc_ = nt_; _Pragma("unroll") for (int o_ = 1; o_ < 32; o_ <<= 1) { const int t_ = __shfl_up(inc_, o_); if ((tid & 63) >= o_) inc_ += t_; } \
        const int st_ = inc_ - nt_; if (tid < NE) { TS[tid] = st_; for (int k = 0; k < nt_; ++k) TE[st_ + k] = (unsigned char)tid; } if (tid == NE - 1) { MISC[17] = (unsigned)inc_; TS[NE] = inc_; } } __syncthreads(); } while (0)
    if (IN(7)) {
        const int tid = fresh_tid(), lane = tid & 63;
        TILE_TABLE();
        const LAS int* TS = (const LAS int*)(lds + CTRL_OFF + LC_TSTART);
        for (int a = bx * NTHR + tid; a < NASSIGN; a += G * NTHR) { const int e = AE[a], row = TS[e] * 256 + APOS[a]; ROWTOK[row] = a >> 2; ROWGATE[row] = AGATE[a]; AROW[a] = row; }
        for (int e = bx; e < NE; e += G) { const int cnt = (int)__hip_atomic_load((unsigned*)(ctl + CW_ECNT) + e, __ATOMIC_RELAXED, __HIP_MEMORY_SCOPE_AGENT); const int r0 = TS[e] * 256 + cnt, r1 = (TS[e] + ((cnt + 255) >> 8)) * 256;
            for (int r = r0 + tid; r < r1; r += NTHR) { ROWTOK[r] = 0; ROWGATE[r] = 0.f; } }
    }
    SEAM(7);
    if (IN(8)) {
        const int tid = fresh_tid(), lane = tid & 63;
        TILE_TABLE();
        LAS int* rowtab = (LAS int*)(lds + 131072);
        pg8::Gemm g{HB, W1T, XROWS, 2048, D}; pg8::MoeOrder<true> S{(const PG8_LAS unsigned char*)(lds + CTRL_OFF + LC_TEXP), (const PG8_LAS int*)(lds + CTRL_OFF + LC_TSTART), (int)MISC[17], 8, G, bx, rowtab};
        { pg8::Unit u; for (int i = 0; i < 28 && S.next(i, u); ++i) if (tid < 256) rowtab[i * 256 + tid] = ROWTOK[u.pm * 256 + tid]; }
        __syncthreads();
        pg8::EpiSwiglu E{ACT, D, args.in[I_B1]};
        pg8::gemm_phase<pg8::EpiSwiglu, pg8::MoeOrder<true>, true, true>(lds + RING_OFF, g, S, E);
    }
    SEAM(8);
    if (IN(9)) {
        const int tid = fresh_tid(), lane = tid & 63;
        TILE_TABLE();
        pg8::Gemm g{ACT, W2T, XROWS, D, D}; pg8::MoeOrder<false> S{(const PG8_LAS unsigned char*)(lds + CTRL_OFF + LC_TEXP), (const PG8_LAS int*)(lds + CTRL_OFF + LC_TSTART), (int)MISC[17], 4, G, bx, nullptr};
        pg8::EpiGate E{EOUT, D, args.in[I_B2], ROWGATE};
        pg8::gemm_phase<pg8::EpiGate, pg8::MoeOrder<false>, true, true>(lds + RING_OFF, g, S, E);
    }
    SEAM(9);
    if (IN(10)) {
        const int tid = fresh_tid(), lane = tid & 63;
        for (int m0 = gw; m0 < M; m0 += 2 * NGW) {
            int rows[2][4];
#pragma unroll
            for (int u = 0; u < 2; ++u)
#pragma unroll
                for (int s = 0; s < 4; ++s) rows[u][s] = AROW[(m0 + u * NGW) * 4 + s];
            u32x2v hw[2][4], ew[2][4][4];
#pragma unroll
            for (int u = 0; u < 2; ++u) {
#pragma unroll
                for (int j = 0; j < 4; ++j) hw[u][j] = *(const u32x2v*)(HB + (size_t)(m0 + u * NGW) * D + 4 * lane + 256 * j);
#pragma unroll
                for (int s = 0; s < 4; ++s)
#pragma unroll
                    for (int j = 0; j < 4; ++j) ew[u][s][j] = *(const u32x2v*)(EOUT + (size_t)rows[u][s] * D + 4 * lane + 256 * j); }
#pragma unroll
            for (int u = 0; u < 2; ++u) { f32x4 v[4];
#pragma unroll
                for (int j = 0; j < 4; ++j) { const u32x2v w = hw[u][j];
                    v[j] = (f32x4){__uint_as_float(w.x << 16), __uint_as_float(w.x & 0xffff0000u), __uint_as_float(w.y << 16), __uint_as_float(w.y & 0xffff0000u)} * ALPHA; }
#pragma unroll
                for (int s = 0; s < 4; ++s)
#pragma unroll
                    for (int j = 0; j < 4; ++j) { const u32x2v w = ew[u][s][j];
                        v[j].x += __uint_as_float(w.x << 16); v[j].y += __uint_as_float(w.x & 0xffff0000u); v[j].z += __uint_as_float(w.y << 16); v[j].w += __uint_as_float(w.y & 0xffff0000u); }
                ln_finish(v, args.in[I_LN2W], args.in[I_LN2B], lane, args.out + (size_t)(m0 + u * NGW) * D, nullptr); }
        }
    }
#undef IN
#undef SEAM
#undef TILE_TABLE
}

#ifndef MK_ONE_LAUNCH
#define MK_ONE_LAUNCH 1
#endif
extern "C" void kernel_launch(void* const* d_in, const int* in_sizes, int n_in, void* d_out, int out_size, void* d_ws, size_t ws_size, hipStream_t stream) {
    static int grid = 0;
    if (grid == 0) {
        if (n_in != 29 || in_sizes[0] != M * D || out_size != M * D || ws_size < WS_END) { fprintf(stderr, "kernel_launch: unexpected shapes (n_in %d, in0 %d, out %d, ws %zu); nothing launched\n", n_in, n_in > 0 ? in_sizes[0] : -1, out_size, ws_size); grid = -1; return; }
        int dev = 0, cus = 0, per_cu = 0;
        if (hipGetDevice(&dev) != hipSuccess || hipDeviceGetAttribute(&cus, hipDeviceAttributeMultiprocessorCount, dev) != hipSuccess) { grid = -1; return; }
        if (hipFuncSetAttribute((const void*)fwd_kernel, hipFuncAttributeMaxDynamicSharedMemorySize, LDS_BYTES) != hipSuccess) { fprintf(stderr, "kernel_launch: hipFuncSetAttribute failed\n"); grid = -1; return; }
        if (hipOccupancyMaxActiveBlocksPerMultiprocessor(&per_cu, (const void*)fwd_kernel, NTHR, LDS_BYTES) != hipSuccess || per_cu < 1) fprintf(stderr, "kernel_launch: occupancy query reports %d\n", per_cu);
        (void)hipGetLastError();
        grid = cus;
        if (grid < 32) { grid = -1; return; }
    }
    if (grid < 0) return;
    if (hipMemsetAsync((char*)d_ws + WS_CTL, 0, CTL_ZERO_BYTES, stream) != hipSuccess) return;
    Args a{};
    for (int i = 0; i < 29; ++i) a.in[i] = (const float*)d_in[i];
    a.out = (float*)d_out; a.ws = (unsigned char*)d_ws;
#if MK_ONE_LAUNCH
    a.ph_lo = 0; a.ph_hi = N_PHASES;
    hipLaunchKernelGGL(fwd_kernel, dim3(grid), dim3(NTHR), LDS_BYTES, stream, a);
#else
    for (int p = 0; p < N_PHASES; ++p) {
#ifdef PROBE_REP
        if (p == PROBE_REP && (p == 5 || p == 6)) { a.ph_lo = (p == 5) ? 103 : 102; a.ph_hi = a.ph_lo + 1; hipLaunchKernelGGL(fwd_kernel, dim3(grid), dim3(NTHR), LDS_BYTES, stream, a); }
#endif
        a.ph_lo = p; a.ph_hi = p + 1; hipLaunchKernelGGL(fwd_kernel, dim3(grid), dim3(NTHR), LDS_BYTES, stream, a);
#ifdef PROBE_REP
        if (p == PROBE_REP && p != 5 && p != 6) { if (p == 3) { a.ph_lo = PROBE_P3; a.ph_hi = PROBE_P3 + 1; } hipLaunchKernelGGL(fwd_kernel, dim3(grid), dim3(NTHR), LDS_BYTES, stream, a); }
#endif
    }
#endif
}
```

```cpp
#include <hip/hip_runtime.h>
#include <hip/hip_bf16.h>
#include <cstdio>
#include <cstdint>
#include <cmath>

namespace pg8 {
#define PG8_LAS __attribute__((address_space(3)))
typedef unsigned short bf16_t;
typedef short bf16x8 __attribute__((ext_vector_type(8)));
typedef float f32x4 __attribute__((ext_vector_type(4)));
typedef unsigned u32x4 __attribute__((ext_vector_type(4)));
typedef unsigned u32x2 __attribute__((ext_vector_type(2)));
constexpr int BM = 256, BK = 64, HALF = 128, HTB = HALF * BK * 2  , STAGE_BYTES = 8 * HTB, NXCD = 8, WGM = 8;

__host__ __device__ __forceinline__ int lds_byte(int r, int c) { const int st = (r >> 4) * 2 + (c >> 5), rr = r & 15, cc = c & 31, ob = rr * 64 + cc * 2; return st * 1024 + (ob ^ (((ob >> 9) & 1) << 5)); }
__host__ __device__ __forceinline__ void stage_rc(int b, int& R, int& C) { const int st = b / 1024, sb = b % 1024, swz = sb ^ (((sb >> 9) & 1) << 5); R = (st >> 1) * 16 + swz / 64; C = (st & 1) * 32 + (swz % 64) / 2; }
__host__ __device__ __forceinline__ int perm32(int rho) { const int n = rho >> 4, i = rho & 15; return 8 * (i >> 2) + 4 * n + (i & 3); }

struct Unit { int pm, pn, pb, pe; };
struct Gemm { const bf16_t* A; const bf16_t* Bt; int M, N, K; };

struct StaticOrder {
    static constexpr bool GATHER = false, PREFETCH_B = false;
    __device__ __forceinline__ int arow(int, int) const { return 0; }
    int nM, nN, nwg, G, c;
    __host__ __device__ void init(int M, int N, int G_, int c_) { nM = M / BM; nN = N / BM; nwg = nM * nN; G = G_; c = c_; }
    __host__ __device__ bool next(int i, Unit& u) const {
        const long L = (long)i * G + c; if (L >= nwg) return false;
        int wgid = (int)L; { const int q = nwg / NXCD, r = nwg % NXCD, xcd = wgid % NXCD, off = wgid / NXCD; wgid = (xcd < r ? xcd * (q + 1) : r * (q + 1) + (xcd - r) * q) + off; }
        const int nig = WGM * nN, gid = wgid / nig, fm = gid * WGM, gsz = (nM - fm) < WGM ? (nM - fm) : WGM;
        u.pm = fm + ((wgid % nig) % gsz); u.pn = (wgid % nig) / gsz; u.pb = u.pn; u.pe = 0; return true;
    }
};
template <bool GATHER_> struct MoeOrder {
    static constexpr bool GATHER = GATHER_, PREFETCH_B = false;
    const PG8_LAS unsigned char* texp; const PG8_LAS int* ts; int ntiles, nN, G, c; const PG8_LAS int* rowtab;
    __device__ __forceinline__ int arow(int ui, int r) const { return rowtab[ui * 256 + r]; }
    __device__ __forceinline__ bool next(int i, Unit& u) const {
        int rt, pn;
        if ((G & 7) == 0) { const int x = c & 7, ng = G >> 3, t0 = (x * ntiles) >> 3, t1 = ((x + 1) * ntiles) >> 3; const int k = i * ng + (c >> 3); if (k >= (t1 - t0) * nN) return false; rt = t0 + k / nN; pn = k - (k / nN) * nN; }
        else { const int L = i * G + c; if (L >= ntiles * nN) return false; rt = L / nN; pn = L - rt * nN; }
        const int e = texp[rt];
        u.pm = rt; u.pn = pn; u.pb = e * nN + pn; u.pe = e; return true;
    }
};

typedef float f32x2c_ __attribute__((ext_vector_type(2))); typedef __bf16 bf16x2c_ __attribute__((ext_vector_type(2)));
__device__ __forceinline__ unsigned cvt_pk_bf16(float lo, float hi) { const f32x2c_ v = {lo, hi}; const bf16x2c_ b = __builtin_convertvector(v, bf16x2c_); return __builtin_bit_cast(unsigned, b); }

struct EpiF32 {
    static constexpr bool PERM = false;
    float* O; int ldc;
    __device__ __forceinline__ void operator()(const f32x4 (&acc)[2][2][4][2], const Unit& u, int wr, int wc, int fr, int fq) const {
        const int row0 = u.pm * BM + wr * 64 + fr, col0 = u.pn * BM + wc * 32 + 4 * fq;
#pragma unroll
        for (int ai = 0; ai < 2; ++ai)
#pragma unroll
            for (int m = 0; m < 4; ++m) { float* rowp = O + (size_t)(row0 + ai * HALF + m * 16) * ldc + col0;
#pragma unroll
                for (int bj = 0; bj < 2; ++bj)
#pragma unroll
                    for (int n = 0; n < 2; ++n) *(f32x4*)(rowp + bj * HALF + n * 16) = acc[ai][bj][m][n]; }
    }
};
struct EpiBf16 {
    static constexpr bool PERM = true;
    bf16_t* O; int ldc;
    __device__ __forceinline__ void operator()(const f32x4 (&acc)[2][2][4][2], const Unit& u, int wr, int wc, int fr, int fq) const {
        const int row0 = u.pm * BM + wr * 64 + fr, col0 = u.pn * BM + wc * 32 + 8 * fq;
#pragma unroll
        for (int ai = 0; ai < 2; ++ai)
#pragma unroll
            for (int m = 0; m < 4; ++m) { bf16_t* rowp = O + (size_t)(row0 + ai * HALF + m * 16) * ldc + col0;
#pragma unroll
                for (int bj = 0; bj < 2; ++bj) { const f32x4 v0 = acc[ai][bj][m][0], v1 = acc[ai][bj][m][1];
                    u32x4 w; w.x = cvt_pk_bf16(v0[0], v0[1]); w.y = cvt_pk_bf16(v0[2], v0[3]); w.z = cvt_pk_bf16(v1[0], v1[1]); w.w = cvt_pk_bf16(v1[2], v1[3]);
                    *(u32x4*)(rowp + bj * HALF) = w; } }
    }
};
struct EpiResid {
    static constexpr bool PERM = false;
    const bf16_t* I; float* O; int ldc; float alpha;
    __device__ __forceinline__ void operator()(const f32x4 (&acc)[2][2][4][2], const Unit& u, int wr, int wc, int fr, int fq) const {
        const int row0 = u.pm * BM + wr * 64 + fr, col0 = u.pn * BM + wc * 32 + 4 * fq;
#pragma unroll
        for (int ai = 0; ai < 2; ++ai)
#pragma unroll
            for (int m = 0; m < 4; ++m) { const size_t ro = (size_t)(row0 + ai * HALF + m * 16) * ldc + col0;
#pragma unroll
                for (int bj = 0; bj < 2; ++bj)
#pragma unroll
                    for (int n = 0; n < 2; ++n) { const u32x2 w = *(const u32x2*)(I + ro + bj * HALF + n * 16); const f32x4 o = {__uint_as_float(w.x << 16), __uint_as_float(w.x & 0xffff0000u), __uint_as_float(w.y << 16), __uint_as_float(w.y & 0xffff0000u)};
                        *(f32x4*)(O + ro + bj * HALF + n * 16) = o * alpha + acc[ai][bj][m][n]; } }
    }
};
__device__ __forceinline__ float swiglu1(float g, float l) {
    g = fminf(g, 7.0f); l = fminf(fmaxf(l, -7.0f), 7.0f);
    const float s = __builtin_amdgcn_rcpf(1.0f + __builtin_amdgcn_exp2f(-1.702f * 1.4426950408889634f * g));
    return g * s * (l + 1.0f);
}
struct EpiSwiglu {
    static constexpr bool PERM = true;
    bf16_t* O; int ldc; const float* b1;
    __device__ __forceinline__ void operator()(const f32x4 (&acc)[2][2][4][2], const Unit& u, int wr, int wc, int fr, int fq) const {
        const int row0 = u.pm * BM + wr * 64 + fr; const int cl0 = u.pn * BM + wc * 32 + 8 * fq;
        const float* bp = b1 + (size_t)u.pe * 2048 + cl0;
        f32x4 bv[2][2];
#pragma unroll
        for (int bj = 0; bj < 2; ++bj)
#pragma unroll
            for (int n = 0; n < 2; ++n) bv[bj][n] = *(const f32x4*)(bp + bj * HALF + 4 * n);
        const bool odd = (fq & 1) != 0; const int oc = (u.pn * BM + wc * 32) / 2 + 4 * (fq & ~1) + (odd ? HALF / 2 : 0);
#pragma unroll
        for (int ai = 0; ai < 2; ++ai)
#pragma unroll
            for (int m = 0; m < 4; ++m) { u32x2 w[2];
#pragma unroll
                for (int bj = 0; bj < 2; ++bj) { const f32x4 v0 = acc[ai][bj][m][0] + bv[bj][0], v1 = acc[ai][bj][m][1] + bv[bj][1];
                    w[bj].x = cvt_pk_bf16(swiglu1(v0[0], v0[1]), swiglu1(v0[2], v0[3])); w[bj].y = cvt_pk_bf16(swiglu1(v1[0], v1[1]), swiglu1(v1[2], v1[3])); }
                const u32x2 snd = odd ? w[0] : w[1]; u32x2 rcv; rcv.x = (unsigned)__shfl_xor((int)snd.x, 16); rcv.y = (unsigned)__shfl_xor((int)snd.y, 16);
                const u32x4 o = odd ? (u32x4){rcv.x, rcv.y, w[1].x, w[1].y} : (u32x4){w[0].x, w[0].y, rcv.x, rcv.y};
                *(u32x4*)(O + (size_t)(row0 + ai * HALF + m * 16) * ldc + oc) = o; }
    }
};
struct EpiGate {
    static constexpr bool PERM = true;
    bf16_t* O; int ldc; const float* b2; const float* gate;
    __device__ __forceinline__ void operator()(const f32x4 (&acc)[2][2][4][2], const Unit& u, int wr, int wc, int fr, int fq) const {
        const int row0 = u.pm * BM + wr * 64 + fr; const int col0 = u.pn * BM + wc * 32 + 8 * fq;
        const float* bp = b2 + (size_t)u.pe * 1024 + col0;
        f32x4 bv[2][2];
#pragma unroll
        for (int bj = 0; bj < 2; ++bj)
#pragma unroll
            for (int n = 0; n < 2; ++n) bv[bj][n] = *(const f32x4*)(bp + bj * HALF + 4 * n);
#pragma unroll
        for (int ai = 0; ai < 2; ++ai)
#pragma unroll
            for (int m = 0; m < 4; ++m) { const int row = row0 + ai * HALF + m * 16; const float gt = gate[row]; bf16_t* rowp = O + (size_t)row * ldc + col0;
#pragma unroll
                for (int bj = 0; bj < 2; ++bj) { const f32x4 v0 = (acc[ai][bj][m][0] + bv[bj][0]) * gt, v1 = (acc[ai][bj][m][1] + bv[bj][1]) * gt;
                    u32x4 w; w.x = cvt_pk_bf16(v0[0], v0[1]); w.y = cvt_pk_bf16(v0[2], v0[3]); w.z = cvt_pk_bf16(v1[0], v1[1]); w.w = cvt_pk_bf16(v1[2], v1[3]);
                    *(u32x4*)(rowp + bj * HALF) = w; } }
    }
};
struct NoSide { __device__ __forceinline__ void pre(const Unit&) {} __device__ __forceinline__ void post(const Unit&) {} };
template <class Epi, class Sched, bool ALIGN_EPI, bool SP2, class Side>
__device__ __forceinline__ void gemm_phase(PG8_LAS unsigned char* lds, const Gemm g, const Sched& S, const Epi& E, Side& side) {
    const int tid = threadIdx.x, wid = __builtin_amdgcn_readfirstlane(tid >> 6), lane = tid & 63, wr = wid >> 2, wc = wid & 3, fr = lane & 15, fq = lane >> 4;
    const int K = g.K, nt = K / BK;
    unsigned voffA[2], voffB[2]; int RA[2];
#pragma unroll
    for (int i = 0; i < 2; ++i) { int R, C; stage_rc(tid * 16 + i * 8192, R, C); const int Rb = Epi::PERM ? ((R & ~31) + perm32(R & 31)) : R; RA[i] = R;
        voffA[i] = (unsigned)(R * K + C) * 2u; voffB[i] = (unsigned)(Rb * K + C) * 2u; }
    unsigned vA[2][2], vAn[2][2];
#define PG8_AOFF(dst, UI) do { _Pragma("unroll") for (int h_ = 0; h_ < 2; ++h_) _Pragma("unroll") for (int i_ = 0; i_ < 2; ++i_) \
        dst[h_][i_] = Sched::GATHER ? ((unsigned)S.arow((UI), h_ * HALF + RA[i_]) * (unsigned)(K * 2) + (voffA[i_] - (unsigned)(RA[i_] * K) * 2u)) : (voffA[i_] + (unsigned)h_ * (unsigned)(HALF * K * 2)); } while (0)
    const size_t kstep = (size_t)(BK * 2);
    const size_t hstep = (size_t)HALF * K * 2;
    const size_t tstep = 2 * hstep;
    const unsigned ldsw = (unsigned)wid * 1024u;
    const int aoff = lds_byte(wr * 64 + fr, fq * 8), boff = lds_byte(wc * 32 + fr, fq * 8);
#define PG8_SA(b, h) (((b) * 2 + (h)) * HTB)
#define PG8_SB(b, h) ((4 + (b) * 2 + (h)) * HTB)
#define PG8_STAGE(bufoff, gbase, voff) do { _Pragma("unroll") for (int _i = 0; _i < 2; ++_i) \
        __builtin_amdgcn_global_load_lds((const unsigned*)((const char*)(gbase) + (voff)[_i]), (PG8_LAS unsigned*)(lds + (bufoff) + ldsw + _i * 8192), 16, 0, 0); } while (0)
#define PG8_LDA(dst, b, h) do { _Pragma("unroll") for (int m = 0; m < 4; ++m) _Pragma("unroll") for (int k = 0; k < 2; ++k) dst[m][k] = *(const PG8_LAS bf16x8*)(lds + PG8_SA(b, h) + aoff + m * 2048 + k * 1024); } while (0)
#define PG8_LDB(dst, b, h) do { _Pragma("unroll") for (int n = 0; n < 2; ++n) _Pragma("unroll") for (int k = 0; k < 2; ++k) dst[n][k] = *(const PG8_LAS bf16x8*)(lds + PG8_SB(b, h) + boff + n * 2048 + k * 1024); } while (0)
#define PG8_MMA(ai, bj, At, Bt) do { __builtin_amdgcn_s_setprio(1); _Pragma("unroll") for (int m = 0; m < 4; ++m) _Pragma("unroll") for (int n = 0; n < 2; ++n) _Pragma("unroll") for (int k = 0; k < 2; ++k) \
        acc[ai][bj][m][n] = __builtin_amdgcn_mfma_f32_16x16x32_bf16(Bt[n][k], At[m][k], acc[ai][bj][m][n], 0, 0, 0); __builtin_amdgcn_s_setprio(0); } while (0)
#define PG8_WAIT_V(n) asm volatile("s_waitcnt vmcnt(" #n ")" ::: "memory")
#define PG8_WAIT_L(n) asm volatile("s_waitcnt lgkmcnt(" #n ")" ::: "memory")
#define PG8_BAR __builtin_amdgcn_s_barrier()
#define PG8_SCHED __builtin_amdgcn_sched_barrier(0)
    Unit cur, nxt; int ui = 0; unsigned pfd = 0u;
    if (!S.next(0, cur)) return;
    f32x4 acc[2][2][4][2];
#pragma unroll
    for (int a = 0; a < 2; ++a)
#pragma unroll
        for (int b = 0; b < 2; ++b)
#pragma unroll
            for (int m = 0; m < 4; ++m)
#pragma unroll
                for (int n = 0; n < 2; ++n) acc[a][b][m][n] = (f32x4){0.f, 0.f, 0.f, 0.f};
    bf16x8 At[4][2], B0[2][2], B1[2][2];
    const char* cA = (const char*)g.A + (Sched::GATHER ? (size_t)0 : (size_t)cur.pm * tstep); const char* cB = (const char*)g.Bt + (size_t)cur.pb * tstep;
    PG8_AOFF(vA, 0);
    if constexpr (SP2) {
        PG8_STAGE(PG8_SB(0, 0), cB, voffB); PG8_STAGE(PG8_SB(0, 1), cB + hstep, voffB); PG8_STAGE(PG8_SA(0, 0), cA, vA[0]); PG8_STAGE(PG8_SA(0, 1), cA, vA[1]);
        if (wr == 1) PG8_BAR;
        PG8_WAIT_V(2); PG8_BAR;
        PG8_STAGE(PG8_SB(1, 0), cB + kstep, voffB); PG8_STAGE(PG8_SA(1, 0), cA + kstep, vA[0]); PG8_STAGE(PG8_SB(1, 1), cB + hstep + kstep, voffB);
        PG8_WAIT_V(6); PG8_BAR;
    } else {
        PG8_STAGE(PG8_SB(0, 0), cB, voffB); PG8_STAGE(PG8_SA(0, 0), cA, vA[0]); PG8_STAGE(PG8_SB(0, 1), cB + hstep, voffB); PG8_STAGE(PG8_SA(0, 1), cA, vA[1]);
        if (wr == 1) PG8_BAR;
        PG8_WAIT_V(4); PG8_BAR;
        PG8_STAGE(PG8_SB(1, 0), cB + kstep, voffB); PG8_STAGE(PG8_SA(1, 0), cA + kstep, vA[0]); PG8_STAGE(PG8_SB(1, 1), cB + hstep + kstep, voffB);
        PG8_WAIT_V(6); PG8_BAR;
    }
    for (;;) {
        const bool has_next = S.next(ui + 1, nxt);
        if (has_next) PG8_AOFF(vAn, ui + 1); else { vAn[0][0] = vA[0][0]; vAn[0][1] = vA[0][1]; vAn[1][0] = vA[1][0]; vAn[1][1] = vA[1][1]; }
        const char* nA = has_next ? (const char*)g.A + (Sched::GATHER ? (size_t)0 : (size_t)nxt.pm * tstep) : cA;
        if constexpr (Sched::PREFETCH_B) {
            if (has_next && nxt.pb != cur.pb) { const char* pfb = (const char*)g.Bt + (size_t)nxt.pb * tstep + (size_t)tid * 128;
#pragma unroll
                for (int j_ = 0; j_ < 8; ++j_) asm volatile("global_load_dword %0, %1, off" : "+v"(pfd) : "v"(pfb + (size_t)j_ * 65536) : "memory"); } } const char* nB = has_next ? (const char*)g.Bt + (size_t)nxt.pb * tstep : cB;
        for (int t = 0; t < nt; t += 2) {
            const bool last = (t == nt - 2);
            const char* a1 = cA + (size_t)(t + 1) * kstep;
            const char* a2 = last ? nA : cA + (size_t)(t + 2) * kstep; const char* b2 = last ? nB : cB + (size_t)(t + 2) * kstep;
            const char* a3 = a2 + kstep; const char* b3 = b2 + kstep;
            unsigned vS[2][2]; vS[0][0] = last ? vAn[0][0] : vA[0][0]; vS[0][1] = last ? vAn[0][1] : vA[0][1]; vS[1][0] = last ? vAn[1][0] : vA[1][0]; vS[1][1] = last ? vAn[1][1] : vA[1][1];

            if constexpr (SP2) {
            PG8_LDB(B0, 0, 0); PG8_LDB(B1, 0, 1); PG8_SCHED; PG8_LDA(At, 0, 0); PG8_STAGE(PG8_SA(1, 1), a1, vA[1]);
            PG8_WAIT_V(8); PG8_WAIT_L(0); PG8_BAR; PG8_MMA(0, 0, At, B0); PG8_MMA(0, 1, At, B1); PG8_BAR; PG8_SCHED;
            PG8_LDA(At, 0, 1); PG8_STAGE(PG8_SB(0, 0), b2, voffB); PG8_STAGE(PG8_SB(0, 1), b2 + hstep, voffB); PG8_STAGE(PG8_SA(0, 0), a2, vS[0]);
            PG8_WAIT_V(8); PG8_WAIT_L(0); PG8_BAR; PG8_MMA(1, 0, At, B0); PG8_MMA(1, 1, At, B1); PG8_BAR; PG8_SCHED;
            PG8_LDB(B0, 1, 0); PG8_LDB(B1, 1, 1); PG8_SCHED; PG8_LDA(At, 1, 0); PG8_STAGE(PG8_SA(0, 1), a2, vS[1]);
            PG8_WAIT_V(8); PG8_WAIT_L(0); PG8_BAR; PG8_MMA(0, 0, At, B0); PG8_MMA(0, 1, At, B1); PG8_BAR; PG8_SCHED;
            PG8_LDA(At, 1, 1); PG8_STAGE(PG8_SB(1, 0), b3, voffB); PG8_STAGE(PG8_SB(1, 1), b3 + hstep, voffB); PG8_STAGE(PG8_SA(1, 0), a3, vS[0]);
            PG8_WAIT_V(8); PG8_WAIT_L(0); PG8_BAR; PG8_MMA(1, 0, At, B0); PG8_MMA(1, 1, At, B1); PG8_BAR; PG8_SCHED;
            } else {
            PG8_LDB(B0, 0, 0); PG8_SCHED; PG8_LDA(At, 0, 0); PG8_STAGE(PG8_SA(1, 1), a1, vA[1]);
            PG8_WAIT_L(8); PG8_BAR; PG8_WAIT_L(0); PG8_MMA(0, 0, At, B0); PG8_BAR; PG8_SCHED;
            PG8_LDB(B1, 0, 1); PG8_STAGE(PG8_SB(0, 0), b2, voffB);
            PG8_BAR; PG8_WAIT_L(0); PG8_MMA(0, 1, At, B1); PG8_BAR;
            PG8_LDA(At, 0, 1); PG8_STAGE(PG8_SA(0, 0), a2, vS[0]);
            PG8_BAR; PG8_WAIT_L(0); PG8_MMA(1, 0, At, B0); PG8_BAR; PG8_SCHED;
            PG8_STAGE(PG8_SB(0, 1), b2 + hstep, voffB);
            PG8_WAIT_V(6); PG8_BAR; PG8_MMA(1, 1, At, B1); PG8_BAR;
            PG8_LDB(B0, 1, 0); PG8_SCHED; PG8_LDA(At, 1, 0); PG8_STAGE(PG8_SA(0, 1), a2, vS[1]);
            PG8_WAIT_L(8); PG8_BAR; PG8_WAIT_L(0); PG8_MMA(0, 0, At, B0); PG8_BAR; PG8_SCHED;
            PG8_LDB(B1, 1, 1); PG8_STAGE(PG8_SB(1, 0), b3, voffB);
            PG8_BAR; PG8_WAIT_L(0); PG8_MMA(0, 1, At, B1); PG8_BAR;
            PG8_LDA(At, 1, 1); PG8_STAGE(PG8_SA(1, 0), a3, vS[0]);
            PG8_BAR; PG8_WAIT_L(0); PG8_MMA(1, 0, At, B0); PG8_BAR; PG8_SCHED;
            PG8_STAGE(PG8_SB(1, 1), b3 + hstep, voffB);
            PG8_WAIT_V(6); PG8_BAR; PG8_MMA(1, 1, At, B1); PG8_BAR;
            }
        }
        if constexpr (ALIGN_EPI) { if (wr == 0) PG8_BAR; }
        side.pre(cur); E(acc, cur, wr, wc, fr, fq); side.post(cur);
        if constexpr (Sched::PREFETCH_B) asm volatile("" : "+v"(pfd));
        if (!has_next) break;
#pragma unroll
        for (int a = 0; a < 2; ++a)
#pragma unroll
            for (int b = 0; b < 2; ++b)
#pragma unroll
                for (int m = 0; m < 4; ++m)
#pragma unroll
                    for (int n = 0; n < 2; ++n) acc[a][b][m][n] = (f32x4){0.f, 0.f, 0.f, 0.f};
        cur = nxt; cA = nA; cB = nB; ++ui; vA[0][0] = vAn[0][0]; vA[0][1] = vAn[0][1]; vA[1][0] = vAn[1][0]; vA[1][1] = vAn[1][1];
        if constexpr (ALIGN_EPI) { if (wr == 1) PG8_BAR; }
    }
    PG8_WAIT_V(0);
    if constexpr (!ALIGN_EPI) { if (wr == 0) PG8_BAR; }
    PG8_BAR;
#undef PG8_SA
#undef PG8_SB
#undef PG8_STAGE
#undef PG8_AOFF
#undef PG8_LDA
#undef PG8_LDB
#undef PG8_MMA
#undef PG8_WAIT_V
#undef PG8_WAIT_L
#undef PG8_BAR
#undef PG8_SCHED
}
template <class Epi, class Sched, bool ALIGN_EPI = false, bool SP2 = false>
__device__ __forceinline__ void gemm_phase(PG8_LAS unsigned char* lds, const Gemm g, const Sched& S, const Epi& E) { NoSide ns; gemm_phase<Epi, Sched, ALIGN_EPI, SP2, NoSide>(lds, g, S, E, ns); }
}
namespace attn_body {
using bf16=__hip_bfloat16;
using bf16x8=__attribute__((ext_vector_type(8)))short;
using s16x4=__attribute__((ext_vector_type(4)))short;
using f32x16=__attribute__((ext_vector_type(16)))float;
using u32x4=__attribute__((ext_vector_type(4)))unsigned;
using f32x4=__attribute__((ext_vector_type(4)))float;
constexpr int BATCH=4,NHEAD=8,SEQ=4096,D=64,DM=NHEAD*D;
constexpr int OPITCH=1024;
constexpr int PROJ_PITCH=3840, OG_COL=3232;
constexpr int NW=8,QBLK=32,QB=QBLK*NW,KVBLK=64,NQB=SEQ/QB;
constexpr int ATTN_PITCH=DM, ATTN_UNIT_ROWS=QB;
__device__ __forceinline__ int crow(int r,int hi){return (r&3)+8*(r>>2)+4*hi;}
#define SBAR() __builtin_amdgcn_sched_barrier(0)
__device__ __forceinline__ void cmask(f32x16&p0,f32x16&p1,int jb,int qrel,int hi){
  const float NEG=-INFINITY; int kb=64*jb+4*hi;
  #pragma unroll
  for(int r=0;r<16;++r){int kv=kb+(r&3)+8*(r>>2); if(kv>qrel)p0[r]=NEG; if(kv+32>qrel)p1[r]=NEG;}
}

constexpr int NSLOT=3, SLOTB=8192;
constexpr int LDS_K=0, LDS_V=NSLOT*SLOTB, LDS_WS=2*NSLOT*SLOTB, LDS_OST=LDS_WS+NW*64*4, LDS_BIAS=LDS_OST+NW*4096, LDS_SCAN=LDS_BIAS+SEQ*4, LDS_BYTES=LDS_SCAN+64;
constexpr float C2=0.125f*1.4426950408889634f;
__device__ __forceinline__ void glds16(const void*gsrc,unsigned lds_dst){unsigned keep;
  asm volatile("s_mov_b32 %0, m0\n\ts_mov_b32 m0, %2\n\ts_nop 0\n\tglobal_load_lds_dwordx4 %1, off\n\ts_mov_b32 m0, %0":"=&s"(keep):"v"(gsrc),"s"(lds_dst):"memory");}
__device__ __forceinline__ float max3f(float a,float b,float c){float r;asm("v_max3_f32 %0, %1, %2, %3":"=v"(r):"v"(a),"v"(b),"v"(c));return r;}
__device__ __forceinline__ float max2f(float a,float b){float r;asm("v_max_f32_e32 %0, %1, %2":"=v"(r):"v"(a),"v"(b));return r;}
__device__ __forceinline__ float fadd_s(float a,float b){float r;asm("v_add_f32_e32 %0, %1, %2":"=v"(r):"v"(a),"v"(b));return r;}
__device__ __forceinline__ float fsub_s(float a,float b){float r;asm("v_sub_f32_e32 %0, %1, %2":"=v"(r):"v"(a),"v"(b));return r;}
typedef float f32x2_t __attribute__((ext_vector_type(2))); typedef __bf16 bf16x2_t __attribute__((ext_vector_type(2)));
__device__ __forceinline__ unsigned cvtpk_s(float lo,float hi){f32x2_t v={lo,hi};bf16x2_t b=__builtin_convertvector(v,bf16x2_t);return __builtin_bit_cast(unsigned,b);}
#define WAIT_BAR(N) asm volatile("s_waitcnt vmcnt(" #N ") lgkmcnt(0)\n\ts_barrier":::"memory")

__device__ __forceinline__ void qkt(f32x16&p0,f32x16&p1,const char*Kslot,const bf16x8*qr,const f32x16&c0i,const f32x16&c1i,int r32,int hi){
  const char*kb=Kslot+hi*1024+r32*16;
  #pragma unroll
  for(int d0=0;d0<4;++d0){
    const bf16x8 b0=*reinterpret_cast<const bf16x8*>(kb+d0*2048);
    const bf16x8 b1=*reinterpret_cast<const bf16x8*>(kb+d0*2048+512);
    if(d0==0){p0=__builtin_amdgcn_mfma_f32_32x32x16_bf16(b0,qr[0],c0i,0,0,0);p1=__builtin_amdgcn_mfma_f32_32x32x16_bf16(b1,qr[0],c1i,0,0,0);}
    else{p0=__builtin_amdgcn_mfma_f32_32x32x16_bf16(b0,qr[d0],p0,0,0,0);p1=__builtin_amdgcn_mfma_f32_32x32x16_bf16(b1,qr[d0],p1,0,0,0);}}
}
typedef __attribute__((address_space(3))) const char* lds_cptr;
typedef short v4i16_t __attribute__((ext_vector_type(4)));
__device__ __forceinline__ void kload8(bf16x8*kf,lds_cptr kp){
  kf[0]=*(const __attribute__((address_space(3))) bf16x8*)(kp);      kf[1]=*(const __attribute__((address_space(3))) bf16x8*)(kp+512);
  kf[2]=*(const __attribute__((address_space(3))) bf16x8*)(kp+2048); kf[3]=*(const __attribute__((address_space(3))) bf16x8*)(kp+2560);
  kf[4]=*(const __attribute__((address_space(3))) bf16x8*)(kp+4096); kf[5]=*(const __attribute__((address_space(3))) bf16x8*)(kp+4608);
  kf[6]=*(const __attribute__((address_space(3))) bf16x8*)(kp+6144); kf[7]=*(const __attribute__((address_space(3))) bf16x8*)(kp+6656);
}
__device__ __forceinline__ void kload2(bf16x8*kf,lds_cptr kp,int j){ kf[2*j]=*(const __attribute__((address_space(3))) bf16x8*)(kp+j*2048); kf[2*j+1]=*(const __attribute__((address_space(3))) bf16x8*)(kp+j*2048+512); }
__device__ __forceinline__ s16x4 vtr(lds_cptr p){ return __builtin_bit_cast(s16x4,__builtin_amdgcn_ds_read_tr16_b64_v4i16((__attribute__((address_space(3))) v4i16_t*)p)); }
__device__ __forceinline__ float rowmax(const f32x16&p0,const f32x16&p1){
  float a=max3f(p0[0],p0[1],p1[0]),b=max3f(p0[2],p0[3],p1[1]);a=max3f(a,p1[2],p1[3]);
  #pragma unroll
  for(int r=4;r<16;r+=4){a=max3f(a,p0[r],p0[r+1]);b=max3f(b,p0[r+2],p0[r+3]);a=max3f(a,p1[r],p1[r+1]);b=max3f(b,p1[r+2],p1[r+3]);}
  const float m=max2f(a,b);
  auto rr=__builtin_amdgcn_permlane32_swap(__float_as_uint(m),__float_as_uint(m),false,false);
  return max2f(__uint_as_float(rr[0]),__uint_as_float(rr[1]));
}
__device__ __forceinline__ void pv(f32x16*o,int vb,bf16x8 pa0,bf16x8 pa1,bf16x8 pa2,bf16x8 pa3){
  #pragma unroll
  for(int d0=0;d0<2;++d0){s16x4 lo[4],hi[4];
    #pragma unroll
    for(int ks=0;ks<4;++ks){
      asm volatile("ds_read_b64_tr_b16 %0,%1 offset:%c2":"=&v"(lo[ks]):"v"(vb),"i"(d0*4096+ks*1024):"memory");
      asm volatile("ds_read_b64_tr_b16 %0,%1 offset:%c2":"=&v"(hi[ks]):"v"(vb),"i"(d0*4096+ks*1024+512):"memory");}
    asm volatile("s_waitcnt lgkmcnt(0)":::"memory");SBAR();
    #define PK(k) (bf16x8){lo[k][0],lo[k][1],lo[k][2],lo[k][3],hi[k][0],hi[k][1],hi[k][2],hi[k][3]}
    o[d0]=__builtin_amdgcn_mfma_f32_32x32x16_bf16(pa0,PK(0),o[d0],0,0,0);
    o[d0]=__builtin_amdgcn_mfma_f32_32x32x16_bf16(pa1,PK(1),o[d0],0,0,0);
    o[d0]=__builtin_amdgcn_mfma_f32_32x32x16_bf16(pa2,PK(2),o[d0],0,0,0);
    o[d0]=__builtin_amdgcn_mfma_f32_32x32x16_bf16(pa3,PK(3),o[d0],0,0,0);
    #undef PK
  }
}

#ifndef ATTN_STORE16
#define ATTN_STORE16(p,v) (*(u32x4*)(p)=(v))
#endif
template<int THRL> __device__ __forceinline__ void attn_unit(int b,int h,int qb,const bf16*Q,const bf16*__restrict__ K,const bf16*__restrict__ V,bf16*O,const float*__restrict__ logf,const unsigned short*__restrict__ proj,char*shm){
  const int tid=threadIdx.x,lane=tid&63,r32=lane&31,hi=lane>>5; const int wid=__builtin_amdgcn_readfirstlane(tid>>6);
  const long rowbase=(long)b*SEQ; const int q0=qb*QB;
  { float*biasL=(float*)(shm+LDS_BIAS); float*scanL=(float*)(shm+LDS_SCAN);
    const int nk=q0+QB,i0=tid*8; const float*lf=logf+((long)(b*NHEAD+h))*SEQ;
    float v8[8]; float run=0.f;
    if(i0<nk){ const f32x4 a_=*(const f32x4*)(lf+i0),c_=*(const f32x4*)(lf+i0+4);
      v8[0]=a_[0];v8[1]=v8[0]+a_[1];v8[2]=v8[1]+a_[2];v8[3]=v8[2]+a_[3];v8[4]=v8[3]+c_[0];v8[5]=v8[4]+c_[1];v8[6]=v8[5]+c_[2];v8[7]=v8[6]+c_[3];run=v8[7]; }
    else{ _Pragma("unroll") for(int i=0;i<8;++i)v8[i]=0.f; }
    float inc=run;
    _Pragma("unroll") for(int o_=1;o_<64;o_<<=1){ const float t_=__shfl_up(inc,o_); if(lane>=o_)inc+=t_; }
    if(lane==63)scanL[wid]=inc;
    __syncthreads();
    float base=inc-run; for(int w_=0;w_<wid;++w_)base+=scanL[w_];
    if(i0<nk){ const float L2E=-1.4426950408889634f;
      *(f32x4*)(biasL+i0)=(f32x4){(base+v8[0])*L2E,(base+v8[1])*L2E,(base+v8[2])*L2E,(base+v8[3])*L2E};
      *(f32x4*)(biasL+i0+4)=(f32x4){(base+v8[4])*L2E,(base+v8[5])*L2E,(base+v8[6])*L2E,(base+v8[7])*L2E}; }
    __syncthreads(); }
  int tskip;
  { const float*biasL=(const float*)(shm+LDS_BIAS); const int NT0=(q0+QB)/KVBLK; const float bq=biasL[q0];
    const bool need=(lane<NT0)?(bq-biasL[64*lane+63]<=80.f):true;
    const unsigned long long mk=__ballot(need); int first=mk?(__ffsll((long long)mk)-1):0;
    first&=~1; if(first>NT0-4)first=NT0-4; if(first<0)first=0; tskip=__builtin_amdgcn_readfirstlane(first); }
  const bf16*Qw=Q+(rowbase+q0+wid*QBLK)*DM+h*D;
  const bf16*Kh=K+(rowbase+(long)tskip*KVBLK)*DM+h*D,*Vh=V+(rowbase+(long)tskip*KVBLK)*DM+h*D;
  const unsigned lds0=(unsigned)(uintptr_t)shm;
  float*wsf=(float*)(shm+LDS_WS)+wid*64;
  const bf16*ksrc=Kh+(long)lane*DM+wid*8;
  const bf16*vsrc=Vh+(long)(16*(wid&3)+(lane>>2))*DM+(wid>>2)*32+(lane&3)*8;
  const unsigned kdst=lds0+LDS_K+wid*1024, vdst=lds0+LDS_V+wid*1024;
  #define DMA_K(t,slot) glds16(ksrc+(long)(t)*KVBLK*DM,(unsigned)__builtin_amdgcn_readfirstlane(kdst+(slot)))
  #define DMA_V(t,slot) glds16(vsrc+(long)(t)*KVBLK*DM,(unsigned)__builtin_amdgcn_readfirstlane(vdst+(slot)))
  const int vb0=(int)(lds0+LDS_V)+((lane>>4)&1)*32+(lane&3)*8+(4*hi+((lane&15)>>2))*64;
  const char*Kbase=shm+LDS_K; bf16x8 kf[8];
  const lds_cptr shm3=(lds_cptr)shm; const lds_cptr kp0=shm3+LDS_K+hi*1024+r32*16; const lds_cptr vp0=shm3+LDS_V+((lane>>4)&1)*32+(lane&3)*8+(4*hi+((lane&15)>>2))*64;
  const int NT=(q0+QB)/KVBLK-tskip;
  #define BIASC(C0,C1,t,ng) do{ const __attribute__((address_space(3))) f32x4*bq_=(const __attribute__((address_space(3))) f32x4*)(shm3+LDS_BIAS+((t)+tskip)*256+hi*16); \
    _Pragma("unroll") for(int g_=0;g_<4;++g_){ const f32x4 x0_=bq_[2*g_],x1_=bq_[8+2*g_]; \
      _Pragma("unroll") for(int i_=0;i_<4;++i_){ C0[4*g_+i_]=x0_[i_]+(ng); C1[4*g_+i_]=x1_[i_]+(ng); } } }while(0)
  DMA_K(0,0);DMA_V(0,0);DMA_K(1,SLOTB);
  bf16x8 qr[4];
  #pragma unroll
  for(int d0=0;d0<4;++d0)qr[d0]=*reinterpret_cast<const bf16x8*>(&Qw[(long)r32*DM+d0*16+hi*8]);
  float mhat=0.f,l_reg=0.f;f32x16 o[2];o[0]=f32x16{};o[1]=f32x16{};float negm_s=0.f;
  const int qrel=wid*QBLK+r32;
  #define CMASK(P0,P1,t) do{int jb_=(t)-(NT-4); if(jb_>=0)cmask(P0,P1,jb_,qrel,hi);}while(0)
  bool resc=false;
  #define START(P0,P1) do{ const float rm=rowmax(P0,P1); resc=false; \
    { const float dl=rm; mhat=fadd_s(mhat,dl); \
      _Pragma("unroll") for(int r=0;r<16;++r){P0[r]=fsub_s(P0[r],dl);P1[r]=fsub_s(P1[r],dl);} \
      negm_s=-mhat; } \
    _Pragma("unroll") for(int r=0;r<16;++r)P0[r]=__builtin_amdgcn_exp2f(P0[r]); }while(0)
  #define RESC() do{ if(resc){ asm volatile("s_waitcnt lgkmcnt(0)":::"memory"); \
      _Pragma("unroll") for(int d_=0;d_<2;++d_) _Pragma("unroll") for(int r=0;r<16;++r)o[d_][r]*=wsf[crow(r,hi)]; } }while(0)
  f32x16 pA0,pA1,pB0,pB1;
  int sl_prev=0,sl_cur=0,sl_next=SLOTB;
  #define ROT() do{sl_prev=sl_cur;sl_cur=sl_next;sl_next=(sl_next==(NSLOT-1)*SLOTB)?0:sl_next+SLOTB;}while(0)
  DMA_K(2,2*SLOTB);
  WAIT_BAR(3);
  { f32x16 c0i_,c1i_; BIASC(c0i_,c1i_,0,0.f); qkt(pA0,pA1,Kbase,qr,c0i_,c1i_,r32,hi); }asm volatile("s_nop 15\n\ts_nop 7":"+v"(pA0),"+v"(pA1));CMASK(pA0,pA1,0);
  START(pA0,pA1);
  _Pragma("unroll") for(int r=0;r<16;++r)pA1[r]=__builtin_amdgcn_exp2f(pA1[r]);
  WAIT_BAR(0);
  DMA_K(3,0);DMA_V(1,SLOTB);
  ROT();
  kload8(kf,kp0+sl_cur);
  WAIT_BAR(2);
  s16x4 vlo[8],vhi[8]; u32x4 pw0,pw1,pw2,pw3;
  #define PKW(P,B) cvtpk_s(P[B],P[B+1])
  #define PAF(k) __builtin_bit_cast(bf16x8,pw##k)
  #define VFR(i) (bf16x8){vlo[i][0],vlo[i][1],vlo[i][2],vlo[i][3],vhi[i][0],vhi[i][1],vhi[i][2],vhi[i][3]}
  #define PIN(x) asm volatile("":"+v"(x))
  #define MX3(a,b,c) __builtin_fmaxf(__builtin_fmaxf((a),(b)),(c))
  #define GAPA(MF,A0,A1,A2,A3,W0,W1,PW) do{ MF; sacc+=A0; sacc+=A1; sacc+=A2; sacc+=A3; PIN(sacc); W0; W1; PIN(PW); SBAR(); }while(0)
  #define EX(v) __builtin_amdgcn_exp2f(v)
  #define GAPB(MF,X,B) do{ MF; X[B]=EX(X[B]); X[B+1]=EX(X[B+1]); X[B+2]=EX(X[B+2]); X[B+3]=EX(X[B+3]); PIN(X); SBAR(); }while(0)
  #define VRD(i) do{ vlo[i]=vtr(vp_+(((i)>>2)*4096+((i)&3)*1024)); vhi[i]=vtr(vp_+(((i)>>2)*4096+((i)&3)*1024+512)); }while(0)
  #define KRD(G,j) do{ if(G){ kload2(kf,kp0+sl_next,j); SBAR(); } }while(0)
  #define STEP(C0,C1,P0,P1,t,GK,GV,GL) do{ SBAR(); BIASC(C0,C1,t,negm_s); SBAR(); \
    const lds_cptr vp_=vp0+sl_prev; \
    VRD(0); SBAR(); float sacc=(P0[0]+P0[1]); \
    GAPA(C0=__builtin_amdgcn_mfma_f32_32x32x16_bf16(kf[0],qr[0],C0,0,0,0), P0[2],P0[3],P0[4],P0[5],     pw0[0]=PKW(P0,0), pw0[1]=PKW(P0,2), pw0); \
    VRD(4); SBAR(); GAPA(C1=__builtin_amdgcn_mfma_f32_32x32x16_bf16(kf[1],qr[0],C1,0,0,0), P0[6],P0[7],P0[8],P0[9],     pw0[2]=PKW(P0,4), pw0[3]=PKW(P0,6), pw0); \
    VRD(1); SBAR(); GAPA(C0=__builtin_amdgcn_mfma_f32_32x32x16_bf16(kf[2],qr[1],C0,0,0,0),   P0[10],P0[11],P0[12],P0[13], pw1[0]=PKW(P0,8), pw1[1]=PKW(P0,10), pw1); \
    VRD(5); SBAR(); GAPA(C1=__builtin_amdgcn_mfma_f32_32x32x16_bf16(kf[3],qr[1],C1,0,0,0),   P0[14],P0[15],P1[0],P1[1],   pw1[2]=PKW(P0,12),pw1[3]=PKW(P0,14), pw1); \
    VRD(2); SBAR(); GAPA(C0=__builtin_amdgcn_mfma_f32_32x32x16_bf16(kf[4],qr[2],C0,0,0,0),   P1[2],P1[3],P1[4],P1[5],     pw2[0]=PKW(P1,0), pw2[1]=PKW(P1,2), pw2); \
    VRD(6); SBAR(); GAPA(C1=__builtin_amdgcn_mfma_f32_32x32x16_bf16(kf[5],qr[2],C1,0,0,0),   P1[6],P1[7],P1[8],P1[9],     pw2[2]=PKW(P1,4), pw2[3]=PKW(P1,6), pw2); \
    VRD(3); SBAR(); GAPA(C0=__builtin_amdgcn_mfma_f32_32x32x16_bf16(kf[6],qr[3],C0,0,0,0),   P1[10],P1[11],P1[12],P1[13], pw3[0]=PKW(P1,8), pw3[1]=PKW(P1,10), pw3); \
    VRD(7); SBAR(); GAPA(C1=__builtin_amdgcn_mfma_f32_32x32x16_bf16(kf[7],qr[3],C1,0,0,0),   P1[14],P1[15],0.f,0.f,       pw3[2]=PKW(P1,12),pw3[3]=PKW(P1,14), pw3); \
    l_reg+=sacc; \
    if(GK){DMA_K((t)+3,sl_cur);} if(GV){DMA_V((t)+1,sl_next);} \
    CMASK(C0,C1,t); \
    { float a=MX3(C0[0],C0[1],C1[0]),b=MX3(C0[2],C0[3],C1[1]); a=MX3(a,C1[2],C1[3]); \
      _Pragma("unroll") for(int r=4;r<16;r+=4){a=MX3(a,C0[r],C0[r+1]);b=MX3(b,C0[r+2],C0[r+3]);a=MX3(a,C1[r],C1[r+1]);b=MX3(b,C1[r+2],C1[r+3]);} \
      float rm=__builtin_fmaxf(a,b); { auto rr=__builtin_amdgcn_permlane32_swap(__float_as_uint(rm),__float_as_uint(rm),false,false); rm=__builtin_fmaxf(__uint_as_float(rr[0]),__uint_as_float(rr[1])); } \
      resc=false; \
      if(__builtin_expect(__any(rm>(float)THRL),0)){ const float dl=__builtin_fmaxf(rm,0.f); mhat+=dl; \
        _Pragma("unroll") for(int r=0;r<16;++r){C0[r]-=dl;C1[r]-=dl;} \
        negm_s=-mhat; \
        const float f=__builtin_amdgcn_exp2f(-dl); l_reg*=f; if(hi==0)wsf[r32]=f; resc=true; } } \
    SBAR(); \
    GAPB(o[0]=__builtin_amdgcn_mfma_f32_32x32x16_bf16(PAF(0),VFR(0),o[0],0,0,0), C0,0); \
    GAPB(o[1]=__builtin_amdgcn_mfma_f32_32x32x16_bf16(PAF(0),VFR(4),o[1],0,0,0), C0,4); \
    KRD(GL,0); GAPB(o[0]=__builtin_amdgcn_mfma_f32_32x32x16_bf16(PAF(1),VFR(1),o[0],0,0,0), C0,8); \
    KRD(GL,1); GAPB(o[1]=__builtin_amdgcn_mfma_f32_32x32x16_bf16(PAF(1),VFR(5),o[1],0,0,0), C0,12); \
    KRD(GL,2); GAPB(o[0]=__builtin_amdgcn_mfma_f32_32x32x16_bf16(PAF(2),VFR(2),o[0],0,0,0), C1,0); \
    KRD(GL,3); GAPB(o[1]=__builtin_amdgcn_mfma_f32_32x32x16_bf16(PAF(2),VFR(6),o[1],0,0,0), C1,4); \
    GAPB(o[0]=__builtin_amdgcn_mfma_f32_32x32x16_bf16(PAF(3),VFR(3),o[0],0,0,0), C1,8); \
    GAPB(o[1]=__builtin_amdgcn_mfma_f32_32x32x16_bf16(PAF(3),VFR(7),o[1],0,0,0), C1,12); \
    }while(0)
  int t=1;
  #undef CMASK
  #define CMASK(P0,P1,t) do{}while(0)
  for(;t+5<NT;t+=2){
    STEP(pB0,pB1,pA0,pA1,t,true,true,true);     WAIT_BAR(2); RESC(); ROT();
    STEP(pA0,pA1,pB0,pB1,t+1,true,true,true);   WAIT_BAR(2); RESC(); ROT();
  }
  #undef CMASK
  #define CMASK(P0,P1,t) do{int jb_=(t)-(NT-4); if(jb_>=0)cmask(P0,P1,jb_,qrel,hi);}while(0)
  #define ENDW(tt) do{ if((tt)+3<NT){WAIT_BAR(2);} else if((tt)+2<NT){WAIT_BAR(1);} else {WAIT_BAR(0);} }while(0)
  for(;t+1<NT;t+=2){
    STEP(pB0,pB1,pA0,pA1,t,(t+3<NT),(t+1<NT),(t+1<NT));       ENDW(t);   RESC(); ROT();
    STEP(pA0,pA1,pB0,pB1,t+1,(t+4<NT),(t+2<NT),(t+2<NT));     ENDW(t+1); RESC(); ROT();
  }
  STEP(pB0,pB1,pA0,pA1,NT-1,false,false,false); RESC();
  { float sacc=pB0[0]+pB0[1]; _Pragma("unroll") for(int r=2;r<16;++r)sacc+=pB0[r]; _Pragma("unroll") for(int r=0;r<16;++r)sacc+=pB1[r]; l_reg+=sacc;
    pw0=(u32x4){PKW(pB0,0),PKW(pB0,2),PKW(pB0,4),PKW(pB0,6)};pw1=(u32x4){PKW(pB0,8),PKW(pB0,10),PKW(pB0,12),PKW(pB0,14)};pw2=(u32x4){PKW(pB1,0),PKW(pB1,2),PKW(pB1,4),PKW(pB1,6)};pw3=(u32x4){PKW(pB1,8),PKW(pB1,10),PKW(pB1,12),PKW(pB1,14)};
    SBAR(); pv(o,vb0+sl_cur,PAF(0),PAF(1),PAF(2),PAF(3)); }
  #undef PKW
  #undef PAF
  #undef VFR
  #undef PIN
  #undef MX3
  #undef GAPA
  #undef GAPB
  #undef EX
  #undef VRD
  #undef KRD
  #undef STEP
  #undef ENDW
  {auto rr=__builtin_amdgcn_permlane32_swap(__float_as_uint(l_reg),__float_as_uint(l_reg),false,false);l_reg=__uint_as_float(rr[0])+__uint_as_float(rr[1]);}
  if(hi==0)wsf[32+r32]=l_reg;asm volatile("s_waitcnt lgkmcnt(0)":::"memory");
  float rli[16];
  #pragma unroll
  for(int r=0;r<16;++r)rli[r]=__builtin_amdgcn_rcpf(wsf[32+crow(r,hi)]);
  bf16*Ow=O+(rowbase+q0+wid*QBLK)*OPITCH+h*D; const unsigned short*ogw=proj+(rowbase+q0+wid*QBLK)*(long)PROJ_PITCH+OG_COL+h*D;
  { bf16*stg=(bf16*)(shm+LDS_OST)+wid*2048;
    #pragma unroll
    for(int r=0;r<16;++r){const int orow=crow(r,hi);
      #pragma unroll
      for(int d0=0;d0<2;++d0)stg[orow*64+d0*32+r32]=__float2bfloat16(o[d0][r]*rli[r]);}
    asm volatile("s_waitcnt lgkmcnt(0)":::"memory");
    #pragma unroll
    for(int i=0;i<4;++i){const int row=i*8+(lane>>3),ch=lane&7; u32x4 v=*(const u32x4*)(stg+row*64+ch*8);
      const u32x4 gw_=*(const u32x4*)(ogw+(long)row*PROJ_PITCH+ch*8);
      const f32x4 g0={__uint_as_float(gw_[0]<<16),__uint_as_float(gw_[0]&0xffff0000u),__uint_as_float(gw_[1]<<16),__uint_as_float(gw_[1]&0xffff0000u)},g1={__uint_as_float(gw_[2]<<16),__uint_as_float(gw_[2]&0xffff0000u),__uint_as_float(gw_[3]<<16),__uint_as_float(gw_[3]&0xffff0000u)};
      #define SG(x) __builtin_amdgcn_rcpf(1.0f+__builtin_amdgcn_exp2f(-1.4426950408889634f*(x)))
      #define LO(w) __uint_as_float((w)<<16)
      #define HI(w) __uint_as_float((w)&0xffff0000u)
      v[0]=cvtpk_s(LO(v[0])*SG(g0[0]),HI(v[0])*SG(g0[1])); v[1]=cvtpk_s(LO(v[1])*SG(g0[2]),HI(v[1])*SG(g0[3]));
      v[2]=cvtpk_s(LO(v[2])*SG(g1[0]),HI(v[2])*SG(g1[1])); v[3]=cvtpk_s(LO(v[3])*SG(g1[2]),HI(v[3])*SG(g1[3]));
      #undef SG
      #undef LO
      #undef HI
      ATTN_STORE16(Ow+(long)row*OPITCH+ch*8,v);} }
  asm volatile("s_waitcnt lgkmcnt(0)\n\ts_barrier":::"memory");
  #undef DMA_K
  #undef DMA_V
  #undef CMASK
  #undef START
  #undef RESC
  #undef ROT
  #undef BIASC
}
constexpr int ATTN_LDS_BYTES=LDS_BYTES;
struct AttnTensors { const bf16* Q; const bf16* K; const bf16* V; bf16* O; const float* logf; const unsigned short* proj; };
constexpr int N_UNITS=BATCH*NHEAD*NQB;
template<int THRL=8> __device__ __forceinline__ void attn_phase(char*lds,const AttnTensors&T,unsigned*qhead,volatile __attribute__((address_space(3))) unsigned*qslot){
  for(;;){
    if(threadIdx.x==0)*qslot=__hip_atomic_fetch_add(qhead,1u,__ATOMIC_RELAXED,__HIP_MEMORY_SCOPE_AGENT);
    __syncthreads(); const unsigned u=*qslot; __syncthreads();
    if(u>=(unsigned)N_UNITS)break;
    const int qb=NQB-1-(int)(u>>5),bh=(int)(u&31u);
    attn_unit<THRL>(bh/NHEAD,bh%NHEAD,qb,T.Q,T.K,T.V,T.O,T.logf,T.proj,lds);
  }
}
#undef SBAR
#undef WAIT_BAR
}
#define GAS __attribute__((address_space(1)))
#define LAS __attribute__((address_space(3)))
typedef unsigned short bf16;
typedef unsigned v4u __attribute__((ext_vector_type(4)));
typedef float f32x4 __attribute__((ext_vector_type(4)));
typedef short bf16x8 __attribute__((ext_vector_type(8)));
typedef GAS unsigned gu32;
typedef GAS unsigned long long gu64;
#define RLX_AGENT __ATOMIC_RELAXED, __HIP_MEMORY_SCOPE_AGENT
#define LDS_WAIT() asm volatile("s_waitcnt lgkmcnt(0)" ::: "memory")
#define VM_WAIT() asm volatile("s_waitcnt vmcnt(0)" ::: "memory")
__device__ __forceinline__ unsigned long long rt() { return __builtin_amdgcn_s_memrealtime(); }
__device__ __forceinline__ unsigned f2bf(float f) { unsigned u = __builtin_bit_cast(unsigned, f); return (u + 0x7fffu + ((u >> 16) & 1u)) >> 16; }
__device__ __forceinline__ unsigned pk2(float lo, float hi) { return pg8::cvt_pk_bf16(lo, hi); }

#define XB_TMO      128
#define XB_XCNT(j)  (256  + 64 * (j))
#define XB_XSUB(j)  (1280 + 64 * (j))
#define XB_XGEN(j)  (2304 + 64 * (j))
#define XB_TOP      3328
#define XB_TOPGEN   3392
#define XCD_BAR_WORDS 3456
#define XB_SPIN_CAP (1u << 18)

__device__ __forceinline__ unsigned xb_ld(unsigned* p)              { return __hip_atomic_load(p, __ATOMIC_RELAXED, __HIP_MEMORY_SCOPE_AGENT); }
__device__ __forceinline__ unsigned xb_add(unsigned* p, unsigned v) { return __hip_atomic_fetch_add(p, v, __ATOMIC_RELAXED, __HIP_MEMORY_SCOPE_AGENT); }
__device__ __forceinline__ unsigned xb_xcc_id() { return (unsigned)__builtin_amdgcn_s_getreg((3 << 11) | 20) & 0xFu; }
#define XB_SPIN(cond, bar) do { unsigned _sp = 0; while (cond) { __builtin_amdgcn_s_sleep(1); \
    if ((++_sp & 255u) == 0u) { if (xb_ld(&(bar)[XB_TMO])) break; if (_sp > XB_SPIN_CAP) { atomicAdd(&(bar)[XB_TMO], 1u); break; } } } } while (0)

struct XcdBarrier {
    unsigned* bar; unsigned x;
    volatile LAS unsigned* st;
};

__device__ __forceinline__ XcdBarrier xcd_barrier_post(unsigned* bar, volatile LAS unsigned* st) {
    XcdBarrier b; b.bar = bar; b.x = xb_xcc_id(); b.st = st;
    if (threadIdx.x == 0) (void)xb_add(&bar[XB_XCNT(b.x)], 1u);
    return b;
}
__device__ __forceinline__ void xcd_barrier_complete(unsigned* bar, unsigned x, unsigned& nloc, unsigned& nx) {
    const unsigned G = gridDim.x * gridDim.y * gridDim.z;
    unsigned sum, cnt, mine, sp = 0u;
    for (;;) {
        sum = 0u; cnt = 0u; mine = 0u;
#pragma unroll
        for (unsigned j = 0; j < 16; ++j) { const unsigned c = xb_ld(&bar[XB_XCNT(j)]); sum += c; cnt += (c > 0u) ? 1u : 0u; mine = (j == x) ? c : mine; }
        if (sum == G) break;
        __builtin_amdgcn_s_sleep(1);
        if ((++sp & 255u) == 0u) { if (xb_ld(&bar[XB_TMO])) break; if (sp > XB_SPIN_CAP) { atomicAdd(&bar[XB_TMO], 1u); break; } }
    }
    nloc = mine > 0u ? mine : 1u; nx = cnt > 0u ? cnt : 1u;
}

__device__ __forceinline__ void xcd_barrier(const XcdBarrier& b) {
    asm volatile("s_waitcnt vmcnt(0)" ::: "memory");
    __syncthreads();
    if (threadIdx.x == 0) {
        unsigned* bar = b.bar;
        __builtin_amdgcn_s_waitcnt(0);
        unsigned nloc = b.st[0], nx = b.st[1];
        if (nloc == 0u) { xcd_barrier_complete(bar, b.x, nloc, nx); b.st[0] = nloc; b.st[1] = nx; }
        const unsigned old = xb_add(&bar[XB_XSUB(b.x)], 1u);
        const unsigned gen = old / nloc;
        if (old + 1u == (gen + 1u) * nloc) {
            __builtin_amdgcn_fence(__ATOMIC_RELEASE, "agent");
            asm volatile("s_waitcnt vmcnt(0)" ::: "memory");
            const unsigned og = xb_add(&bar[XB_TOP], 1u);
            const unsigned tg = og / nx;
            if (og + 1u == (tg + 1u) * nx) xb_add(&bar[XB_TOPGEN], 1u);
            else XB_SPIN(xb_ld(&bar[XB_TOPGEN]) == tg, bar);
            __builtin_amdgcn_fence(__ATOMIC_ACQUIRE, "agent");
            xb_add(&bar[XB_XGEN(b.x)], 1u);
            asm volatile("s_waitcnt vmcnt(0)" ::: "memory");
        } else {
            XB_SPIN(xb_ld(&bar[XB_XGEN(b.x)]) == gen, bar);
            __builtin_amdgcn_fence(__ATOMIC_ACQUIRE, "agent");
            asm volatile("s_waitcnt vmcnt(0)" ::: "memory");
        }
    }
    __syncthreads();
}

constexpr int NWAVES = 8, NTHR = 512;
constexpr int BATCH = 4, SEQ = 4096, D = 1024, M = BATCH * SEQ;
constexpr int NH = 8, HD = 64, RWW = 512;
constexpr int IN_COLS = 3752, PL = 3840;
constexpr int C_R = 0, C_K = 512, C_V = 1024, C_WD = 1536, C_AD = 1568, C_GD = 1600;
constexpr int C_FQ = 1696, C_FK = 2208, C_FV = 2720, C_OG = 3232, C_FZ = 3744;
constexpr int NE = 32, TOPK = 4, NASSIGN = M * TOPK, MAXTILES = NASSIGN / 256 + NE, XROWS = MAXTILES * 256;
constexpr float LN_EPS = 1e-5f, QK_EPS = 1e-6f, GN_EPS = 64e-5f, ALPHA = 1.189207115002721f;
static_assert(attn_body::PROJ_PITCH == PL && attn_body::OG_COL == C_OG, "attention body constants");

constexpr size_t MiB = 1u << 20;
constexpr size_t WS_CTL = 0, CTL_ZERO_BYTES = 1 * MiB;
constexpr size_t WS_WIN = 2 * MiB, WS_WO = 10 * MiB;
constexpr size_t WS_LOGF = 12 * MiB;
constexpr size_t WS_AE = WS_LOGF + 512 * 1024, WS_APOS = WS_AE + 256 * 1024, WS_AGATE = WS_APOS + 256 * 1024, WS_AROW = WS_AGATE + 256 * 1024, WS_ROWGATE = WS_AROW + 256 * 1024, WS_ROWTOK = WS_ROWGATE + 512 * 1024;
constexpr size_t WS_W1T = 32 * MiB, WS_W2T = 160 * MiB;
constexpr size_t WS_HB = 224 * MiB;
constexpr size_t WS_HF = 256 * MiB;
constexpr size_t WS_PROJ = 320 * MiB;
constexpr size_t WS_G = 560 * MiB, WS_BONUS = 592 * MiB;
constexpr size_t WS_QB = 624 * MiB, WS_KB = 640 * MiB, WS_VB = 656 * MiB;
constexpr size_t WS_MIX = 672 * MiB;
constexpr size_t WS_MC = 704 * MiB, WS_NT = 720 * MiB, WS_QC = 752 * MiB, WS_ZT = 768 * MiB;
constexpr size_t WS_Y = 800 * MiB;
constexpr size_t WS_XS = 320 * MiB, WS_ACT = 464 * MiB, WS_EOUT = 320 * MiB;
constexpr size_t WS_END = 832 * MiB;
static_assert(WS_ROWTOK + (size_t)XROWS * 4 <= WS_W1T && WS_XS + (size_t)XROWS * 2048 <= WS_ACT && WS_ACT + (size_t)XROWS * 2048 <= WS_QB, "d_ws map");

constexpr int CW_BAR = 4096, CW_ATTQ = 8192, CW_CVQ = 8224, CW_ECNT = 8256;

constexpr int RING_OFF = 0;
constexpr int CTRL_OFF = 159744, LDS_BYTES = 163840;
constexpr int LC_MISC = 0  , LC_HIST = 128, LC_BASE = 256, LC_TSTART = 384, LC_TEXP = 640  , LC_ROWINFO = 1024  ;
static_assert(attn_body::ATTN_LDS_BYTES <= 131072, "attention scratch inside the ring region");

typedef float f32x2 __attribute__((ext_vector_type(2)));
typedef unsigned u32x2v __attribute__((ext_vector_type(2)));
#define MFMA16(a, b, c) __builtin_amdgcn_mfma_f32_16x16x32_bf16((a), (b), (c), 0, 0, 0)
__device__ __forceinline__ float sigmoidf_(float x) { return __builtin_amdgcn_rcpf(1.0f + __builtin_amdgcn_exp2f(-1.4426950408889634f * x)); }
__device__ __forceinline__ float tanh_fast(float x) { return 1.0f - 2.0f * __builtin_amdgcn_rcpf(1.0f + __builtin_amdgcn_exp2f(2.8853900817779268f * x)); }
__device__ __forceinline__ float log1pexp_neg(float ax) { return 0.6931471805599453f * __builtin_amdgcn_logf(1.0f + __builtin_amdgcn_exp2f(-1.4426950408889634f * ax)); }
__device__ __forceinline__ float bf2f(unsigned short b) { return __uint_as_float((unsigned)b << 16); }
__device__ __forceinline__ unsigned short f2bf16(float f) { return (unsigned short)f2bf(f); }
__device__ __forceinline__ v4u pack8(const float* v) { v4u o; o.x = pg8::cvt_pk_bf16(v[0], v[1]); o.y = pg8::cvt_pk_bf16(v[2], v[3]); o.z = pg8::cvt_pk_bf16(v[4], v[5]); o.w = pg8::cvt_pk_bf16(v[6], v[7]); return o; }
__device__ __forceinline__ float wave_sum(float v) {
#pragma unroll
    for (int o = 1; o < 64; o <<= 1) v += __shfl_xor(v, o);
    return v;
}

__device__ __forceinline__ void transpose_item(const float* W, int K, int N, int nblk, bf16* WT, LAS float* scr, int item, int lane) {
    const int kb = item / nblk, nb = item - kb * nblk, k0 = 64 * kb, n0 = 32 * nb; const int nn = n0 + (lane & 31); const bool ok = nn < N;
#pragma unroll 8
    for (int i = 0; i < 32; ++i) { const int kk = 2 * i + (lane >> 5); scr[kk * 33 + (lane & 31)] = ok ? W[(size_t)(k0 + kk) * N + nn] : 0.f; }
    LDS_WAIT(); asm volatile("" ::: "memory");
    const int c = lane & 7;
#pragma unroll
    for (int j = 0; j < 4; ++j) { const int n = (lane >> 3) + 8 * j; const LAS float* s = scr + (8 * c) * 33 + n;
        v4u o; o.x = pk2(s[0 * 33], s[1 * 33]); o.y = pk2(s[2 * 33], s[3 * 33]); o.z = pk2(s[4 * 33], s[5 * 33]); o.w = pk2(s[6 * 33], s[7 * 33]);
        *(GAS v4u*)(WT + (size_t)(n0 + n) * K + k0 + 8 * c) = o; }
    LDS_WAIT(); asm volatile("" ::: "memory");
}
__device__ __forceinline__ void ln_finish(f32x4 (&v)[4], const float* w, const float* b, int lane, float* outF, bf16* outB) {
    float s = 0.f;
#pragma unroll
    for (int j = 0; j < 4; ++j) s += (v[j].x + v[j].y) + (v[j].z + v[j].w);
    const float mean = wave_sum(s) * (1.f / D); float s2 = 0.f;
#pragma unroll
    for (int j = 0; j < 4; ++j) { v[j] = v[j] - mean; s2 += (v[j].x * v[j].x + v[j].y * v[j].y) + (v[j].z * v[j].z + v[j].w * v[j].w); }
    const float rstd = 1.f / sqrtf(wave_sum(s2) * (1.f / D) + LN_EPS);
#pragma unroll
    for (int j = 0; j < 4; ++j) { const f32x4 wv = *(const f32x4*)(w + 4 * lane + 256 * j), bv = *(const f32x4*)(b + 4 * lane + 256 * j); v[j] = v[j] * rstd * wv + bv;
        if (outF) *(f32x4*)(outF + 4 * lane + 256 * j) = v[j];
        if (outB) { u32x2v o; o.x = pg8::cvt_pk_bf16(v[j].x, v[j].y); o.y = pg8::cvt_pk_bf16(v[j].z, v[j].w); *(u32x2v*)(outB + 4 * lane + 256 * j) = o; } }
}

struct CvtItem { const float* W; bf16* WT; int N; int k0, n0; };
__device__ __forceinline__ CvtItem cvt_item(int it, const float* w1, const float* w2, bf16* W1T, bf16* W2T) {
    CvtItem c;
    it = __builtin_amdgcn_readfirstlane(it);
    if (it < NE * 1024) { const int e = it >> 10, r = it & 1023; c.W = w1 + (size_t)e * D * 2048; c.WT = W1T + (size_t)e * 2048 * D; c.N = 2048; c.k0 = 64 * (r >> 6); c.n0 = 32 * (r & 63); }
    else { const int i2 = it - NE * 1024, e = i2 >> 9, r = i2 & 511; c.W = w2 + (size_t)e * D * D; c.WT = W2T + (size_t)e * D * D; c.N = D; c.k0 = 64 * (r >> 5); c.n0 = 32 * (r & 31); }
    return c;
}
__device__ __forceinline__ void cvt_load(f32x4 (&ld)[8], const CvtItem& c, int lane) {
    const int fr = lane & 15, fq = lane >> 4;
    const char* base = (const char*)(c.W + (size_t)c.k0 * c.N + c.n0);
    const unsigned lo = (unsigned)((8 * (fr >> 2) + (fr & 3)) * c.N + 8 * fq) * 4u;
#pragma unroll
    for (int p = 0; p < 2; ++p)
#pragma unroll
        for (int m = 0; m < 2; ++m) { const unsigned off = lo + (unsigned)((32 * p + 4 * m) * c.N) * 4u;
            ld[(p * 2 + m) * 2] = *(const f32x4*)(base + off); ld[(p * 2 + m) * 2 + 1] = *(const f32x4*)(base + off + 16u); }
}
__device__ __forceinline__ void cvt_finish(const f32x4 (&ld)[8], const CvtItem& c, int lane) {
    const int fr = lane & 15, fq = lane >> 4;
    bf16x8 sel[2];
#pragma unroll
    for (int h = 0; h < 2; ++h) { v4u sw;
#pragma unroll
        for (int e2 = 0; e2 < 4; ++e2) sw[e2] = ((8 * fq + 2 * e2 == 16 * h + fr) ? 0x3F80u : 0u) | ((8 * fq + 2 * e2 + 1 == 16 * h + fr) ? 0x3F800000u : 0u);
        sel[h] = __builtin_bit_cast(bf16x8, sw); }
#pragma unroll
    for (int p = 0; p < 2; ++p) { bf16x8 a[2];
#pragma unroll
        for (int m = 0; m < 2; ++m) { const f32x4 x0 = ld[(p * 2 + m) * 2], x1 = ld[(p * 2 + m) * 2 + 1]; v4u q; q.x = pk2(x0[0], x0[1]); q.y = pk2(x0[2], x0[3]); q.z = pk2(x1[0], x1[1]); q.w = pk2(x1[2], x1[3]); a[m] = __builtin_bit_cast(bf16x8, q); }
#pragma unroll
        for (int h = 0; h < 2; ++h) { const f32x4 z4 = {0.f, 0.f, 0.f, 0.f}; const f32x4 d0 = MFMA16(a[0], sel[h], z4), d1 = MFMA16(a[1], sel[h], z4);
            v4u o; o.x = pk2(d0[0], d0[1]); o.y = pk2(d0[2], d0[3]); o.z = pk2(d1[0], d1[1]); o.w = pk2(d1[2], d1[3]);
            *(v4u*)((char*)(c.WT + (size_t)c.n0 * D + c.k0) + (unsigned)((16 * h + fr) * D + 32 * p + 8 * fq) * 2u) = o; } }
}

struct CvtSide { const float* w2; bf16* W2T; int lane, wave; f32x4 cld[8]; CvtItem ci;
    __device__ __forceinline__ void pre(const pg8::Unit& u) { const int idx = ((u.pm * 8 + u.pn) * 8 + wave) & (NE * 512 - 1); ci = cvt_item(NE * 1024 + idx, nullptr, w2, nullptr, W2T); cvt_load(cld, ci, lane); }
    __device__ __forceinline__ void post(const pg8::Unit&) { cvt_finish(cld, ci, lane); } };

struct FoxRow { v4u qa, ka, va; unsigned short fz; };
struct FoxPtrs { const bf16* proj; const float *qn, *kn, *bfp; bf16 *QB, *KB, *VB; float* LOGF; };
__device__ __forceinline__ void fox_load(FoxRow& r, const FoxPtrs& F, int m, int lane) {
    const bf16* pr = F.proj + (size_t)m * PL; r.qa = *(const v4u*)(pr + C_FQ + 8 * lane); r.ka = *(const v4u*)(pr + C_FK + 8 * lane); r.va = *(const v4u*)(pr + C_FV + 8 * lane); r.fz = pr[C_FZ + (lane & 7)]; }
__device__ __forceinline__ void fox_finish(const FoxRow& r, const FoxPtrs& F, int m, int lane) {
    const int d0 = (8 * lane) & 63; float q[8], k[8]; float sq = 0.f, sk = 0.f;
    const f32x4 qn0 = *(const f32x4*)(F.qn + d0), qn1 = *(const f32x4*)(F.qn + d0 + 4), kn0 = *(const f32x4*)(F.kn + d0), kn1 = *(const f32x4*)(F.kn + d0 + 4);
    const float qnv[8] = {qn0[0], qn0[1], qn0[2], qn0[3], qn1[0], qn1[1], qn1[2], qn1[3]}, knv[8] = {kn0[0], kn0[1], kn0[2], kn0[3], kn1[0], kn1[1], kn1[2], kn1[3]};
#pragma unroll
    for (int i = 0; i < 4; ++i) { q[2 * i] = __uint_as_float(r.qa[i] << 16); q[2 * i + 1] = __uint_as_float(r.qa[i] & 0xffff0000u); k[2 * i] = __uint_as_float(r.ka[i] << 16); k[2 * i + 1] = __uint_as_float(r.ka[i] & 0xffff0000u); }
#pragma unroll
    for (int i = 0; i < 8; ++i) { sq += q[i] * q[i]; sk += k[i] * k[i]; }
    sq += __shfl_xor(sq, 1); sq += __shfl_xor(sq, 2); sq += __shfl_xor(sq, 4);
    sk += __shfl_xor(sk, 1); sk += __shfl_xor(sk, 2); sk += __shfl_xor(sk, 4);
    const float rq = rsqrtf(sq * (1.f / 64.f) + QK_EPS) * attn_body::C2, rk = rsqrtf(sk * (1.f / 64.f) + QK_EPS);
#pragma unroll
    for (int i = 0; i < 8; ++i) { q[i] = q[i] * rq * qnv[i]; k[i] = k[i] * rk * knv[i]; }
    *(v4u*)(F.QB + (size_t)m * 512 + 8 * lane) = pack8(q); *(v4u*)(F.KB + (size_t)m * 512 + 8 * lane) = pack8(k); *(v4u*)(F.VB + (size_t)m * 512 + 8 * lane) = r.va;
    if (lane < 8) { const float z = bf2f(r.fz) + F.bfp[lane]; const float lf = fminf(z, 0.f) - log1pexp_neg(fabsf(z)); const int b = m >> 12, t = m & 4095; F.LOGF[(size_t)(b * NH + lane) * SEQ + t] = lf; }
}

namespace rwk {
constexpr int OPS = 144;
constexpr int XPS = 336;
constexpr int O_WT = 0;
constexpr int O_A = 21504;
constexpr int O_XLH = O_A, O_XLL = O_A + 21504, O_PART = O_A;
constexpr int O_RT = O_A, O_AT = O_A + 9216, O_BT = O_A + 18432, O_KT = O_A + 27648;
constexpr int O_XT = O_AT;
constexpr int O_PT1 = O_KT;
constexpr int O_U2 = 64512;
constexpr int O_CUM = O_U2, O_BF = O_U2 + 16384, O_KF = O_U2 + 32768;
constexpr int O_PA0 = O_U2, O_PT0 = O_U2 + 9216, O_ARB = O_U2 + 18432, O_ARK = O_U2 + 27648, O_AAK = O_U2 + 36864, O_PA1 = O_AAK;
constexpr int O_VT = 113664, O_BHT = O_VT + 9216, O_KHT = O_VT + 18432, O_GAMC = 141312, O_RHS = 141568  , O_END = O_RHS + 16384;
static_assert(O_END <= CTRL_OFF, "RWKV arena below the LDS control area");

#define LDS_BARRIER() do { asm volatile("s_waitcnt lgkmcnt(0)" ::: "memory"); __builtin_amdgcn_s_barrier(); asm volatile("" ::: "memory"); } while (0)
struct Ptrs { const bf16* proj; const float *mu, *w0, *w2, *a0, *a2, *g2, *k_k, *k_a, *r_k; bf16 *G, *Bonus; bf16* Mc; bf16* NT; bf16* Qc; bf16* ZT; };
struct Pre { u32x2v xp[5], xq[5]; v4u rc, rp, kc, kp, vc, vp; };
struct Cvt { const float *w1, *w2; bf16 *W1T, *W2T; int it0; const FoxPtrs* fox; int foxm; };

__device__ __forceinline__ void stage_weights(LAS unsigned char* lds, int h, const Ptrs& P) {
    const int tid = threadIdx.x;
#pragma unroll
    for (int q = 0; q < 5; ++q) { const int p = tid + 512 * q, n = p & 63, j0 = 4 * (p >> 6);
        const float* src = (j0 < 32) ? (P.w2 + j0 * 512) : ((j0 < 64) ? (P.a2 + (j0 - 32) * 512) : (P.g2 + (j0 - 64) * 512));
        const float a = src[h * 64 + n], b = src[512 + h * 64 + n], c = src[1024 + h * 64 + n], d = src[1536 + h * 64 + n];
        u32x2v w; w.x = pg8::cvt_pk_bf16(a, b); w.y = pg8::cvt_pk_bf16(c, d); *(LAS u32x2v*)(lds + O_WT + n * XPS + j0 * 2) = w; }
}
__device__ __forceinline__ void prefetch(Pre& R, const int un, const Ptrs& P, const int tid) { const int b = un >> 9, h = (un >> 6) & 7, c = un & 63; const int tok0 = b * SEQ + c * 64;
    const int t = tid >> 3, hn0 = h * 64 + 8 * (tid & 7);
    const char* pb = (const char*)(P.proj + (size_t)tok0 * PL);
    const char* pbm = (c == 0) ? pb : pb - (size_t)PL * 2;
    const unsigned pshift = (c == 0) ? (unsigned)PL * 2u : 0u;
#pragma unroll
    for (int i = 0; i < 5; ++i) { const int idx = tid + 512 * i, tt = idx / 40, c4 = idx - tt * 40; const unsigned off = (unsigned)(tt * PL + C_WD + 4 * c4) * 2u;
        R.xp[i] = *(const u32x2v*)(pb + off); R.xq[i] = (c == 0 && tt == 0) ? (u32x2v){0u, 0u} : *(const u32x2v*)(pbm + (off - pshift)); }
    const bool first = (c == 0 && t == 0); const unsigned off = (unsigned)(t * PL + hn0) * 2u;
    R.rc = *(const v4u*)(pb + off + C_R * 2); R.kc = *(const v4u*)(pb + off + C_K * 2); R.vc = *(const v4u*)(pb + off + C_V * 2);
    if (first) { R.rp = (v4u){0u, 0u, 0u, 0u}; R.kp = R.rp; R.vp = R.rp; }
    else { R.rp = *(const v4u*)(pbm + (off - pshift) + C_R * 2); R.kp = *(const v4u*)(pbm + (off - pshift) + C_K * 2); R.vp = *(const v4u*)(pbm + (off - pshift) + C_V * 2); }
}

__device__ __forceinline__ void unit(LAS unsigned char* lds, const int un, const Ptrs& P, const Pre& R, Pre& Rn, const bool has_next, const int un_next, const Cvt& cv) {
    int tid_ = threadIdx.x; asm volatile("" : "+v"(tid_));
    const int tid = tid_, lane = tid & 63, w = __builtin_amdgcn_readfirstlane(tid >> 6);
    const int b = un >> 9, h = (un >> 6) & 7, c = un & 63; const int tok0 = b * SEQ + c * 64;
    LAS float* CU = (LAS float*)(lds + O_CUM); LAS float* BF = (LAS float*)(lds + O_BF); LAS float* KF = (LAS float*)(lds + O_KF);
    LAS float* RHS = (LAS float*)(lds + O_RHS); LAS float* PART = (LAS float*)(lds + O_PART); LAS float* GAMC = (LAS float*)(lds + O_GAMC);
    const int t = tid >> 3, cg = tid & 7, n0 = 8 * cg, hn0 = h * 64 + n0;
    const int fr = lane & 15, fq = lane >> 4;
    FoxRow fxr; const bool dofox = cv.foxm >= 0; if (dofox) fox_load(fxr, *cv.fox, cv.foxm, lane);
    const bool docv = cv.it0 >= 0; f32x4 cldA[8], cldB[8]; CvtItem ciA, ciB;
    if (docv) { ciA = cvt_item(cv.it0, cv.w1, cv.w2, cv.W1T, cv.W2T); cvt_load(cldA, ciA, lane); }
#define BF4(w) ((f32x4){__uint_as_float((w).x << 16), __uint_as_float((w).x & 0xffff0000u), __uint_as_float((w).y << 16), __uint_as_float((w).y & 0xffff0000u)})
#pragma unroll
    for (int i = 0; i < 5; ++i) { const int idx = tid + 512 * i, tt = idx / 40, c4 = idx - tt * 40; const f32x4 m4 = *(const f32x4*)(P.mu + C_WD + 4 * c4);
        const f32x4 xp = BF4(R.xp[i]), xq = BF4(R.xq[i]); f32x4 x = xp + m4 * (xq - xp); float hi[4], lo[4];
#pragma unroll
        for (int e = 0; e < 4; ++e) { const int j = 4 * c4 + e; const float y = (j < 32) ? tanh_fast(x[e]) : ((j < 64) ? x[e] : sigmoidf_(x[e])); hi[e] = bf2f(f2bf16(y)); lo[e] = y - hi[e]; }
        u32x2v wh, wl; wh.x = pg8::cvt_pk_bf16(hi[0], hi[1]); wh.y = pg8::cvt_pk_bf16(hi[2], hi[3]); wl.x = pg8::cvt_pk_bf16(lo[0], lo[1]); wl.y = pg8::cvt_pk_bf16(lo[2], lo[3]);
        *(LAS u32x2v*)(lds + O_XLH + tt * XPS + c4 * 8) = wh; *(LAS u32x2v*)(lds + O_XLL + tt * XPS + c4 * 8) = wl; }
    float r8[8], k8[8], v8[8];
    { u32x2v a; f32x4 rc[2], rp[2], kc[2], kp[2], vc[2], vp[2];
      a = (u32x2v){R.rc.x, R.rc.y}; rc[0] = BF4(a); a = (u32x2v){R.rc.z, R.rc.w}; rc[1] = BF4(a); a = (u32x2v){R.rp.x, R.rp.y}; rp[0] = BF4(a); a = (u32x2v){R.rp.z, R.rp.w}; rp[1] = BF4(a);
      a = (u32x2v){R.kc.x, R.kc.y}; kc[0] = BF4(a); a = (u32x2v){R.kc.z, R.kc.w}; kc[1] = BF4(a); a = (u32x2v){R.kp.x, R.kp.y}; kp[0] = BF4(a); a = (u32x2v){R.kp.z, R.kp.w}; kp[1] = BF4(a);
      a = (u32x2v){R.vc.x, R.vc.y}; vc[0] = BF4(a); a = (u32x2v){R.vc.z, R.vc.w}; vc[1] = BF4(a); a = (u32x2v){R.vp.x, R.vp.y}; vp[0] = BF4(a); a = (u32x2v){R.vp.z, R.vp.w}; vp[1] = BF4(a);
#pragma unroll
      for (int hf = 0; hf < 2; ++hf) { const f32x4 mr = *(const f32x4*)(P.mu + C_R + hn0 + 4 * hf), mk = *(const f32x4*)(P.mu + C_K + hn0 + 4 * hf), mv = *(const f32x4*)(P.mu + C_V + hn0 + 4 * hf);
          const f32x4 r = rc[hf] + mr * (rp[hf] - rc[hf]), k = kc[hf] + mk * (kp[hf] - kc[hf]), v = vc[hf] + mv * (vp[hf] - vc[hf]);
#pragma unroll
          for (int e = 0; e < 4; ++e) { r8[4 * hf + e] = r[e]; k8[4 * hf + e] = k[e]; v8[4 * hf + e] = v[e]; } } }
#undef BF4
    LDS_BARRIER();
    if (docv) { ciB = cvt_item(cv.it0 + 1, cv.w1, cv.w2, cv.W1T, cv.W2T); cvt_load(cldB, ciB, lane); }
    {
        const int tt = w & 3;
#pragma unroll
        for (int cc = 0; cc < 2; ++cc) { const int nt = 2 * (w >> 2) + cc; f32x4 acc[3];
#pragma unroll
            for (int a = 0; a < 3; ++a) acc[a] = (f32x4){0.f, 0.f, 0.f, 0.f};
#pragma unroll
            for (int ks = 0; ks < 5; ++ks) { const int a = (ks == 0) ? 0 : ((ks == 1) ? 1 : 2);
                const bf16x8 bw = *(const LAS bf16x8*)(lds + O_WT + (16 * nt + fr) * XPS + (32 * ks + 8 * fq) * 2);
                const bf16x8 xh = *(const LAS bf16x8*)(lds + O_XLH + (16 * tt + fr) * XPS + (32 * ks + 8 * fq) * 2), xl = *(const LAS bf16x8*)(lds + O_XLL + (16 * tt + fr) * XPS + (32 * ks + 8 * fq) * 2);
                acc[a] = MFMA16(xh, bw, acc[a]); acc[a] = MFMA16(xl, bw, acc[a]); }
#pragma unroll
            for (int a = 0; a < 3; ++a)
#pragma unroll
                for (int j = 0; j < 4; ++j) CU[a * 4096 + (16 * tt + 4 * fq + j) * 64 + 16 * nt + fr] = acc[a][j]; }
    }
    LDS_BARRIER();
    if (dofox) fox_finish(fxr, *cv.fox, cv.foxm, lane);
    float a8[8], b8[8], lw8[8];
    {
        float accw[8], acca[8], accg[8];
        { const f32x4 q0 = *(const LAS f32x4*)(CU + t * 64 + n0), q1 = *(const LAS f32x4*)(CU + t * 64 + n0 + 4), q2 = *(const LAS f32x4*)(BF + t * 64 + n0), q3 = *(const LAS f32x4*)(BF + t * 64 + n0 + 4), q4 = *(const LAS f32x4*)(KF + t * 64 + n0), q5 = *(const LAS f32x4*)(KF + t * 64 + n0 + 4);
#pragma unroll
          for (int e = 0; e < 4; ++e) { accw[e] = q0[e]; accw[4 + e] = q1[e]; acca[e] = q2[e]; acca[4 + e] = q3[e]; accg[e] = q4[e]; accg[4 + e] = q5[e]; } }
        float kkr[8], lr8[8], g8[8]; float ss = 0.f, dotb = 0.f;
        float pw0[8], pa0[8], pkk[8], pka[8], prk[8];
#pragma unroll
        for (int hf = 0; hf < 2; ++hf) { const f32x4 q0 = *(const f32x4*)(P.w0 + hn0 + 4 * hf), q1 = *(const f32x4*)(P.a0 + hn0 + 4 * hf), q2 = *(const f32x4*)(P.k_k + hn0 + 4 * hf), q3 = *(const f32x4*)(P.k_a + hn0 + 4 * hf), q4 = *(const f32x4*)(P.r_k + hn0 + 4 * hf);
#pragma unroll
            for (int e = 0; e < 4; ++e) { pw0[4 * hf + e] = q0[e]; pa0[4 * hf + e] = q1[e]; pkk[4 * hf + e] = q2[e]; pka[4 * hf + e] = q3[e]; prk[4 * hf + e] = q4[e]; } }
#pragma unroll
        for (int i = 0; i < 8; ++i) {
            const float xw = pw0[i] + accw[i];
            const float wv = fminf(xw, 0.f) - log1pexp_neg(fabsf(xw)) - 0.5f;
            lw8[i] = -__expf(wv);
            lr8[i] = sigmoidf_(pa0[i] + acca[i]); g8[i] = accg[i];
            kkr[i] = k8[i] * pkk[i]; ss += kkr[i] * kkr[i];
            k8[i] = k8[i] * (1.f + (lr8[i] - 1.f) * pka[i]);
            dotb += r8[i] * k8[i] * prk[i]; }
        ss += __shfl_xor(ss, 1); ss += __shfl_xor(ss, 2); ss += __shfl_xor(ss, 4);
        dotb += __shfl_xor(dotb, 1); dotb += __shfl_xor(dotb, 2); dotb += __shfl_xor(dotb, 4);
        const float inv = 1.f / fmaxf(sqrtf(ss), 1e-12f);
        float bon[8];
#pragma unroll
        for (int i = 0; i < 8; ++i) { const float kk = kkr[i] * inv; a8[i] = -kk; b8[i] = kk * lr8[i]; bon[i] = dotb * v8[i]; }
        *(v4u*)(P.G + (size_t)(tok0 + t) * RWW + hn0) = pack8(g8); *(v4u*)(P.Bonus + (size_t)(tok0 + t) * RWW + hn0) = pack8(bon);
        *(LAS f32x4*)(CU + t * 64 + n0) = (f32x4){lw8[0], lw8[1], lw8[2], lw8[3]}; *(LAS f32x4*)(CU + t * 64 + n0 + 4) = (f32x4){lw8[4], lw8[5], lw8[6], lw8[7]};
        *(LAS f32x4*)(BF + t * 64 + n0) = (f32x4){b8[0], b8[1], b8[2], b8[3]}; *(LAS f32x4*)(BF + t * 64 + n0 + 4) = (f32x4){b8[4], b8[5], b8[6], b8[7]};
        *(LAS f32x4*)(KF + t * 64 + n0) = (f32x4){k8[0], k8[1], k8[2], k8[3]}; *(LAS f32x4*)(KF + t * 64 + n0 + 4) = (f32x4){k8[4], k8[5], k8[6], k8[7]};
        LAS unsigned short* VT = (LAS unsigned short*)(lds + O_VT);
#pragma unroll
        for (int i = 0; i < 8; ++i) VT[(n0 + i) * 72 + t] = f2bf16(v8[i]);
    }
    LDS_BARRIER();
    if (docv) { cvt_finish(cldA, ciA, lane); ciA = cvt_item(cv.it0 + 2, cv.w1, cv.w2, cv.W1T, cv.W2T); cvt_load(cldA, ciA, lane); }
    {
        const int n = tid & 63, tg = w; float run = 0.f;
#pragma unroll
        for (int i = 0; i < 8; ++i) { run += CU[(8 * tg + i) * 64 + n]; CU[(8 * tg + i) * 64 + n] = run; }
        PART[tg * 64 + n] = run;
        LDS_BARRIER();
        float off = 0.f;
        for (int g = 0; g < tg; ++g) off += PART[g * 64 + n];
#pragma unroll
        for (int i = 0; i < 8; ++i) CU[(8 * tg + i) * 64 + n] += off;
        if (tg == 7) GAMC[n] = __expf(run + off);
    }
    LDS_BARRIER();
    {
        const f32x4 c0 = *(const LAS f32x4*)(CU + t * 64 + n0), c1 = *(const LAS f32x4*)(CU + t * 64 + n0 + 4);
        const float cum[8] = {c0[0], c0[1], c0[2], c0[3], c1[0], c1[1], c1[2], c1[3]};
        float rt[8], at[8], bt[8], kt[8];
#pragma unroll
        for (int i = 0; i < 8; ++i) { const float ein = __expf(cum[i]), eex = __expf(cum[i] - lw8[i]), eneg = __expf(-cum[i]);
            rt[i] = r8[i] * ein; at[i] = a8[i] * eex; bt[i] = b8[i] * eneg; kt[i] = k8[i] * eneg; }
        *(LAS v4u*)(lds + O_RT + t * OPS + cg * 16) = pack8(rt); *(LAS v4u*)(lds + O_AT + t * OPS + cg * 16) = pack8(at);
        *(LAS v4u*)(lds + O_BT + t * OPS + cg * 16) = pack8(bt); *(LAS v4u*)(lds + O_KT + t * OPS + cg * 16) = pack8(kt);
        *(LAS f32x4*)(RHS + t * 64 + n0) = (f32x4){at[0], at[1], at[2], at[3]}; *(LAS f32x4*)(RHS + t * 64 + n0 + 4) = (f32x4){at[4], at[5], at[6], at[7]};
    }
    {
        const int n = tid & 63, tg = w; const float cC = CU[63 * 64 + n]; float bh[8], kh[8];
#pragma unroll
        for (int i = 0; i < 8; ++i) { const int tt = 8 * tg + i; const float e = __expf(cC - CU[tt * 64 + n]); bh[i] = BF[tt * 64 + n] * e; kh[i] = KF[tt * 64 + n] * e; }
        *(LAS v4u*)(lds + O_BHT + n * OPS + tg * 16) = pack8(bh); *(LAS v4u*)(lds + O_KHT + n * OPS + tg * 16) = pack8(kh);
    }
    LDS_BARRIER();
    if (docv) cvt_finish(cldB, ciB, lane);
    if (has_next) prefetch(Rn, un_next, P, tid);
#define FRAG(off, row, ks) (*(const LAS bf16x8*)(lds + (off) + (row) * OPS + (ks) * 64 + fq * 16))
    {
        const int tt = w & 3, mg = w >> 2; const int lo = mg ? O_RT : O_AT;
        LAS unsigned short* AAK = (LAS unsigned short*)(lds + O_AAK); LAS unsigned short* ARB = (LAS unsigned short*)(lds + O_ARB); LAS unsigned short* ARK = (LAS unsigned short*)(lds + O_ARK);
        LAS unsigned short* PA0 = (LAS unsigned short*)(lds + O_PA0);
        const bf16x8 l0 = FRAG(lo, 16 * tt + fr, 0), l1 = FRAG(lo, 16 * tt + fr, 1);
#pragma unroll
        for (int ct = 0; ct < 4; ++ct)
#pragma unroll
            for (int rh = 0; rh < 2; ++rh) {
                f32x4 acc = {0.f, 0.f, 0.f, 0.f};
                if (ct <= tt) { const int ro = rh ? O_KT : O_BT; acc = MFMA16(l0, FRAG(ro, 16 * ct + fr, 0), acc); acc = MFMA16(l1, FRAG(ro, 16 * ct + fr, 1), acc); }
                const int col = 16 * ct + fr, rowb = 16 * tt + 4 * fq; float vv[4];
#pragma unroll
                for (int j = 0; j < 4; ++j) vv[j] = (mg == 0) ? ((col < rowb + j) ? acc[j] : 0.f) : ((col <= rowb + j) ? acc[j] : 0.f);
                LAS unsigned short* dst = (mg == 0) ? (rh == 0 ? PA0 : AAK) : (rh == 0 ? ARB : ARK);
#pragma unroll
                for (int j = 0; j < 4; ++j) dst[(rowb + j) * 72 + col] = f2bf16(vv[j]);
                if (mg == 0 && rh == 0) { u32x2v pk; pk.x = pg8::cvt_pk_bf16(vv[0], vv[1]); pk.y = pg8::cvt_pk_bf16(vv[2], vv[3]); *(LAS u32x2v*)(lds + O_PT0 + col * OPS + rowb * 2) = pk; }
            }
    }
    LDS_BARRIER();
    {
        f32x4 X[4];
        if (w < 4) {
#pragma unroll
            for (int tt = 0; tt < 4; ++tt)
#pragma unroll
                for (int j = 0; j < 4; ++j) X[tt][j] = RHS[(16 * tt + 4 * fq + j) * 64 + 16 * w + fr];
        } else {
#pragma unroll
            for (int tt = 0; tt < 4; ++tt) { f32x4 acc = {0.f, 0.f, 0.f, 0.f};
                acc = MFMA16(FRAG(O_AAK, 16 * tt + fr, 0), FRAG(O_VT, 16 * (w - 4) + fr, 0), acc); acc = MFMA16(FRAG(O_AAK, 16 * tt + fr, 1), FRAG(O_VT, 16 * (w - 4) + fr, 1), acc); X[tt] = acc; }
        }
        LDS_BARRIER();
#pragma unroll
        for (int k = 0; k < 6; ++k) {
            const int pa = (k & 1) ? O_PA1 : O_PA0, pt = (k & 1) ? O_PT1 : O_PT0, pan = (k & 1) ? O_PA0 : O_PA1, ptn = (k & 1) ? O_PT0 : O_PT1;
            bf16x8 xb[2];
#pragma unroll
            for (int ks = 0; ks < 2; ++ks) { v4u q; q.x = pk2(X[2 * ks][0], X[2 * ks][1]); q.y = pk2(X[2 * ks][2], X[2 * ks][3]); q.z = pk2(X[2 * ks + 1][0], X[2 * ks + 1][1]); q.w = pk2(X[2 * ks + 1][2], X[2 * ks + 1][3]); xb[ks] = __builtin_bit_cast(bf16x8, q); }
#pragma unroll
            for (int tt = 0; tt < 4; ++tt)
#pragma unroll
                for (int ks = 0; ks < 2; ++ks) { const LAS unsigned char* rp_ = lds + pa + (16 * tt + fr) * OPS + (32 * ks + 4 * fq) * 2;
                    const u32x2v p0 = *(const LAS u32x2v*)rp_, p1 = *(const LAS u32x2v*)(rp_ + 32); const v4u pq = {p0.x, p0.y, p1.x, p1.y};
                    X[tt] = MFMA16(__builtin_bit_cast(bf16x8, pq), xb[ks], X[tt]); }
            if (k < 5) {
                const int tt = w & 3;
#pragma unroll
                for (int cc = 0; cc < 2; ++cc) { const int ct = 2 * (w >> 2) + cc; f32x4 acc = {0.f, 0.f, 0.f, 0.f};
                    acc = MFMA16(FRAG(pa, 16 * tt + fr, 0), FRAG(pt, 16 * ct + fr, 0), acc); acc = MFMA16(FRAG(pa, 16 * tt + fr, 1), FRAG(pt, 16 * ct + fr, 1), acc);
                    const int col = 16 * ct + fr, rowb = 16 * tt + 4 * fq; LAS unsigned short* PAn = (LAS unsigned short*)(lds + pan);
#pragma unroll
                    for (int j = 0; j < 4; ++j) PAn[(rowb + j) * 72 + col] = f2bf16(acc[j]);
                    u32x2v pk; pk.x = pk2(acc[0], acc[1]); pk.y = pk2(acc[2], acc[3]); *(LAS u32x2v*)(lds + ptn + col * OPS + rowb * 2) = pk; }
            }
            LDS_BARRIER();
        }
#pragma unroll
        for (int tt = 0; tt < 4; ++tt) { u32x2v pk; pk.x = pk2(X[tt][0], X[tt][1]); pk.y = pk2(X[tt][2], X[tt][3]); *(LAS u32x2v*)(lds + O_XT + (16 * w + fr) * OPS + (16 * tt + 4 * fq) * 2) = pk; }
    }
    LDS_BARRIER();
    if (docv) cvt_finish(cldA, ciA, lane);
#ifdef RW_REP_S7
    for (int rep_ = 0; rep_ < 2; ++rep_)
#endif
    {
        asm volatile("" ::: "memory");
        const int rt = w & 3; const size_t ub = (size_t)un * 4096;
        const LAS unsigned short* RTb = (const LAS unsigned short*)(lds + O_RT);
#pragma unroll
        for (int cc = 0; cc < 2; ++cc) { const int ct = 2 * (w >> 2) + cc;
            const bf16x8 arb0 = FRAG(O_ARB, 16 * rt + fr, 0), arb1 = FRAG(O_ARB, 16 * rt + fr, 1), ark0 = FRAG(O_ARK, 16 * rt + fr, 0), ark1 = FRAG(O_ARK, 16 * rt + fr, 1);
            const bf16x8 bht0 = FRAG(O_BHT, 16 * rt + fr, 0), bht1 = FRAG(O_BHT, 16 * rt + fr, 1), kht0 = FRAG(O_KHT, 16 * rt + fr, 0), kht1 = FRAG(O_KHT, 16 * rt + fr, 1);
            const bf16x8 xa0 = FRAG(O_XT, 16 * ct + fr, 0), xa1 = FRAG(O_XT, 16 * ct + fr, 1), xv0 = FRAG(O_XT, 64 + 16 * ct + fr, 0), xv1 = FRAG(O_XT, 64 + 16 * ct + fr, 1);
            const bf16x8 vt0 = FRAG(O_VT, 16 * ct + fr, 0), vt1 = FRAG(O_VT, 16 * ct + fr, 1);
            f32x4 z4 = {0.f, 0.f, 0.f, 0.f};
            f32x4 q = MFMA16(arb0, xa0, z4); q = MFMA16(arb1, xa1, q);
            f32x4 z = MFMA16(arb0, xv0, z4); z = MFMA16(arb1, xv1, z); z = MFMA16(ark0, vt0, z); z = MFMA16(ark1, vt1, z);
            f32x4 m = MFMA16(bht0, xa0, z4); m = MFMA16(bht1, xa1, m);
            f32x4 nn = MFMA16(bht0, xv0, z4); nn = MFMA16(bht1, xv1, nn); nn = MFMA16(kht0, vt0, nn); nn = MFMA16(kht1, vt1, nn);
            const int col = 16 * ct + fr;
            const int mks = col >> 5, mfq = (col & 15) >> 2, me = 4 * ((col >> 4) & 1) + (col & 3);
            LAS unsigned short* QST = (LAS unsigned short*)(lds + O_RHS); LAS unsigned short* MST = QST + 4096; LAS unsigned short* ZST = (LAS unsigned short*)(lds + O_PA0);
#pragma unroll
            for (int j = 0; j < 4; ++j) { const int row = 16 * rt + 4 * fq + j;
                QST[row * 64 + col] = f2bf16(q[j] + bf2f(RTb[row * 72 + col]));
                MST[(((rt * 2 + mks) * 64) + mfq * 16 + (row & 15)) * 8 + me] = f2bf16(m[j] + ((row == col) ? GAMC[row] : 0.f)); }
            { u32x2v pz; pz.x = pk2(z[0], z[1]); pz.y = pk2(z[2], z[3]); *(LAS u32x2v*)(ZST + col * 64 + 16 * rt + 4 * fq) = pz; }
            { u32x2v pn; pn.x = pk2(nn[0], nn[1]); pn.y = pk2(nn[2], nn[3]); *(u32x2v*)(P.NT + ub + ((ct * 4 + rt) * 64 + lane) * 4) = pn; }
        }
    }
#undef FRAG
    LDS_BARRIER();
    { const size_t ub = (size_t)un * 4096;
      *(v4u*)(P.Qc + ub + tid * 8) = *(const LAS v4u*)(lds + O_RHS + tid * 16); *(v4u*)(P.Mc + ub + tid * 8) = *(const LAS v4u*)(lds + O_RHS + 8192 + tid * 16); *(v4u*)(P.ZT + ub + tid * 8) = *(const LAS v4u*)(lds + O_PA0 + tid * 16); }
    LDS_BARRIER();
}

constexpr int CH_SLOT = 16384, CH_NSLOT = 9, CH_AHEAD = 7;
__device__ __forceinline__ void glds16(const void* gsrc, unsigned lds_dst) { unsigned keep;
    asm volatile("s_mov_b32 %0, m0\n\ts_mov_b32 m0, %2\n\ts_nop 0\n\tglobal_load_lds_dwordx4 %1, off\n\ts_mov_b32 m0, %0" : "=&s"(keep) : "v"(gsrc), "s"(lds_dst) : "memory"); }
__device__ __forceinline__ void chain(LAS unsigned char* lds, int bh, const bf16* Mc, const bf16* NT, bf16* SH, bf16* SL) {
    const int tid = threadIdx.x, lane = tid & 63, w = __builtin_amdgcn_readfirstlane(tid >> 6), fr = lane & 15, fq = lane >> 4;
    const unsigned lds0 = (unsigned)(uintptr_t)lds;
    if (w >= 4) {
        const int k = w - 4;
#define CH_ISSUE(cc) do { const size_t ub_ = (size_t)(bh * 64 + (cc)) * 4096; const unsigned sl_ = lds0 + (unsigned)(((cc) % CH_NSLOT) * CH_SLOT); \
            _Pragma("unroll") for (int i_ = 0; i_ < 4; ++i_) { const int p_ = k + 4 * i_; \
                const void* src_ = (p_ < 8) ? (const void*)(Mc + ub_ + p_ * 512 + lane * 8) : (const void*)(NT + ub_ + (p_ - 8) * 512 + lane * 8); \
                glds16(src_, (unsigned)__builtin_amdgcn_readfirstlane(sl_ + p_ * 1024)); } } while (0)
        for (int cc = 0; cc < CH_AHEAD; ++cc) CH_ISSUE(cc);
        for (int c = 0; c < 64; ++c) {
            if (c + CH_AHEAD < 64) CH_ISSUE(c + CH_AHEAD);
            const int left = 63 - c;
            if (left >= 7) asm volatile("s_waitcnt vmcnt(28)" ::: "memory"); else if (left == 6) asm volatile("s_waitcnt vmcnt(24)" ::: "memory"); else if (left == 5) asm volatile("s_waitcnt vmcnt(20)" ::: "memory");
            else if (left == 4) asm volatile("s_waitcnt vmcnt(16)" ::: "memory"); else if (left == 3) asm volatile("s_waitcnt vmcnt(12)" ::: "memory"); else if (left == 2) asm volatile("s_waitcnt vmcnt(8)" ::: "memory");
            else if (left == 1) asm volatile("s_waitcnt vmcnt(4)" ::: "memory"); else asm volatile("s_waitcnt vmcnt(0)" ::: "memory");
            __builtin_amdgcn_s_barrier();
        }
#undef CH_ISSUE
    } else {
        const int vq = w;
        f32x4 S[4];
#pragma unroll
        for (int i = 0; i < 4; ++i) S[i] = (f32x4){0.f, 0.f, 0.f, 0.f};
        for (int c = 0; c < 64; ++c) {
            __builtin_amdgcn_s_barrier(); asm volatile("" ::: "memory");
            const LAS unsigned char* sl = lds + (c % CH_NSLOT) * CH_SLOT;
            const size_t ub = (size_t)(bh * 64 + c) * 4096;
            bf16x8 bh_[2], bl_[2];
#pragma unroll
            for (int ks = 0; ks < 2; ++ks) { float hi8[8], lo8[8];
#pragma unroll
                for (int e = 0; e < 8; ++e) { const float s = S[2 * ks + (e >> 2)][e & 3]; const float hh = bf2f(f2bf16(s)); hi8[e] = hh; lo8[e] = s - hh; }
                const v4u ph = pack8(hi8), pl = pack8(lo8); bh_[ks] = __builtin_bit_cast(bf16x8, ph); bl_[ks] = __builtin_bit_cast(bf16x8, pl);
                const size_t o = ub + (size_t)((vq * 2 + ks) * 64 + lane) * 8;
                *(v4u*)(SH + o) = ph; *(v4u*)(SL + o) = pl; }
#pragma unroll
            for (int mt = 0; mt < 4; ++mt) {
                const bf16x8 a0 = *(const LAS bf16x8*)(sl + ((mt * 2 + 0) * 64 + lane) * 16), a1 = *(const LAS bf16x8*)(sl + ((mt * 2 + 1) * 64 + lane) * 16);
                const u32x2v nw = *(const LAS u32x2v*)(sl + 8192 + ((vq * 4 + mt) * 64 + lane) * 8);
                f32x4 sn = {__uint_as_float(nw.x << 16), __uint_as_float(nw.x & 0xffff0000u), __uint_as_float(nw.y << 16), __uint_as_float(nw.y & 0xffff0000u)};
                sn = MFMA16(a0, bh_[0], sn); sn = MFMA16(a1, bh_[1], sn); sn = MFMA16(a0, bl_[0], sn); sn = MFMA16(a1, bl_[1], sn);
                S[mt] = sn;
            }
        }
    }
}
__device__ __forceinline__ void yout(LAS float* tile, int un, int tt, int lane, const bf16* Qc, const bf16* ZT, const bf16* SH, const bf16* SL, const bf16* G, const bf16* Bonus, const float* gnw, const float* gnb, bf16* MIX) {
    const int fr = lane & 15, fq = lane >> 4; const int b = un >> 9, h = (un >> 6) & 7, c = un & 63; const size_t ub = (size_t)un * 4096;
    bf16x8 qf[2];
#pragma unroll
    for (int ks = 0; ks < 2; ++ks) { const bf16* qp = Qc + ub + (16 * tt + fr) * 64 + 32 * ks + 4 * fq; const u32x2v q0 = *(const u32x2v*)qp, q1 = *(const u32x2v*)(qp + 16);
        const v4u qq = {q0.x, q0.y, q1.x, q1.y}; qf[ks] = __builtin_bit_cast(bf16x8, qq); }
    f32x4 y[4];
#pragma unroll
    for (int vt = 0; vt < 4; ++vt) { const u32x2v zw = *(const u32x2v*)(ZT + ub + (16 * vt + fr) * 64 + 16 * tt + 4 * fq);
        f32x4 acc = {__uint_as_float(zw.x << 16), __uint_as_float(zw.x & 0xffff0000u), __uint_as_float(zw.y << 16), __uint_as_float(zw.y & 0xffff0000u)};
#pragma unroll
        for (int ks = 0; ks < 2; ++ks) { const size_t o = ub + (size_t)((vt * 2 + ks) * 64 + lane) * 8;
            acc = MFMA16(qf[ks], *(const bf16x8*)(SH + o), acc); acc = MFMA16(qf[ks], *(const bf16x8*)(SL + o), acc); }
        y[vt] = acc; }
#pragma unroll
    for (int j = 0; j < 4; ++j) {
        float s = (y[0][j] + y[1][j]) + (y[2][j] + y[3][j]);
        s += __shfl_xor(s, 1); s += __shfl_xor(s, 2); s += __shfl_xor(s, 4); s += __shfl_xor(s, 8);
        const float mean = s * (1.f / 64.f); float d[4], s2 = 0.f;
#pragma unroll
        for (int vt = 0; vt < 4; ++vt) { d[vt] = y[vt][j] - mean; s2 += d[vt] * d[vt]; }
        s2 += __shfl_xor(s2, 1); s2 += __shfl_xor(s2, 2); s2 += __shfl_xor(s2, 4); s2 += __shfl_xor(s2, 8);
        const float rstd = rsqrtf(s2 * (1.f / 64.f) + GN_EPS);
#pragma unroll
        for (int vt = 0; vt < 4; ++vt) tile[(4 * fq + j) * 64 + 16 * vt + fr] = d[vt] * rstd;
    }
    asm volatile("s_waitcnt lgkmcnt(0)" ::: "memory");
    { const int t = lane >> 2, v0 = 16 * (lane & 3), ch = h * 64 + v0; const size_t tok = (size_t)(b * SEQ + c * 64 + 16 * tt + t); const size_t o = tok * RWW + ch;
      const v4u g0 = *(const v4u*)(G + o), g1 = *(const v4u*)(G + o + 8), b0 = *(const v4u*)(Bonus + o), b1 = *(const v4u*)(Bonus + o + 8);
      float r[16];
#pragma unroll
      for (int q4 = 0; q4 < 4; ++q4) { const f32x4 x = *(const LAS f32x4*)(tile + t * 64 + v0 + 4 * q4), w = *(const f32x4*)(gnw + ch + 4 * q4), bb = *(const f32x4*)(gnb + ch + 4 * q4);
#pragma unroll
          for (int e = 0; e < 4; ++e) r[4 * q4 + e] = x[e] * w[e] + bb[e]; }
      const unsigned gw_[8] = {g0.x, g0.y, g0.z, g0.w, g1.x, g1.y, g1.z, g1.w}, bw_[8] = {b0.x, b0.y, b0.z, b0.w, b1.x, b1.y, b1.z, b1.w};
#pragma unroll
      for (int e = 0; e < 8; ++e) { r[2 * e] = (r[2 * e] + __uint_as_float(bw_[e] << 16)) * __uint_as_float(gw_[e] << 16); r[2 * e + 1] = (r[2 * e + 1] + __uint_as_float(bw_[e] & 0xffff0000u)) * __uint_as_float(gw_[e] & 0xffff0000u); }
      *(v4u*)(MIX + tok * D + ch) = pack8(r); *(v4u*)(MIX + tok * D + ch + 8) = pack8(r + 8); }
    asm volatile("s_waitcnt lgkmcnt(0)" ::: "memory");
}
}

struct Args { const float* in[29]; float* out; unsigned char* ws; int ph_lo, ph_hi; };
enum { I_X = 0, I_LNINW, I_LNINB, I_WIN, I_MU, I_W0, I_W2, I_A0, I_A2, I_G2, I_KK, I_KA, I_RK, I_GNW, I_GNB, I_BF, I_QN, I_KN, I_WO, I_LN1W, I_LN1B, I_RW, I_RB, I_W1, I_B1, I_EW2, I_B2, I_LN2W, I_LN2B };
constexpr int N_PHASES = 11;

__device__ __forceinline__ int fresh_tid() { int t = threadIdx.x; asm volatile("" : "+v"(t)); return t; }
__global__ void __launch_bounds__(NTHR, 2) fwd_kernel(Args args) {
    extern __shared__ __attribute__((aligned(16))) unsigned char lds_raw[];
    LAS unsigned char* lds = (LAS unsigned char*)lds_raw;
    volatile LAS unsigned* MISC = (volatile LAS unsigned*)(lds + CTRL_OFF + LC_MISC);
    const int tid = threadIdx.x, lane = tid & 63, wave = __builtin_amdgcn_readfirstlane(tid >> 6);
    const int G = gridDim.x, bx = blockIdx.x;
    const int gw = bx * NWAVES + wave, NGW = G * NWAVES;
    unsigned char* ws = args.ws;
    gu32* ctl = (gu32*)(ws + WS_CTL);
    for (int u = tid; u < (LDS_BYTES - CTRL_OFF) / 4; u += NTHR) ((LAS unsigned*)(lds + CTRL_OFF))[u] = 0u;
    __syncthreads();
    const int lo = args.ph_lo, hi = args.ph_hi;
    const bool multi = (hi - lo) > 1;
    XcdBarrier bar; bar.bar = (unsigned*)(ctl + CW_BAR); bar.x = 0; bar.st = nullptr;
    if (multi) bar = xcd_barrier_post((unsigned*)(ctl + CW_BAR), MISC + 8);
#define IN(k) (lo <= (k) && (k) < hi)
#define SEAM(k) do { if (IN(k) && IN((k) + 1)) xcd_barrier(bar); } while (0)

    bf16* WIN_T = (bf16*)(ws + WS_WIN); bf16* WO_T = (bf16*)(ws + WS_WO); bf16* W1T = (bf16*)(ws + WS_W1T); bf16* W2T = (bf16*)(ws + WS_W2T);
    bf16* HB = (bf16*)(ws + WS_HB); float* HF = (float*)(ws + WS_HF); bf16* PROJ = (bf16*)(ws + WS_PROJ); float* DEAD = (float*)(ws + WS_PROJ + 128 * MiB);
    bf16* GB = (bf16*)(ws + WS_G); bf16* BONUS = (bf16*)(ws + WS_BONUS);
    bf16* QB = (bf16*)(ws + WS_QB); bf16* KB = (bf16*)(ws + WS_KB); bf16* VB = (bf16*)(ws + WS_VB); bf16* MIX = (bf16*)(ws + WS_MIX);
    bf16* MC = (bf16*)(ws + WS_MC); bf16* NT = (bf16*)(ws + WS_NT); bf16* QC = (bf16*)(ws + WS_QC); bf16* ZT = (bf16*)(ws + WS_ZT); bf16* SH = (bf16*)(ws + WS_Y); bf16* SL = (bf16*)(ws + WS_Y + 16 * MiB);
    float* LOGF = (float*)(ws + WS_LOGF);
    int* AE = (int*)(ws + WS_AE); int* APOS = (int*)(ws + WS_APOS); float* AGATE = (float*)(ws + WS_AGATE); int* AROW = (int*)(ws + WS_AROW); float* ROWGATE = (float*)(ws + WS_ROWGATE); int* ROWTOK = (int*)(ws + WS_ROWTOK);
    bf16* XS = (bf16*)(ws + WS_XS); bf16* ACT = (bf16*)(ws + WS_ACT); bf16* EOUT = (bf16*)(ws + WS_EOUT);

    if (IN(0)) {
        const int tid = fresh_tid(), lane = tid & 63;
        LAS float* scr = (LAS float*)(lds + wave * 16384);
        constexpr int I_IN = 16 * 120, I_O = 16 * 32, I_1 = 16 * 64, I_2 = 16 * 32;
        constexpr int NITEMS = I_IN + I_O;
        for (int it = gw; it < NITEMS; it += NGW) {
            int r = it;
            if (r < I_IN) { transpose_item(args.in[I_WIN], D, IN_COLS, 120, WIN_T, scr, r, lane); continue; } r -= I_IN;
            transpose_item(args.in[I_WO], D, D, 32, WO_T, scr, r, lane);
        }
        for (int m = gw; m < M; m += NGW) { f32x4 v[4];
#pragma unroll
            for (int j = 0; j < 4; ++j) v[j] = *(const f32x4*)(args.in[I_X] + (size_t)m * D + 4 * lane + 256 * j);
            ln_finish(v, args.in[I_LNINW], args.in[I_LNINB], lane, nullptr, HB + (size_t)m * D); }
    }
    SEAM(0);
    if (IN(1)) {
        const int tid = fresh_tid(), lane = tid & 63;
        pg8::Gemm g{HB, WIN_T, M, PL, D}; pg8::StaticOrder S; S.init(M, PL, G, bx);
        pg8::EpiBf16 E{PROJ, PL};
        pg8::gemm_phase<pg8::EpiBf16, pg8::StaticOrder, true, true>(lds + RING_OFF, g, S, E);
    }
    SEAM(1);
    if (IN(2)) {
        const int tid = fresh_tid(), lane = tid & 63;
        rwk::Ptrs P{PROJ, args.in[I_MU], args.in[I_W0], args.in[I_W2], args.in[I_A0], args.in[I_A2], args.in[I_G2], args.in[I_KK], args.in[I_KA], args.in[I_RK], GB, BONUS, MC, NT, QC, ZT};
        {
            const FoxPtrs FX{PROJ, args.in[I_QN], args.in[I_KN], args.in[I_BF], QB, KB, VB, LOGF};
            const int h = bx & 7, ngrp = G >> 3; int idx = bx >> 3;
            if (idx < ngrp) {
                rwk::stage_weights(lds, h, P);
                rwk::Pre R0, R1;
#define RW_UN(i) ((((i) >> 6) * NH + h) * 64 + ((i) & 63))
                if (idx < BATCH * 64) rwk::prefetch(R0, RW_UN(idx), P, tid);
                const int nslot = (BATCH * 64 + ngrp - 1) / ngrp; int us = 0;
                for (; idx < BATCH * 64; idx += ngrp, ++us) { const int nx = idx + ngrp; const int it0 = ((bx * NWAVES + wave) * nslot + us) * 3;
                    const int fm = (bx * NWAVES + wave) * nslot + us;
                    const rwk::Cvt cv{args.in[I_W1], args.in[I_EW2], W1T, W2T, (it0 + 2 < NE * 1536) ? it0 : -1, &FX, (fm < M) ? fm : -1};
                    rwk::unit(lds, RW_UN(idx), P, R0, R1, nx < BATCH * 64, RW_UN(nx), cv); R0 = R1; }
#undef RW_UN
            }
            {
                const int ngrp2 = G >> 3, nslot = (ngrp2 > 0) ? (BATCH * 64 + ngrp2 - 1) / ngrp2 : 0; const int covered = (ngrp2 > 0 && (G & 7) == 0 && (BATCH * 64) % ngrp2 == 0) ? G * NWAVES * nslot * 3 : 0;
                for (int it = covered + gw; it < NE * 1536; it += NGW) { f32x4 cld[8]; const CvtItem ci = cvt_item(it, args.in[I_W1], args.in[I_EW2], W1T, W2T); cvt_load(cld, ci, lane); cvt_finish(cld, ci, lane); }
            }
        }
        {
            const FoxPtrs FX{PROJ, args.in[I_QN], args.in[I_KN], args.in[I_BF], QB, KB, VB, LOGF};
            const int ngrp2 = G >> 3, nslot = (ngrp2 > 0) ? (BATCH * 64 + ngrp2 - 1) / ngrp2 : 0; const int covered = (ngrp2 > 0 && (G & 7) == 0 && (BATCH * 64) % ngrp2 == 0) ? G * NWAVES * nslot : 0;
            for (int m = covered + gw; m < M; m += NGW) { FoxRow r; fox_load(r, FX, m, lane); fox_finish(r, FX, m, lane); }
        }
    }
    SEAM(2);
    if (IN(3) || lo == 100 || lo == 101) {
        const int tid = fresh_tid(), lane = tid & 63;
        if (bx < 32 && lo != 100) { rwk::chain(lds, bx, MC, NT, SH, SL); __syncthreads(); }
        if (lo != 101) {
            const attn_body::AttnTensors AT{(const attn_body::bf16*)QB, (const attn_body::bf16*)KB, (const attn_body::bf16*)VB, (attn_body::bf16*)(MIX + 512), LOGF, PROJ};
            attn_body::attn_phase<40>((char*)lds_raw + RING_OFF, AT, (unsigned*)(ctl + CW_ATTQ + (lo == 100 ? 32 : 0)), MISC + 16);
        }
    }
    SEAM(3);
    if (IN(4)) {
        const int tid = fresh_tid(), lane = tid & 63;
        for (int task = gw; task < BATCH * NH * 64 * 4; task += NGW) rwk::yout((LAS float*)(lds + wave * 4096), task >> 2, task & 3, lane, QC, ZT, SH, SL, GB, BONUS, args.in[I_GNW], args.in[I_GNB], MIX);
    }
    SEAM(4);
    if (IN(5) || lo == 103) {
        const int tid = fresh_tid(), lane = tid & 63;
        pg8::Gemm g{MIX, WO_T, M, D, D}; pg8::StaticOrder S; S.init(M, D, G, bx);
        pg8::EpiResid E{HB, (lo == 103) ? DEAD : HF, D, ALPHA};
        pg8::gemm_phase<pg8::EpiResid, pg8::StaticOrder, true, true>(lds + RING_OFF, g, S, E);
    }
    SEAM(5);
    if (IN(6) || lo == 102) {
        const int tid = fresh_tid(), lane = tid & 63;
        const bool prb = (lo == 102);
        float* HFo = prb ? DEAD : HF; bf16* HBo = prb ? (bf16*)(ws + WS_PROJ + 64 * MiB) : HB;
        int* AEo = prb ? (int*)(ws + WS_PROJ + 100 * MiB) : AE; int* APOSo = prb ? (int*)(ws + WS_PROJ + 101 * MiB) : APOS; float* AGATEo = prb ? (float*)(ws + WS_PROJ + 102 * MiB) : AGATE;
        unsigned* ecnt = (unsigned*)(ctl + CW_ECNT) + (prb ? 64 : 0);
        constexpr int XRS = 2064, O_XH = 0, O_XLO = 16 * XRS, O_PARTL = 2 * 16 * XRS, O_LGT = O_PARTL + 8 * 2048;
        LAS float* PARTL = (LAS float*)(lds + O_PARTL); LAS float* LGT = (LAS float*)(lds + O_LGT);
        LAS unsigned* HIST = (LAS unsigned*)(lds + CTRL_OFF + LC_HIST); LAS unsigned* BASE = (LAS unsigned*)(lds + CTRL_OFF + LC_BASE);
        LAS int* RI_E = (LAS int*)(lds + CTRL_OFF + LC_ROWINFO); LAS int* RI_P = RI_E + 256; LAS float* RI_G = (LAS float*)(RI_P + 256);
        const float* rw = args.in[I_RW]; const float* rb = args.in[I_RB];
        const int fr = lane & 15, fq = lane >> 4;
        bf16x8 wh[2][4], wl[2][4];
#pragma unroll
        for (int et = 0; et < 2; ++et)
#pragma unroll
            for (int ks = 0; ks < 4; ++ks) { float hi[8], lo[8];
#pragma unroll
                for (int i = 0; i < 8; ++i) { const float v = rw[(size_t)(128 * wave + 32 * ks + 8 * fq + i) * NE + 16 * et + fr]; hi[i] = bf2f(f2bf16(v)); lo[i] = v - hi[i]; }
                const v4u ph = pack8(hi), pl = pack8(lo); wh[et][ks] = __builtin_bit_cast(bf16x8, ph); wl[et][ks] = __builtin_bit_cast(bf16x8, pl); }
        if (tid < NE) HIST[tid] = 0u;
        __syncthreads();
        for (int r0 = bx * 64; r0 < M; r0 += G * 64) {
            for (int g = 0; g < 4; ++g) {
                f32x4 v[2][4];
#pragma unroll
                for (int u = 0; u < 2; ++u)
#pragma unroll
                    for (int j = 0; j < 4; ++j) v[u][j] = *(const f32x4*)(HF + (size_t)(r0 + 16 * g + 2 * wave + u) * D + 4 * lane + 256 * j);
#pragma unroll
                for (int u = 0; u < 2; ++u) { const int rl = 2 * wave + u; const int m = r0 + 16 * g + rl;
                    ln_finish(v[u], args.in[I_LN1W], args.in[I_LN1B], lane, nullptr, HBo + (size_t)m * D);
#pragma unroll
                    for (int j = 0; j < 4; ++j) { float hi[4], lo[4];
#pragma unroll
                        for (int e = 0; e < 4; ++e) { hi[e] = bf2f(f2bf16(v[u][j][e])); lo[e] = v[u][j][e] - hi[e]; }
                        u32x2v ph, pl; ph.x = pk2(hi[0], hi[1]); ph.y = pk2(hi[2], hi[3]); pl.x = pk2(lo[0], lo[1]); pl.y = pk2(lo[2], lo[3]);
                        *(LAS u32x2v*)(lds + O_XH + rl * XRS + (4 * lane + 256 * j) * 2) = ph; *(LAS u32x2v*)(lds + O_XLO + rl * XRS + (4 * lane + 256 * j) * 2) = pl; } }
                __syncthreads();
                f32x4 acc[2] = {{0.f, 0.f, 0.f, 0.f}, {0.f, 0.f, 0.f, 0.f}};
#pragma unroll
                for (int ks = 0; ks < 4; ++ks) { const bf16x8 xh = *(const LAS bf16x8*)(lds + O_XH + fr * XRS + (128 * wave + 32 * ks + 8 * fq) * 2), xl = *(const LAS bf16x8*)(lds + O_XLO + fr * XRS + (128 * wave + 32 * ks + 8 * fq) * 2);
#pragma unroll
                    for (int et = 0; et < 2; ++et) { acc[et] = MFMA16(xh, wh[et][ks], acc[et]); acc[et] = MFMA16(xl, wh[et][ks], acc[et]); acc[et] = MFMA16(xh, wl[et][ks], acc[et]); } }
#pragma unroll
                for (int et = 0; et < 2; ++et)
#pragma unroll
                    for (int j = 0; j < 4; ++j) PARTL[wave * 512 + (4 * fq + j) * 32 + 16 * et + fr] = acc[et][j];
                __syncthreads();
                { const int row = tid >> 5, e = tid & 31; float s = rb[e];
#pragma unroll
                  for (int w8 = 0; w8 < 8; ++w8) s += PARTL[w8 * 512 + row * 32 + e];
                  LGT[e * 64 + 16 * g + row] = s; }
            }
            __syncthreads();
            if (wave == 0) {
                float t0 = -INFINITY, t1 = -INFINITY, t2 = -INFINITY, t3 = -INFINITY; int i0 = 0, i1 = 0, i2 = 0, i3 = 0;
#pragma unroll 8
                for (int e = 0; e < NE; ++e) { const float x = LGT[e * 64 + lane];
                    if (x > t3) { if (x > t2) { t3 = t2; i3 = i2; if (x > t1) { t2 = t1; i2 = i1; if (x > t0) { t1 = t0; i1 = i0; t0 = x; i0 = e; } else { t1 = x; i1 = e; } } else { t2 = x; i2 = e; } } else { t3 = x; i3 = e; } } }
                const float e1 = __expf(t1 - t0), e2 = __expf(t2 - t0), e3 = __expf(t3 - t0); const float inv = 1.f / (1.f + e1 + e2 + e3);
                const float gt[4] = {inv, e1 * inv, e2 * inv, e3 * inv}; const int ti[4] = {i0, i1, i2, i3};
#pragma unroll
                for (int j = 0; j < 4; ++j) { const unsigned p = __hip_atomic_fetch_add(HIST + ti[j], 1u, __ATOMIC_RELAXED, __HIP_MEMORY_SCOPE_WORKGROUP); RI_E[lane * 4 + j] = ti[j]; RI_P[lane * 4 + j] = (int)p; RI_G[lane * 4 + j] = gt[j]; }
            }
            __syncthreads();
            if (tid < NE) { BASE[tid] = __hip_atomic_fetch_add(ecnt + tid, HIST[tid], __ATOMIC_RELAXED, __HIP_MEMORY_SCOPE_AGENT); HIST[tid] = 0u; }
            __syncthreads();
            if (tid < 256) { const int e = RI_E[tid]; const size_t a = (size_t)r0 * 4 + tid; AEo[a] = e; APOSo[a] = (int)BASE[e] + RI_P[tid]; AGATEo[a] = RI_G[tid]; }
            __syncthreads();
        }
    }
    SEAM(6);
#define TILE_TABLE() do { if (tid < 64) { LAS int* TS = (LAS int*)(lds + CTRL_OFF + LC_TSTART); LAS unsigned char* TE = (LAS unsigned char*)(lds + CTRL_OFF + LC_TEXP); \
        const int cnt = (tid < NE) ? (int)__hip_atomic_load((unsigned*)(ctl + CW_ECNT) + tid, __ATOMIC_RELAXED, __HIP_MEMORY_SCOPE_AGENT) : 0; const int nt_ = (cnt + 255) >> 8; \
        int inc_ = nt_; _Pragma("unroll") for (int o_ = 1; o_ < 32; o_ <<= 1) { const int t_ = __shfl_up(inc_, o_); if ((tid & 63) >= o_) inc_ += t_; } \
        const int st_ = inc_ - nt_; if (tid < NE) { TS[tid] = st_; for (int k = 0; k < nt_; ++k) TE[st_ + k] = (unsigned char)tid; } if (tid == NE - 1) { MISC[17] = (unsigned)inc_; TS[NE] = inc_; } } __syncthreads(); } while (0)
    if (IN(7)) {
        const int tid = fresh_tid(), lane = tid & 63;
        TILE_TABLE();
        const LAS int* TS = (const LAS int*)(lds + CTRL_OFF + LC_TSTART);
        for (int a = bx * NTHR + tid; a < NASSIGN; a += G * NTHR) { const int e = AE[a], row = TS[e] * 256 + APOS[a]; ROWTOK[row] = a >> 2; ROWGATE[row] = AGATE[a]; AROW[a] = row; }
        for (int e = bx; e < NE; e += G) { const int cnt = (int)__hip_atomic_load((unsigned*)(ctl + CW_ECNT) + e, __ATOMIC_RELAXED, __HIP_MEMORY_SCOPE_AGENT); const int r0 = TS[e] * 256 + cnt, r1 = (TS[e] + ((cnt + 255) >> 8)) * 256;
            for (int r = r0 + tid; r < r1; r += NTHR) { ROWTOK[r] = 0; ROWGATE[r] = 0.f; } }
    }
    SEAM(7);
    if (IN(8)) {
        const int tid = fresh_tid(), lane = tid & 63;
        TILE_TABLE();
        LAS int* rowtab = (LAS int*)(lds + 131072);
        pg8::Gemm g{HB, W1T, XROWS, 2048, D}; pg8::MoeOrder<true> S{(const PG8_LAS unsigned char*)(lds + CTRL_OFF + LC_TEXP), (const PG8_LAS int*)(lds + CTRL_OFF + LC_TSTART), (int)MISC[17], 8, G, bx, rowtab};
        { pg8::Unit u; for (int i = 0; i < 28 && S.next(i, u); ++i) if (tid < 256) rowtab[i * 256 + tid] = ROWTOK[u.pm * 256 + tid]; }
        __syncthreads();
        pg8::EpiSwiglu E{ACT, D, args.in[I_B1]};
        pg8::gemm_phase<pg8::EpiSwiglu, pg8::MoeOrder<true>, true, true>(lds + RING_OFF, g, S, E);
    }
    SEAM(8);
    if (IN(9)) {
        const int tid = fresh_tid(), lane = tid & 63;
        TILE_TABLE();
        pg8::Gemm g{ACT, W2T, XROWS, D, D}; pg8::MoeOrder<false> S{(const PG8_LAS unsigned char*)(lds + CTRL_OFF + LC_TEXP), (const PG8_LAS int*)(lds + CTRL_OFF + LC_TSTART), (int)MISC[17], 4, G, bx, nullptr};
        pg8::EpiGate E{EOUT, D, args.in[I_B2], ROWGATE};
        pg8::gemm_phase<pg8::EpiGate, pg8::MoeOrder<false>, true, true>(lds + RING_OFF, g, S, E);
    }
    SEAM(9);
    if (IN(10)) {
        const int tid = fresh_tid(), lane = tid & 63;
        for (int m0 = gw; m0 < M; m0 += 2 * NGW) {
            int rows[2][4];
#pragma unroll
            for (int u = 0; u < 2; ++u)
#pragma unroll
                for (int s = 0; s < 4; ++s) rows[u][s] = AROW[(m0 + u * NGW) * 4 + s];
            u32x2v hw[2][4], ew[2][4][4];
#pragma unroll
            for (int u = 0; u < 2; ++u) {
#pragma unroll
                for (int j = 0; j < 4; ++j) hw[u][j] = *(const u32x2v*)(HB + (size_t)(m0 + u * NGW) * D + 4 * lane + 256 * j);
#pragma unroll
                for (int s = 0; s < 4; ++s)
#pragma unroll
                    for (int j = 0; j < 4; ++j) ew[u][s][j] = *(const u32x2v*)(EOUT + (size_t)rows[u][s] * D + 4 * lane + 256 * j); }
#pragma unroll
            for (int u = 0; u < 2; ++u) { f32x4 v[4];
#pragma unroll
                for (int j = 0; j < 4; ++j) { const u32x2v w = hw[u][j];
                    v[j] = (f32x4){__uint_as_float(w.x << 16), __uint_as_float(w.x & 0xffff0000u), __uint_as_float(w.y << 16), __uint_as_float(w.y & 0xffff0000u)} * ALPHA; }
#pragma unroll
                for (int s = 0; s < 4; ++s)
#pragma unroll
                    for (int j = 0; j < 4; ++j) { const u32x2v w = ew[u][s][j];
                        v[j].x += __uint_as_float(w.x << 16); v[j].y += __uint_as_float(w.x & 0xffff0000u); v[j].z += __uint_as_float(w.y << 16); v[j].w += __uint_as_float(w.y & 0xffff0000u); }
                ln_finish(v, args.in[I_LN2W], args.in[I_LN2B], lane, args.out + (size_t)(m0 + u * NGW) * D, nullptr); }
        }
    }
#undef IN
#undef SEAM
#undef TILE_TABLE
}

#ifndef MK_ONE_LAUNCH
#define MK_ONE_LAUNCH 1
#endif
extern "C" void kernel_launch(void* const* d_in, const int* in_sizes, int n_in, void* d_out, int out_size, void* d_ws, size_t ws_size, hipStream_t stream) {
    static int grid = 0;
    if (grid == 0) {
        if (n_in != 29 || in_sizes[0] != M * D || out_size != M * D || ws_size < WS_END) { fprintf(stderr, "kernel_launch: unexpected shapes (n_in %d, in0 %d, out %d, ws %zu); nothing launched\n", n_in, n_in > 0 ? in_sizes[0] : -1, out_size, ws_size); grid = -1; return; }
        int dev = 0, cus = 0, per_cu = 0;
        if (hipGetDevice(&dev) != hipSuccess || hipDeviceGetAttribute(&cus, hipDeviceAttributeMultiprocessorCount, dev) != hipSuccess) { grid = -1; return; }
        if (hipFuncSetAttribute((const void*)fwd_kernel, hipFuncAttributeMaxDynamicSharedMemorySize, LDS_BYTES) != hipSuccess) { fprintf(stderr, "kernel_launch: hipFuncSetAttribute failed\n"); grid = -1; return; }
        if (hipOccupancyMaxActiveBlocksPerMultiprocessor(&per_cu, (const void*)fwd_kernel, NTHR, LDS_BYTES) != hipSuccess || per_cu < 1) fprintf(stderr, "kernel_launch: occupancy query reports %d\n", per_cu);
        (void)hipGetLastError();
        grid = cus;
        if (grid < 32) { grid = -1; return; }
    }
    if (grid < 0) return;
    if (hipMemsetAsync((char*)d_ws + WS_CTL, 0, CTL_ZERO_BYTES, stream) != hipSuccess) return;
    Args a{};
    for (int i = 0; i < 29; ++i) a.in[i] = (const float*)d_in[i];
    a.out = (float*)d_out; a.ws = (unsigned char*)d_ws;
#if MK_ONE_LAUNCH
    a.ph_lo = 0; a.ph_hi = N_PHASES;
    hipLaunchKernelGGL(fwd_kernel, dim3(grid), dim3(NTHR), LDS_BYTES, stream, a);
#else
    for (int p = 0; p < N_PHASES; ++p) {
#ifdef PROBE_REP
        if (p == PROBE_REP && (p == 5 || p == 6)) { a.ph_lo = (p == 5) ? 103 : 102; a.ph_hi = a.ph_lo + 1; hipLaunchKernelGGL(fwd_kernel, dim3(grid), dim3(NTHR), LDS_BYTES, stream, a); }
#endif
        a.ph_lo = p; a.ph_hi = p + 1; hipLaunchKernelGGL(fwd_kernel, dim3(grid), dim3(NTHR), LDS_BYTES, stream, a);
#ifdef PROBE_REP
        if (p == PROBE_REP && p != 5 && p != 6) { if (p == 3) { a.ph_lo = PROBE_P3; a.ph_hi = PROBE_P3 + 1; } hipLaunchKernelGGL(fwd_kernel, dim3(grid), dim3(NTHR), LDS_BYTES, stream, a); }
#endif
    }
#endif
}
```
